# Optimizing an MI355X kernel written in HIP

```python
import jax
import jax.numpy as jnp
from jax import lax

D_MODEL = 2048
BATCH = 2
SEQ = 8192
DEPTH = 1

MIX_WIDTH = D_MODEL
HEAD_DIM = 128
NSA_HEADS = 8
NSA_KV_HEADS = 2
NSA_WIDTH = NSA_HEADS * HEAD_DIM
KV_WIDTH = NSA_KV_HEADS * HEAD_DIM
N_BRANCH = 3
CMP_BLK = 32
CMP_STRIDE = 16
CMP_HIDDEN = 256
SLC_BLK = 64
N_SEL = 16
WINDOW = 512
NSA_Q_BLK = 64
ROPE_THETA = 500000.0
ROT_DIM = HEAD_DIM // 4
POOL_WIDTH = MIX_WIDTH - NSA_WIDTH
POOL_WINDOWS = (2, 4, 8, 16)
N_POOL_GROUPS = 4
POOL_GC = POOL_WIDTH // N_POOL_GROUPS
IN_COLS = NSA_WIDTH + 6 * KV_WIDTH + NSA_HEADS * N_BRANCH + POOL_WIDTH
N_EXPERTS = 32
TOP_K = 4
D_FF = D_MODEL
SWIGLU_ALPHA = 1.702
SWIGLU_LIMIT = 7.0
MOE_BLK = 128
RMS_EPS = 1e-5
QK_EPS = 1e-6
MASK_VALUE = -1e30
FORCE_VALUE = 1e30

kernel_name = 'hybrid_nsa_pool_moe_layer'


def rmsnorm(x, g, eps=RMS_EPS):
    xf = x.astype(jnp.float32)
    y = xf * lax.rsqrt(jnp.mean(xf * xf, axis=-1, keepdims=True) + eps)
    return (y * g.astype(jnp.float32)).astype(x.dtype)


def partial_rope(x, pos):
    half = ROT_DIM // 2
    inv_freq = ROPE_THETA ** (-jnp.arange(0, ROT_DIM, 2, dtype=jnp.float32) / ROT_DIM)
    ang = pos[:, None] * inv_freq[None, :]
    cos = jnp.cos(ang)[None, :, None, :]
    sin = jnp.sin(ang)[None, :, None, :]
    xf = x.astype(jnp.float32)
    x1, x2, rest = xf[..., :half], xf[..., half:ROT_DIM], xf[..., ROT_DIM:]
    y = jnp.concatenate([x1 * cos - x2 * sin, x2 * cos + x1 * sin, rest], axis=-1)
    return y.astype(x.dtype)


def masked_softmax(s, mask):
    p = jax.nn.softmax(jnp.where(mask, s, MASK_VALUE), axis=-1)
    return jnp.where(mask, p, 0.0)


def compress_blocks(kv, pos_emb, w1, b1, w2, b2):
    B, S, G, D = kv.shape
    chunks = kv.reshape(B, S // CMP_STRIDE, CMP_STRIDE, G, D)
    blocks = jnp.concatenate([chunks[:, :-1], chunks[:, 1:]], axis=2)
    blocks = blocks + pos_emb[None, None, :, None, :]
    hid = jax.nn.gelu(jnp.einsum('bnlgd,ldh->bngh', blocks, w1) + b1)
    return jnp.einsum('bngh,hd->bngd', hid, w2) + b2


def nsa_mixer(q, k_c, v_c, k_s, v_s, k_w, v_w, g_logit,
              q_norm_g, k_norm_cmp_g, k_norm_slc_g, k_norm_win_g,
              cmp_k_pos, cmp_k_w1, cmp_k_b1, cmp_k_w2, cmp_k_b2,
              cmp_v_pos, cmp_v_w1, cmp_v_b1, cmp_v_w2, cmp_v_b2):
    B, S, _ = q.shape
    H, G, D = NSA_HEADS, NSA_KV_HEADS, HEAD_DIM
    R = H // G
    Q = NSA_Q_BLK
    pos = jnp.arange(S, dtype=jnp.float32)
    q = partial_rope(rmsnorm(q.reshape(B, S, H, D), q_norm_g, QK_EPS), pos)
    k_s = partial_rope(rmsnorm(k_s.reshape(B, S, G, D), k_norm_slc_g, QK_EPS), pos)
    k_w = partial_rope(rmsnorm(k_w.reshape(B, S, G, D), k_norm_win_g, QK_EPS), pos)
    v_s = v_s.reshape(B, S, G, D)
    v_w = v_w.reshape(B, S, G, D)
    n_cmp = S // CMP_STRIDE - 1
    c_end = jnp.arange(n_cmp, dtype=jnp.int32) * CMP_STRIDE + (CMP_BLK - 1)
    k_c = compress_blocks(k_c.reshape(B, S, G, D), cmp_k_pos, cmp_k_w1, cmp_k_b1, cmp_k_w2, cmp_k_b2)
    k_c = partial_rope(rmsnorm(k_c, k_norm_cmp_g, QK_EPS), c_end.astype(jnp.float32))
    v_c = compress_blocks(v_c.reshape(B, S, G, D), cmp_v_pos, cmp_v_w1, cmp_v_b1, cmp_v_w2, cmp_v_b2)
    gates = jax.nn.sigmoid(g_logit.astype(jnp.float32)).astype(q.dtype).reshape(B, S, G, R, N_BRANCH)
    n_slc = S // SLC_BLK
    n_sel = min(N_SEL, n_slc)
    k_blocks = k_s.reshape(B, n_slc, SLC_BLK, G, D).transpose(0, 3, 1, 2, 4)
    v_blocks = v_s.reshape(B, n_slc, SLC_BLK, G, D).transpose(0, 3, 1, 2, 4)
    pad = ((0, 0), (WINDOW, 0), (0, 0), (0, 0))
    k_wp = jnp.pad(k_w, pad)
    v_wp = jnp.pad(v_w, pad)
    scale = HEAD_DIM ** -0.5
    gather_blocks = jax.vmap(jax.vmap(lambda blocks, idx: blocks[idx]))
    blk_ids = jnp.arange(n_slc, dtype=jnp.int32)
    in_blk = jnp.arange(SLC_BLK, dtype=jnp.int32)
    win_off = jnp.arange(Q + WINDOW, dtype=jnp.int32) - WINDOW

    def attend_block(qi):
        qs = qi * Q
        t = qs + jnp.arange(Q, dtype=jnp.int32)
        qb = lax.dynamic_slice_in_dim(q, qs, Q, axis=1).reshape(B, Q, G, R, D)
        s_c = jnp.einsum('bqgrd,bngd->bgrqn', qb, k_c).astype(jnp.float32) * scale
        p_c = masked_softmax(s_c, c_end[None, :] <= t[:, None])
        o_c = jnp.einsum('bgrqn,bngd->bqgrd', p_c.astype(v_c.dtype), v_c)
        imp = p_c.sum(axis=2)
        chunk = (jnp.pad(imp, ((0, 0), (0, 0), (0, 0), (0, 1)))
                 + jnp.pad(imp, ((0, 0), (0, 0), (0, 0), (1, 0))))
        blk_score = chunk.reshape(B, G, Q, n_slc, SLC_BLK // CMP_STRIDE).sum(-1)
        cur = (t // SLC_BLK)[:, None]
        forced = (blk_ids == 0) | (blk_ids == cur) | (blk_ids == cur - 1)
        blk_score = jnp.where(forced, FORCE_VALUE,
                              jnp.where(blk_ids <= cur, blk_score, MASK_VALUE))
        _, sel = lax.top_k(blk_score, n_sel)
        k_sel = gather_blocks(k_blocks, sel).reshape(B, G, Q, n_sel * SLC_BLK, D)
        v_sel = gather_blocks(v_blocks, sel).reshape(B, G, Q, n_sel * SLC_BLK, D)
        kpos = (sel[..., None] * SLC_BLK + in_blk).reshape(B, G, Q, n_sel * SLC_BLK)
        s_s = jnp.einsum('bqgrd,bgqkd->bgrqk', qb, k_sel).astype(jnp.float32) * scale
        p_s = masked_softmax(s_s, (kpos <= t[:, None])[:, :, None])
        o_s = jnp.einsum('bgrqk,bgqkd->bqgrd', p_s.astype(v_sel.dtype), v_sel)
        kw = lax.dynamic_slice_in_dim(k_wp, qs, Q + WINDOW, axis=1)
        vw = lax.dynamic_slice_in_dim(v_wp, qs, Q + WINDOW, axis=1)
        kpos_w = qs + win_off
        diff = t[:, None] - kpos_w[None, :]
        mask_w = (diff >= 0) & (diff < WINDOW) & (kpos_w[None, :] >= 0)
        s_w = jnp.einsum('bqgrd,bkgd->bgrqk', qb, kw).astype(jnp.float32) * scale
        p_w = masked_softmax(s_w, mask_w)
        o_w = jnp.einsum('bgrqk,bkgd->bqgrd', p_w.astype(vw.dtype), vw)
        gb = lax.dynamic_slice_in_dim(gates, qs, Q, axis=1)
        o = gb[..., 0:1] * o_c + gb[..., 1:2] * o_s + gb[..., 2:3] * o_w
        return o.reshape(B, Q, H * D)

    out = lax.map(attend_block, jnp.arange(S // Q, dtype=jnp.int32))
    return out.transpose(1, 0, 2, 3).reshape(B, S, H * D)


def pool_mixer(v, pool_w, pool_scale):
    B, S, _ = v.shape
    vg = v.reshape(B, S, N_POOL_GROUPS, POOL_GC).astype(jnp.float32)
    cs = jnp.cumsum(vg, axis=1)
    t = jnp.arange(S, dtype=jnp.int32)
    outs = []
    for gi, w in enumerate(POOL_WINDOWS):
        c = cs[:, :, gi]
        lag = jnp.pad(c, ((0, 0), (w, 0), (0, 0)))[:, :S]
        cnt = jnp.minimum(t + 1, w).astype(jnp.float32)[None, :, None]
        outs.append((c - lag) / cnt - vg[:, :, gi])
    d = jnp.stack(outs, axis=2).astype(v.dtype)
    y = jnp.einsum('bsgc,gce->bsge', d, pool_w)
    return y.reshape(B, S, POOL_WIDTH) * pool_scale


def moe_ffn(h, w_router, b_router, w_gate_up, b_gate_up, w_down, b_down):
    T, D = h.shape
    logits = jnp.einsum('td,de->te', h, w_router).astype(jnp.float32) + b_router.astype(jnp.float32)
    top_logit, top_idx = lax.top_k(logits, TOP_K)
    top_w = jax.nn.softmax(top_logit, axis=-1)
    n_assign = T * TOP_K
    flat_e = top_idx.reshape(n_assign)
    flat_tok = jnp.arange(n_assign, dtype=jnp.int32) // TOP_K
    flat_w = top_w.reshape(n_assign)
    order = jnp.argsort(flat_e)
    e_sorted = flat_e[order]
    counts = jnp.bincount(flat_e, length=N_EXPERTS)
    start = jnp.cumsum(counts) - counts
    padded = (counts + MOE_BLK - 1) // MOE_BLK * MOE_BLK
    pad_end = jnp.cumsum(padded)
    pad_start = pad_end - padded
    dest = pad_start[e_sorted] + (jnp.arange(n_assign, dtype=jnp.int32) - start[e_sorted])
    n_rows = n_assign + N_EXPERTS * MOE_BLK
    n_blocks = n_rows // MOE_BLK
    tok_buf = jnp.zeros((n_rows,), jnp.int32).at[dest].set(flat_tok[order])
    w_buf = jnp.zeros((n_rows,), jnp.float32).at[dest].set(flat_w[order])
    blk_exp = jnp.minimum(
        jnp.searchsorted(pad_end, jnp.arange(n_blocks, dtype=jnp.int32) * MOE_BLK, side='right'),
        N_EXPERTS - 1)

    def expert_block(args):
        tok, wt, e = args
        xb = h[tok]
        gu = xb @ w_gate_up[e] + b_gate_up[e]
        gate = jnp.minimum(gu[:, :D_FF], SWIGLU_LIMIT)
        up = jnp.clip(gu[:, D_FF:], -SWIGLU_LIMIT, SWIGLU_LIMIT)
        act = (up + 1.0) * gate * jax.nn.sigmoid(SWIGLU_ALPHA * gate)
        y = act @ w_down[e] + b_down[e]
        return y * wt[:, None].astype(y.dtype)

    y_buf = lax.map(expert_block, (tok_buf.reshape(n_blocks, MOE_BLK),
                                   w_buf.reshape(n_blocks, MOE_BLK), blk_exp))
    return jnp.zeros_like(h).at[tok_buf].add(y_buf.reshape(n_rows, D))


def hybrid_layer(x, norm1_g, w_in, q_norm_g, k_norm_cmp_g, k_norm_slc_g, k_norm_win_g,
                 cmp_k_pos, cmp_k_w1, cmp_k_b1, cmp_k_w2, cmp_k_b2,
                 cmp_v_pos, cmp_v_w1, cmp_v_b1, cmp_v_w2, cmp_v_b2,
                 pool_w, pool_scale, w_out, norm2_g,
                 w_router, b_router, w_gate_up, b_gate_up, w_down, b_down):
    B, S, _ = x.shape
    h = rmsnorm(x, norm1_g)
    z = jnp.einsum('bsd,dc->bsc', h, w_in)
    sizes = [NSA_WIDTH] + [KV_WIDTH] * 6 + [NSA_HEADS * N_BRANCH, POOL_WIDTH]
    cuts = [sum(sizes[:i + 1]) for i in range(len(sizes) - 1)]
    q, k_c, v_c, k_s, v_s, k_w, v_w, g_logit, pool_in = jnp.split(z, cuts, axis=-1)
    nsa_out = nsa_mixer(q, k_c, v_c, k_s, v_s, k_w, v_w, g_logit,
                        q_norm_g, k_norm_cmp_g, k_norm_slc_g, k_norm_win_g,
                        cmp_k_pos, cmp_k_w1, cmp_k_b1, cmp_k_w2, cmp_k_b2,
                        cmp_v_pos, cmp_v_w1, cmp_v_b1, cmp_v_w2, cmp_v_b2)
    pool_out = pool_mixer(pool_in, pool_w, pool_scale)
    mix = jnp.concatenate([nsa_out, pool_out], axis=-1)
    x = x + jnp.einsum('bsc,cd->bsd', mix, w_out)
    h2 = rmsnorm(x, norm2_g).reshape(B * S, D_MODEL)
    y = moe_ffn(h2, w_router, b_router, w_gate_up, b_gate_up, w_down, b_down)
    return x + y.reshape(B, S, D_MODEL)


def _normal(k, shape, scale):
    return scale * jax.random.normal(k, shape, jnp.float32)


def setup_inputs(seed: int = 0) -> dict:
    key = jax.random.key(seed)
    ks = iter(jax.random.split(key, 27))
    L = DEPTH
    gain = lambda k, n: 1.0 + _normal(k, (L, n), 0.1)
    return {
        'x': _normal(next(ks), (BATCH, SEQ, D_MODEL), 1.0),
        'norm1_g': gain(next(ks), D_MODEL),
        'w_in': _normal(next(ks), (L, D_MODEL, IN_COLS), D_MODEL ** -0.5),
        'q_norm_g': gain(next(ks), HEAD_DIM),
        'k_norm_cmp_g': gain(next(ks), HEAD_DIM),
        'k_norm_slc_g': gain(next(ks), HEAD_DIM),
        'k_norm_win_g': gain(next(ks), HEAD_DIM),
        'cmp_k_pos': _normal(next(ks), (L, CMP_BLK, HEAD_DIM), 0.1),
        'cmp_k_w1': _normal(next(ks), (L, CMP_BLK, HEAD_DIM, CMP_HIDDEN), (CMP_BLK * HEAD_DIM) ** -0.5),
        'cmp_k_b1': _normal(next(ks), (L, CMP_HIDDEN), 0.02),
        'cmp_k_w2': _normal(next(ks), (L, CMP_HIDDEN, HEAD_DIM), CMP_HIDDEN ** -0.5),
        'cmp_k_b2': _normal(next(ks), (L, HEAD_DIM), 0.02),
        'cmp_v_pos': _normal(next(ks), (L, CMP_BLK, HEAD_DIM), 0.1),
        'cmp_v_w1': _normal(next(ks), (L, CMP_BLK, HEAD_DIM, CMP_HIDDEN), (CMP_BLK * HEAD_DIM) ** -0.5),
        'cmp_v_b1': _normal(next(ks), (L, CMP_HIDDEN), 0.02),
        'cmp_v_w2': _normal(next(ks), (L, CMP_HIDDEN, HEAD_DIM), CMP_HIDDEN ** -0.5),
        'cmp_v_b2': _normal(next(ks), (L, HEAD_DIM), 0.02),
        'pool_w': _normal(next(ks), (L, N_POOL_GROUPS, POOL_GC, POOL_GC), POOL_GC ** -0.5),
        'pool_scale': gain(next(ks), POOL_WIDTH),
        'w_out': _normal(next(ks), (L, MIX_WIDTH, D_MODEL), MIX_WIDTH ** -0.5),
        'norm2_g': gain(next(ks), D_MODEL),
        'w_router': _normal(next(ks), (L, D_MODEL, N_EXPERTS), D_MODEL ** -0.5),
        'b_router': _normal(next(ks), (L, N_EXPERTS), 0.01),
        'w_gate_up': _normal(next(ks), (L, N_EXPERTS, D_MODEL, 2 * D_FF), D_MODEL ** -0.5),
        'b_gate_up': _normal(next(ks), (L, N_EXPERTS, 2 * D_FF), 0.01),
        'w_down': _normal(next(ks), (L, N_EXPERTS, D_FF, D_MODEL), D_FF ** -0.5),
        'b_down': _normal(next(ks), (L, N_EXPERTS, D_MODEL), 0.01),
    }


def reference(x, norm1_g, w_in, q_norm_g, k_norm_cmp_g, k_norm_slc_g, k_norm_win_g,
              cmp_k_pos, cmp_k_w1, cmp_k_b1, cmp_k_w2, cmp_k_b2,
              cmp_v_pos, cmp_v_w1, cmp_v_b1, cmp_v_w2, cmp_v_b2,
              pool_w, pool_scale, w_out, norm2_g,
              w_router, b_router, w_gate_up, b_gate_up, w_down, b_down):
    layer_params = (norm1_g, w_in, q_norm_g, k_norm_cmp_g, k_norm_slc_g, k_norm_win_g,
                    cmp_k_pos, cmp_k_w1, cmp_k_b1, cmp_k_w2, cmp_k_b2,
                    cmp_v_pos, cmp_v_w1, cmp_v_b1, cmp_v_w2, cmp_v_b2,
                    pool_w, pool_scale, w_out, norm2_g,
                    w_router, b_router, w_gate_up, b_gate_up, w_down, b_down)
    for l in range(DEPTH):
        x = hybrid_layer(x, *[p[l] for p in layer_params])
    return x
```

```cpp
#include <hip/hip_runtime.h>
#include <cstdio>
#include <cstdint>

#define LAS __attribute__((address_space(3)))
#define GAS __attribute__((address_space(1)))
typedef unsigned short bf16_t;
typedef short bf16x8 __attribute__((ext_vector_type(8)));
typedef short s16x4 __attribute__((ext_vector_type(4)));
typedef float f32x4 __attribute__((ext_vector_type(4)));
typedef float f32x2 __attribute__((ext_vector_type(2)));
typedef float f32x16 __attribute__((ext_vector_type(16)));
typedef unsigned u32x4 __attribute__((ext_vector_type(4)));
typedef unsigned u32x2 __attribute__((ext_vector_type(2)));
typedef int i32x4 __attribute__((ext_vector_type(4)));
typedef int i32x8 __attribute__((ext_vector_type(8)));

constexpr int NB = 2, SEQ = 8192, NTOK = NB * SEQ, DM = 2048, NHEAD = 8, HD = 128, NGRP = 2, NEXP = 32, DFF = 2048;
constexpr int NINP = 3840;
constexpr int NCMP = 512;
constexpr int ACT_ROWS = 4 * NTOK + NEXP * 256;
constexpr int NWAVES = 8;

constexpr size_t MiB = 1u << 20;
constexpr size_t WS_CTL = 0, CTL_ZERO_BYTES = 1 * MiB;
constexpr size_t WS_COS = 1 * MiB, WS_SIN = 2 * MiB;
constexpr size_t WS_POSB64 = 2 * MiB + 655360;
constexpr size_t WS_POSB = 3 * MiB;
constexpr size_t WS_W2T = 3 * MiB + 65536;
constexpr size_t WS_WINT = 4 * MiB;
constexpr size_t WS_WOUTT = 20 * MiB;
constexpr size_t WS_W1T = 28 * MiB;
constexpr size_t WS_PWT = 32 * MiB;
constexpr size_t WS_H = 34 * MiB;
constexpr size_t WS_Q = 98 * MiB;
constexpr size_t WS_KV = 130 * MiB, KV_STRIDE = 9 * MiB;
constexpr size_t WS_PIN = 184 * MiB;
constexpr size_t WS_DP = 216 * MiB;
constexpr size_t WS_GLOG = 248 * MiB;
constexpr size_t WS_HID = 250 * MiB;
constexpr size_t WS_CMP = 252 * MiB;
constexpr size_t WS_MIX = 254 * MiB;
constexpr size_t WS_ASCR = 318 * MiB;
constexpr size_t WS_H2 = 350 * MiB;
constexpr size_t WS_SLOT = 414 * MiB;
constexpr size_t WS_TOKL = 415 * MiB;
constexpr size_t WS_WL = 417 * MiB;
constexpr size_t WS_ACT = 420 * MiB;
constexpr size_t WS_YBUF = 708 * MiB;
constexpr size_t WS_WGU = 1024 * MiB;
constexpr size_t WS_WD = 1536 * MiB;
constexpr size_t WS_END = 1792 * MiB;

constexpr int CW_BAR = 4096;
constexpr int CW_CNT = 8192;
constexpr int CW_ERR = 12288;
#ifndef ATT_CHECK
#define ATT_CHECK 0
#endif

constexpr int RING_BYTES = 131072;
constexpr int LTAB_OFF = 133120;
constexpr int SIDE_OFF = LTAB_OFF + 2048, SIDE_BYTES = 4096;
constexpr int MISC_OFF = LTAB_OFF + 24576;
constexpr int LDS_BYTES = MISC_OFF + 256;

#define RLX_AGENT __ATOMIC_RELAXED, __HIP_MEMORY_SCOPE_AGENT
#define LDS_WAIT() asm volatile("s_waitcnt lgkmcnt(0)" ::: "memory")
#define VM_WAIT() asm volatile("s_waitcnt vmcnt(0)" ::: "memory")
__device__ __forceinline__ unsigned cvt_pk_bf16(float lo, float hi) { unsigned r; asm volatile("v_cvt_pk_bf16_f32 %0, %1, %2" : "=v"(r) : "v"(lo), "v"(hi)); return r; }
__device__ __forceinline__ unsigned cvt_pk_bf16_mfma(float lo, float hi) { unsigned r; asm volatile("v_cvt_pk_bf16_f32 %0, %1, %2\n\ts_nop 1" : "=v"(r) : "v"(lo), "v"(hi)); return r; }
__device__ __forceinline__ float bf_lo(unsigned u) { return __uint_as_float(u << 16); }
__device__ __forceinline__ float bf_hi(unsigned u) { return __uint_as_float(u & 0xffff0000u); }
__device__ __forceinline__ float fast_exp2(float x) { return __builtin_amdgcn_exp2f(x); }
__device__ __forceinline__ float fast_rcp(float x) { return __builtin_amdgcn_rcpf(x); }
__device__ __forceinline__ float sigmoidf_(float x) { return fast_rcp(1.0f + fast_exp2(-1.4426950408889634f * x)); }
__device__ __forceinline__ float wave_sum(float v) {
#define WS_STEP(ctrl, rmask) v += __int_as_float(__builtin_amdgcn_update_dpp(0, __float_as_int(v), ctrl, rmask, 0xf, false))
    WS_STEP(0x111, 0xf); WS_STEP(0x112, 0xf); WS_STEP(0x114, 0xf); WS_STEP(0x118, 0xf); WS_STEP(0x142, 0xa); WS_STEP(0x143, 0xc);
#undef WS_STEP
    return __int_as_float(__builtin_amdgcn_readlane(__float_as_int(v), 63));
}
__device__ __forceinline__ int fresh_lane() { int l; asm volatile("v_mbcnt_lo_u32_b32 %0, -1, 0\n\tv_mbcnt_hi_u32_b32 %0, -1, %0" : "=v"(l)); return l; }

#define XB_TMO      128
#define XB_XCNT(j)  (256  + 64 * (j))
#define XB_XSUB(j)  (1280 + 64 * (j))
#define XB_XGEN(j)  (2304 + 64 * (j))
#define XB_TOP      3328
#define XB_TOPGEN   3392
#define XCD_BAR_WORDS 3456
#define XB_SPIN_CAP (1u << 20)
__device__ __forceinline__ unsigned xb_ld(unsigned* p)              { return __hip_atomic_load(p, __ATOMIC_RELAXED, __HIP_MEMORY_SCOPE_AGENT); }
__device__ __forceinline__ unsigned xb_add(unsigned* p, unsigned v) { return __hip_atomic_fetch_add(p, v, __ATOMIC_RELAXED, __HIP_MEMORY_SCOPE_AGENT); }
__device__ __forceinline__ unsigned xb_xcc_id() { return (unsigned)__builtin_amdgcn_s_getreg((3 << 11) | 20) & 0xFu; }
#define XB_SPIN(cond, bar) do { unsigned _sp = 0; while (cond) { __builtin_amdgcn_s_sleep(1); \
    if ((++_sp & 255u) == 0u) { if (xb_ld(&(bar)[XB_TMO])) break; if (_sp > XB_SPIN_CAP) { atomicAdd(&(bar)[XB_TMO], 1u); break; } } } } while (0)
struct XcdBarrier { unsigned* bar; unsigned x; volatile LAS unsigned* st; };
__device__ __forceinline__ XcdBarrier xcd_barrier_post(unsigned* bar, volatile LAS unsigned* st, bool t0) {
    XcdBarrier b; b.bar = bar; b.x = xb_xcc_id(); b.st = st;
    if (t0) (void)xb_add(&bar[XB_XCNT(b.x)], 1u);
    return b;
}
__device__ __forceinline__ void xcd_barrier_complete(unsigned* bar, unsigned x, unsigned& nloc, unsigned& nx) {
    const unsigned G = gridDim.x * gridDim.y * gridDim.z;
    unsigned sum, cnt, mine, sp = 0u;
    for (;;) {
        sum = 0u; cnt = 0u; mine = 0u;
#pragma unroll
        for (unsigned j = 0; j < 16; ++j) { const unsigned c = xb_ld(&bar[XB_XCNT(j)]); sum += c; cnt += (c > 0u) ? 1u : 0u; mine = (j == x) ? c : mine; }
        if (sum == G) break;
        __builtin_amdgcn_s_sleep(1);
        if ((++sp & 255u) == 0u) { if (xb_ld(&bar[XB_TMO])) break; if (sp > XB_SPIN_CAP) { atomicAdd(&bar[XB_TMO], 1u); break; } }
    }
    nloc = mine > 0u ? mine : 1u; nx = cnt > 0u ? cnt : 1u;
}
__device__ __forceinline__ void xcd_barrier(const XcdBarrier& b, bool t0) {
    asm volatile("s_waitcnt vmcnt(0)" ::: "memory");
    __syncthreads();
    if (t0) {
        unsigned* bar = b.bar;
        __builtin_amdgcn_s_waitcnt(0);
        unsigned nloc = b.st[0], nx = b.st[1];
        if (nloc == 0u) { xcd_barrier_complete(bar, b.x, nloc, nx); b.st[0] = nloc; b.st[1] = nx; }
        const unsigned old = xb_add(&bar[XB_XSUB(b.x)], 1u);
        const unsigned gen = old / nloc;
        if (old + 1u == (gen + 1u) * nloc) {
            __builtin_amdgcn_fence(__ATOMIC_RELEASE, "agent");
            asm volatile("s_waitcnt vmcnt(0)" ::: "memory");
            const unsigned og = xb_add(&bar[XB_TOP], 1u);
            const unsigned tg = og / nx;
            if (og + 1u == (tg + 1u) * nx) xb_add(&bar[XB_TOPGEN], 1u);
            else XB_SPIN(xb_ld(&bar[XB_TOPGEN]) == tg, bar);
            __builtin_amdgcn_fence(__ATOMIC_ACQUIRE, "agent");
            xb_add(&bar[XB_XGEN(b.x)], 1u);
            asm volatile("s_waitcnt vmcnt(0)" ::: "memory");
        } else {
            XB_SPIN(xb_ld(&bar[XB_XGEN(b.x)]) == gen, bar);
            __builtin_amdgcn_fence(__ATOMIC_ACQUIRE, "agent");
            asm volatile("s_waitcnt vmcnt(0)" ::: "memory");
        }
    }
    __syncthreads();
}

struct Args {
    const float* in[27];
    float* out;
    unsigned char* ws;
    int ph_lo, ph_hi;
    int use_bar, pad;
};
enum { I_X = 0, I_N1G, I_WIN, I_QNG, I_KNC, I_KNS, I_KNW, I_CKPOS, I_CKW1, I_CKB1, I_CKW2, I_CKB2, I_CVPOS, I_CVW1, I_CVB1, I_CVW2, I_CVB2,
       I_POOLW, I_POOLS, I_WOUT, I_N2G, I_WR, I_BR, I_WGU, I_BGU, I_WD, I_BD };

#ifndef EPI_DBL_MASK
#define EPI_DBL_MASK 0
#endif
namespace pg8 {
constexpr int BM = 256, BK = 64, HALF = 128, HTB = HALF * BK * 2, STAGE_BYTES = 8 * HTB, NXCD = 8, WGM = 8;
__host__ __device__ __forceinline__ int lds_byte(int r, int c) { const int st = (r >> 4) * 2 + (c >> 5), rr = r & 15, cc = c & 31, ob = rr * 64 + cc * 2; return st * 1024 + (ob ^ (((ob >> 9) & 1) << 5)); }
__host__ __device__ __forceinline__ void stage_rc(int b, int& R, int& C) { const int st = b / 1024, sb = b % 1024, swz = sb ^ (((sb >> 9) & 1) << 5); R = (st >> 1) * 16 + swz / 64; C = (st & 1) * 32 + (swz % 64) / 2; }
__host__ __device__ __forceinline__ int perm32(int rho) { const int n = rho >> 4, i = rho & 15; return 8 * (i >> 2) + 4 * n + (i & 3); }

template <class Epi, class Sched>
__device__ __forceinline__ void gemm_phase(LAS unsigned char* lds, const Sched& S, const Epi& E, const int Kb  , const int wid, const int ntiles = 0  ) {
    const int lane = fresh_lane(), tid = wid * 64 + lane, wr = wid >> 2, wc = wid & 3, fr = lane & 15, fq = lane >> 4;
    const int nt = ntiles ? ntiles : Kb / 128;
    constexpr int BR = Sched::B_K16;
    int Rr[2], Cc[2]; unsigned voffB[2];
#pragma unroll
    for (int i = 0; i < 2; ++i) { int R, C; stage_rc(tid * 16 + i * 8192, R, C); Rr[i] = R; Cc[i] = C; const int Rb = Epi::PERM ? ((R & ~31) + perm32(R & 31)) : R; voffB[i] = BR ? (unsigned)(((C >> 3) * BR + Rb) * 16) : (unsigned)(Rb * Kb) + (unsigned)C * 2u; }
    const size_t kstep = (size_t)(BK * 2);
    const size_t kstepB = BR ? (size_t)8 * BR * 16 : kstep;
    const size_t hstepB = BR ? (size_t)HALF * 16 : (size_t)HALF * Kb;
    const unsigned ldsw = (unsigned)wid * 1024u;
    const int aoff = lds_byte(wr * 64 + fr, fq * 8), boff = lds_byte(wc * 32 + fr, fq * 8);
    const char* const Ab = S.a_base();
#define PG8_SA(b, h) (((b) * 2 + (h)) * HTB)
#define PG8_SB(b, h) ((4 + (b) * 2 + (h)) * HTB)
#define PG8_STAGE(bufoff, gbase, voff) do { _Pragma("unroll") for (int _i = 0; _i < 2; ++_i) \
        __builtin_amdgcn_global_load_lds((const unsigned*)((const char*)(gbase) + (voff)[_i]), (LAS unsigned*)(lds + (bufoff) + ldsw + _i * 8192), 16, 0, 0); } while (0)
#define PG8_LDA(dst, b, h) do { _Pragma("unroll") for (int m = 0; m < 4; ++m) _Pragma("unroll") for (int k = 0; k < 2; ++k) dst[m][k] = *(const LAS bf16x8*)(lds + PG8_SA(b, h) + aoff + m * 2048 + k * 1024); } while (0)
#define PG8_LDB(dst, b, h) do { _Pragma("unroll") for (int n = 0; n < 2; ++n) _Pragma("unroll") for (int k = 0; k < 2; ++k) dst[n][k] = *(const LAS bf16x8*)(lds + PG8_SB(b, h) + boff + n * 2048 + k * 1024); } while (0)
#define PG8_MMA(ai, bj, At, Bt) do { __builtin_amdgcn_s_setprio(1); \
        if constexpr (Epi::FP8) { _Pragma("unroll") for (int m = 0; m < 4; ++m) _Pragma("unroll") for (int n = 0; n < 2; ++n) { \
            const i32x8 _b = __builtin_shufflevector(__builtin_bit_cast(i32x4, Bt[n][0]), __builtin_bit_cast(i32x4, Bt[n][1]), 0, 1, 2, 3, 4, 5, 6, 7); \
            const i32x8 _a = __builtin_shufflevector(__builtin_bit_cast(i32x4, At[m][0]), __builtin_bit_cast(i32x4, At[m][1]), 0, 1, 2, 3, 4, 5, 6, 7); \
            acc[ai][bj][m][n] = __builtin_amdgcn_mfma_scale_f32_16x16x128_f8f6f4(_b, _a, acc[ai][bj][m][n], 0, 0, 0, 0x7f7f7f7f, 0, 0x7f7f7f7f); } } \
        else { _Pragma("unroll") for (int m = 0; m < 4; ++m) _Pragma("unroll") for (int n = 0; n < 2; ++n) _Pragma("unroll") for (int k = 0; k < 2; ++k) \
            acc[ai][bj][m][n] = __builtin_amdgcn_mfma_f32_16x16x32_bf16(Bt[n][k], At[m][k], acc[ai][bj][m][n], 0, 0, 0); } \
        __builtin_amdgcn_s_setprio(0); } while (0)
#define PG8_WAIT_V(n) asm volatile("s_waitcnt vmcnt(" #n ")" ::: "memory")
#define PG8_WAIT_L(n) asm volatile("s_waitcnt lgkmcnt(" #n ")" ::: "memory")
#define PG8_BAR __builtin_amdgcn_s_barrier()
#define PG8_SCHED __builtin_amdgcn_sched_barrier(0)
    typename Sched::Unit cur, nxt; int ui = 0;
    if (!S.next(0, cur)) return;
    f32x4 acc[2][2][4][2];
#pragma unroll
    for (int a = 0; a < 2; ++a)
#pragma unroll
        for (int b = 0; b < 2; ++b)
#pragma unroll
            for (int m = 0; m < 4; ++m)
#pragma unroll
                for (int n = 0; n < 2; ++n) acc[a][b][m][n] = (f32x4){0.f, 0.f, 0.f, 0.f};
    bf16x8 At[4][2], B0[2][2], B1[2][2];
    unsigned offA0[2], offA1[2], nofA0[2], nofA1[2];
#pragma unroll
    for (int i = 0; i < 2; ++i) { offA0[i] = S.a_off(cur, Rr[i], Cc[i]); offA1[i] = S.a_off(cur, HALF + Rr[i], Cc[i]); nofA0[i] = offA0[i]; nofA1[i] = offA1[i]; }
    const char* cB = S.b_ptr(cur);
    PG8_STAGE(PG8_SB(0, 0), cB, voffB); PG8_STAGE(PG8_SA(0, 0), Ab, offA0); PG8_STAGE(PG8_SB(0, 1), cB + hstepB, voffB); PG8_STAGE(PG8_SA(0, 1), Ab, offA1);
    if (wr == 1) PG8_BAR;
    PG8_WAIT_V(4); PG8_BAR;
    PG8_STAGE(PG8_SB(1, 0), cB + kstepB, voffB); PG8_STAGE(PG8_SA(1, 0), Ab + kstep, offA0); PG8_STAGE(PG8_SB(1, 1), cB + hstepB + kstepB, voffB);
    PG8_WAIT_V(6); PG8_BAR;
    for (;;) {
        const bool has_next = S.next(ui + 1, nxt);
        const char* nB = has_next ? S.b_ptr(nxt) : cB;
        if (has_next) {
            if constexpr (Sched::SIDE_IDX) S.stage_idx(lds, nxt, (ui + 1) & 1, wid, lane);
            else {
#pragma unroll
                for (int i = 0; i < 2; ++i) { nofA0[i] = S.a_off(nxt, Rr[i], Cc[i]); nofA1[i] = S.a_off(nxt, HALF + Rr[i], Cc[i]); }
            }
        }
        E.stage(lds, cur, ui & 1, wid, lane);
        for (int t = 0; t < nt; t += 2) {
            const bool last = (t == nt - 2);
            const char* a1 = Ab + (size_t)(t + 1) * kstep;
            PG8_LDB(B0, 0, 0); PG8_SCHED; PG8_LDA(At, 0, 0); PG8_STAGE(PG8_SA(1, 1), a1, offA1);
            if (last) {
                if constexpr (Sched::SIDE_IDX) { if (has_next) {
#pragma unroll
                    for (int i = 0; i < 2; ++i) { nofA0[i] = S.a_off_lds(lds, nxt, (ui + 1) & 1, Rr[i], Cc[i]); nofA1[i] = S.a_off_lds(lds, nxt, (ui + 1) & 1, HALF + Rr[i], Cc[i]); } } }
#pragma unroll
                for (int i = 0; i < 2; ++i) { offA0[i] = nofA0[i]; offA1[i] = nofA1[i]; }
            }
            const char* a2 = last ? Ab : Ab + (size_t)(t + 2) * kstep; const char* b2 = last ? nB : cB + (size_t)(t + 2) * kstepB;
            const char* a3 = a2 + kstep; const char* b3 = b2 + kstepB;
            PG8_WAIT_L(8); PG8_BAR; PG8_WAIT_L(0); PG8_MMA(0, 0, At, B0); PG8_BAR; PG8_SCHED;
            PG8_LDB(B1, 0, 1); PG8_STAGE(PG8_SB(0, 0), b2, voffB);
            PG8_BAR; PG8_WAIT_L(0); PG8_MMA(0, 1, At, B1); PG8_BAR;
            PG8_LDA(At, 0, 1); PG8_STAGE(PG8_SA(0, 0), a2, offA0);
            PG8_BAR; PG8_WAIT_L(0); PG8_MMA(1, 0, At, B0); PG8_BAR; PG8_SCHED;
            PG8_STAGE(PG8_SB(0, 1), b2 + hstepB, voffB);
            PG8_WAIT_V(6); PG8_BAR; PG8_MMA(1, 1, At, B1); PG8_BAR;
            PG8_LDB(B0, 1, 0); PG8_SCHED; PG8_LDA(At, 1, 0); PG8_STAGE(PG8_SA(0, 1), a2, offA1);
            PG8_WAIT_L(8); PG8_BAR; PG8_WAIT_L(0); PG8_MMA(0, 0, At, B0); PG8_BAR; PG8_SCHED;
            PG8_LDB(B1, 1, 1); PG8_STAGE(PG8_SB(1, 0), b3, voffB);
            PG8_BAR; PG8_WAIT_L(0); PG8_MMA(0, 1, At, B1); PG8_BAR;
            PG8_LDA(At, 1, 1); PG8_STAGE(PG8_SA(1, 0), a3, offA0);
            PG8_BAR; PG8_WAIT_L(0); PG8_MMA(1, 0, At, B0); PG8_BAR; PG8_SCHED;
            PG8_STAGE(PG8_SB(1, 1), b3 + hstepB, voffB);
            PG8_WAIT_V(6); PG8_BAR; PG8_MMA(1, 1, At, B1); PG8_BAR;
        }
        E(acc, cur, wr, wc, fr, fq, lds, ui & 1);
        if constexpr ((EPI_DBL_MASK & Epi::ID) != 0) E(acc, cur, wr, wc, fr, fq, lds, ui & 1);
        if (!has_next) break;
#pragma unroll
        for (int a = 0; a < 2; ++a)
#pragma unroll
            for (int b = 0; b < 2; ++b)
#pragma unroll
                for (int m = 0; m < 4; ++m)
#pragma unroll
                    for (int n = 0; n < 2; ++n) acc[a][b][m][n] = (f32x4){0.f, 0.f, 0.f, 0.f};
        cur = nxt; cB = nB; ++ui;
    }
    PG8_WAIT_V(0);
    if (wr == 0) PG8_BAR;
    PG8_BAR;
#undef PG8_SA
#undef PG8_SB
#undef PG8_STAGE
#undef PG8_LDA
#undef PG8_LDB
#undef PG8_MMA
#undef PG8_WAIT_V
#undef PG8_WAIT_L
#undef PG8_BAR
#undef PG8_SCHED
}

struct DUnit { int pm, pn; };
struct DenseSched {
    typedef DUnit Unit; static constexpr bool SIDE_IDX = false; static constexpr int B_K16 = 0;
    const char* A; unsigned lda2; const char* Bt; int K; int nM, nN, nwg, G, c;
    __device__ __forceinline__ void init(const void* A_, int lda, const void* Bt_, int M, int N, int K_, int G_, int c_) { A = (const char*)A_; lda2 = (unsigned)lda * 2u; Bt = (const char*)Bt_; K = K_; nM = M / BM; nN = N / BM; nwg = nM * nN; G = G_; c = c_; }
    __device__ __forceinline__ bool next(int i, Unit& u) const {
        const long L = (long)i * G + c; if (L >= nwg) return false;
        int wgid = (int)L; { const int q = nwg / NXCD, r = nwg % NXCD, xcd = wgid % NXCD, off = wgid / NXCD; wgid = (xcd < r ? xcd * (q + 1) : r * (q + 1) + (xcd - r) * q) + off; }
        const int nig = WGM * nN, gid = wgid / nig, fm = gid * WGM, gsz = (nM - fm) < WGM ? (nM - fm) : WGM;
        u.pm = fm + ((wgid % nig) % gsz); u.pn = (wgid % nig) / gsz; return true;
    }
    __device__ __forceinline__ const char* a_base() const { return A; }
    __device__ __forceinline__ unsigned a_off(const Unit& u, int r, int C) const { return (unsigned)(u.pm * BM + r) * lda2 + (unsigned)C * 2u; }
    __device__ __forceinline__ const char* b_ptr(const Unit& u) const { return Bt + (size_t)u.pn * BM * K * 2; }
};
}

namespace epi {
using pg8::BM; using pg8::HALF;
struct InProj {
    __device__ __forceinline__ void stage(LAS unsigned char*, const pg8::DUnit&, int, int, int) const {}
    static constexpr bool PERM = true; static constexpr int ID = 1; static constexpr bool FP8 = false;
    bf16_t* Q; bf16_t* KV; bf16_t* PIN; float* GLOG;
    __device__ __forceinline__ void operator()(const f32x4 (&acc)[2][2][4][2], const pg8::DUnit& u, int wr, int wc, int fr, int fq, LAS unsigned char*, int) const {
        const int row0 = u.pm * BM + wr * 64 + fr, cw = wc * 32 + 8 * fq;
#pragma unroll
        for (int ai = 0; ai < 2; ++ai)
#pragma unroll
            for (int m = 0; m < 4; ++m) {
                const int row = row0 + ai * HALF + m * 16;
#pragma unroll
                for (int bj = 0; bj < 2; ++bj) {
                    const f32x4 v0 = acc[ai][bj][m][0], v1 = acc[ai][bj][m][1];
                    if (u.pn == 14) {
                        if (bj == 0 && cw < 24) { float* g = GLOG + (size_t)row * 32 + cw; *(f32x4*)g = v0; *(f32x4*)(g + 4) = v1; }
                    } else {
                        u32x4 w; w.x = cvt_pk_bf16(v0[0], v0[1]); w.y = cvt_pk_bf16(v0[2], v0[3]); w.z = cvt_pk_bf16(v1[0], v1[1]); w.w = cvt_pk_bf16(v1[2], v1[3]);
                        bf16_t* dst;
                        if (u.pn < 4) dst = Q + (size_t)row * 1024 + u.pn * 256 + bj * 128 + cw;
                        else if (u.pn < 10) { const int b = row >> 13, s = row & 8191; dst = KV + (size_t)(u.pn - 4) * (KV_STRIDE / 2) + ((size_t)((b * 2 + bj) * SEQ + s)) * 128 + cw; }
                        else dst = PIN + (size_t)row * 1024 + (u.pn - 10) * 256 + bj * 128 + cw;
                        *(u32x4*)dst = w;
                    }
                }
            }
    }
};
struct CUnit { int kv, pm, ks; };
struct CmpHid {
    __device__ __forceinline__ void stage(LAS unsigned char*, const CUnit&, int, int, int) const {}
    static constexpr bool PERM = false; static constexpr int ID = 2; static constexpr bool FP8 = false;
    float* HIDP;
    __device__ __forceinline__ void operator()(const f32x4 (&acc)[2][2][4][2], const CUnit& u, int wr, int wc, int fr, int fq, LAS unsigned char*, int) const {
        const int row0 = u.pm * BM + wr * 64 + fr, col0 = wc * 32 + 4 * fq;
        float* base = HIDP + ((size_t)(u.ks * 2 + u.kv) * 2048) * 256;
#pragma unroll
        for (int ai = 0; ai < 2; ++ai)
#pragma unroll
            for (int m = 0; m < 4; ++m) { float* rowp = base + (size_t)(row0 + ai * HALF + m * 16) * 256 + col0;
#pragma unroll
                for (int bj = 0; bj < 2; ++bj)
#pragma unroll
                    for (int n = 0; n < 2; ++n) *(f32x4*)(rowp + bj * HALF + n * 16) = acc[ai][bj][m][n]; }
    }
};
struct PUnit { int g, pm; };
struct Pool {
    __device__ __forceinline__ void stage(LAS unsigned char*, const PUnit&, int, int, int) const {}
    static constexpr bool PERM = true; static constexpr int ID = 4; static constexpr bool FP8 = false;
    bf16_t* MIX; const float* scale;
    __device__ __forceinline__ void operator()(const f32x4 (&acc)[2][2][4][2], const PUnit& u, int wr, int wc, int fr, int fq, LAS unsigned char*, int) const {
        const int row0 = u.pm * BM + wr * 64 + fr, cw = wc * 32 + 8 * fq;
        float sc[2][8];
#pragma unroll
        for (int bj = 0; bj < 2; ++bj)
#pragma unroll
            for (int j = 0; j < 8; ++j) sc[bj][j] = scale[u.g * 256 + bj * 128 + cw + j];
#pragma unroll
        for (int ai = 0; ai < 2; ++ai)
#pragma unroll
            for (int m = 0; m < 4; ++m) {
                const int row = row0 + ai * HALF + m * 16;
#pragma unroll
                for (int bj = 0; bj < 2; ++bj) {
                    float v[8];
#pragma unroll
                    for (int j = 0; j < 8; ++j) v[j] = acc[ai][bj][m][j >> 2][j & 3] * sc[bj][j];
                    u32x4 w; w.x = cvt_pk_bf16(v[0], v[1]); w.y = cvt_pk_bf16(v[2], v[3]); w.z = cvt_pk_bf16(v[4], v[5]); w.w = cvt_pk_bf16(v[6], v[7]);
                    *(u32x4*)(MIX + (size_t)row * 2048 + 1024 + u.g * 256 + bj * 128 + cw) = w;
                }
            }
    }
};
struct OutProj {
    __device__ __forceinline__ void stage(LAS unsigned char*, const pg8::DUnit&, int, int, int) const {}
    static constexpr bool PERM = true; static constexpr int ID = 8; static constexpr bool FP8 = false;
    bf16_t* ATT;
    __device__ __forceinline__ void operator()(const f32x4 (&acc)[2][2][4][2], const pg8::DUnit& u, int wr, int wc, int fr, int fq, LAS unsigned char*, int) const {
        const int row0 = u.pm * BM + wr * 64 + fr, cw = u.pn * BM + wc * 32 + 8 * fq;
#pragma unroll
        for (int ai = 0; ai < 2; ++ai)
#pragma unroll
            for (int m = 0; m < 4; ++m) { bf16_t* rowp = ATT + (size_t)(row0 + ai * HALF + m * 16) * DM + cw;
#pragma unroll
                for (int bj = 0; bj < 2; ++bj) { const f32x4 v0 = acc[ai][bj][m][0], v1 = acc[ai][bj][m][1];
                    u32x4 w; w.x = cvt_pk_bf16(v0[0], v0[1]); w.y = cvt_pk_bf16(v0[2], v0[3]); w.z = cvt_pk_bf16(v1[0], v1[1]); w.w = cvt_pk_bf16(v1[2], v1[3]);
                    *(u32x4*)(rowp + bj * HALF) = w; } }
    }
};
struct MUnit { int e, pm, pn, rowbase, cnt; };
constexpr float W8_SCALE = 64.0f, W8_INV = 1.0f / 64.0f;
struct GateUp {
    static constexpr bool PERM = true; static constexpr int ID = 16; static constexpr bool FP8 = true;
    unsigned char* ACT; const float* bgu;
    __device__ __forceinline__ void stage(LAS unsigned char* lds, const MUnit& u, int par, int wid, int lane) const {
        if (wid < 4) { const float* src = bgu + (size_t)u.e * 4096 + (wid >> 1) * 2048 + u.pn * 128 + (wid & 1) * 64 + lane;
            __builtin_amdgcn_global_load_lds((const unsigned*)src, (LAS unsigned*)(lds + SIDE_OFF + par * SIDE_BYTES + 1024 + wid * 256), 4, 0, 0); }
    }
    __device__ __forceinline__ void operator()(const f32x4 (&acc)[2][2][4][2], const MUnit& u, int wr, int wc, int fr, int fq, LAS unsigned char* lds, int par) const {
        const int row0 = u.rowbase + wr * 64 + fr, cw = wc * 32 + 8 * fq, j0 = u.pn * 128 + cw;
        float bg[8], bu[8];
        { const LAS f32x4* sb = (const LAS f32x4*)(lds + SIDE_OFF + par * SIDE_BYTES + 1024);
          const f32x4 g0 = sb[cw >> 2], g1 = sb[(cw >> 2) + 1], u0 = sb[32 + (cw >> 2)], u1 = sb[33 + (cw >> 2)];
#pragma unroll
          for (int j = 0; j < 4; ++j) { bg[j] = g0[j]; bg[4 + j] = g1[j]; bu[j] = u0[j]; bu[4 + j] = u1[j]; } }
#pragma unroll
        for (int ai = 0; ai < 2; ++ai)
#pragma unroll
            for (int m = 0; m < 4; ++m) {
                const int row = row0 + ai * HALF + m * 16;
                float v[8];
#pragma unroll
                for (int j = 0; j < 8; ++j) {
                    float g = fmaf(acc[ai][0][m][j >> 2][j & 3], W8_INV, bg[j]), up = fmaf(acc[ai][1][m][j >> 2][j & 3], W8_INV, bu[j]);
                    g = fminf(g, 7.0f); up = fminf(fmaxf(up, -7.0f), 7.0f);
                    v[j] = (up + 1.0f) * g * fast_rcp(1.0f + fast_exp2(-2.4554669595930157f * g));
                }
                u32x2 w; int p = __builtin_amdgcn_cvt_pk_fp8_f32(v[0], v[1], 0, false); p = __builtin_amdgcn_cvt_pk_fp8_f32(v[2], v[3], p, true); w.x = (unsigned)p;
                p = __builtin_amdgcn_cvt_pk_fp8_f32(v[4], v[5], 0, false); p = __builtin_amdgcn_cvt_pk_fp8_f32(v[6], v[7], p, true); w.y = (unsigned)p;
                *(u32x2*)(ACT + (size_t)row * 2048 + j0) = w;
            }
    }
};
struct Down {
    static constexpr bool PERM = true; static constexpr int ID = 32; static constexpr bool FP8 = true;
    bf16_t* YBUF; const float* bd; const float* WL;
    __device__ __forceinline__ void stage(LAS unsigned char* lds, const MUnit& u, int par, int wid, int lane) const {
        const float* src = wid < 4 ? bd + (size_t)u.e * 2048 + u.pn * 256 + wid * 64 + lane : WL + (size_t)u.e * NTOK + u.pm * 256 + (wid - 4) * 64 + lane;
        __builtin_amdgcn_global_load_lds((const unsigned*)src, (LAS unsigned*)(lds + SIDE_OFF + par * SIDE_BYTES + 1024 + wid * 256), 4, 0, 0);
    }
    __device__ __forceinline__ void operator()(const f32x4 (&acc)[2][2][4][2], const MUnit& u, int wr, int wc, int fr, int fq, LAS unsigned char* lds, int par) const {
        const int rl0 = wr * 64 + fr, cw = wc * 32 + 8 * fq;
        float bias[2][8];
        const LAS f32x4* sb = (const LAS f32x4*)(lds + SIDE_OFF + par * SIDE_BYTES + 1024);
        const LAS float* sw = (const LAS float*)(lds + SIDE_OFF + par * SIDE_BYTES + 2048);
#pragma unroll
        for (int bj = 0; bj < 2; ++bj) { const f32x4 b0 = sb[bj * 32 + (cw >> 2)], b1 = sb[bj * 32 + (cw >> 2) + 1];
#pragma unroll
            for (int j = 0; j < 4; ++j) { bias[bj][j] = b0[j]; bias[bj][4 + j] = b1[j]; } }
#pragma unroll
        for (int ai = 0; ai < 2; ++ai)
#pragma unroll
            for (int m = 0; m < 4; ++m) {
                const float wt = sw[rl0 + ai * HALF + m * 16];
                const size_t row = (size_t)(u.rowbase + rl0 + ai * HALF + m * 16);
#pragma unroll
                for (int bj = 0; bj < 2; ++bj) {
                    float v[8];
#pragma unroll
                    for (int j = 0; j < 8; ++j) v[j] = fmaf(acc[ai][bj][m][j >> 2][j & 3], W8_INV, bias[bj][j]) * wt;
                    u32x4 w; w.x = cvt_pk_bf16(v[0], v[1]); w.y = cvt_pk_bf16(v[2], v[3]); w.z = cvt_pk_bf16(v[4], v[5]); w.w = cvt_pk_bf16(v[6], v[7]);
                    *(u32x4*)(YBUF + row * 2048 + u.pn * 256 + bj * 128 + cw) = w;
                }
            }
    }
};
}

namespace pg8 {
struct CmpSched {
    typedef epi::CUnit Unit; static constexpr bool SIDE_IDX = false; static constexpr int B_K16 = 0;
    const char* A; const char* Bt; int G, c;
    __device__ __forceinline__ bool next(int i, Unit& u) const { const int L = i * G + c; if (L >= 64) return false; u.kv = L >> 5; u.pm = (L >> 2) & 7; u.ks = L & 3; return true; }
    __device__ __forceinline__ const char* a_base() const { return A; }
    __device__ __forceinline__ unsigned a_off(const Unit& u, int r, int C) const { return (unsigned)(u.kv * (int)KV_STRIDE) + (unsigned)(u.pm * BM + r) * 4096u + (unsigned)u.ks * 2048u + (unsigned)C * 2u; }
    __device__ __forceinline__ const char* b_ptr(const Unit& u) const { return Bt + (size_t)u.kv * 256 * 4096 * 2 + (size_t)u.ks * 2048; }
};
struct PoolSched {
    typedef epi::PUnit Unit; static constexpr bool SIDE_IDX = false; static constexpr int B_K16 = 0;
    const char* A; const char* Bt; int G, c;
    __device__ __forceinline__ bool next(int i, Unit& u) const { const int L = i * G + c; if (L >= 256) return false; u.g = L >> 6; u.pm = L & 63; return true; }
    __device__ __forceinline__ const char* a_base() const { return A; }
    __device__ __forceinline__ unsigned a_off(const Unit& u, int r, int C) const { return (unsigned)(u.pm * BM + r) * 2048u + (unsigned)(u.g * 256 + C) * 2u; }
    __device__ __forceinline__ const char* b_ptr(const Unit& u) const { return Bt + (size_t)u.g * 256 * 256 * 2; }
};
template <int NTN, bool GATHER>
struct MoeSched {
    typedef epi::MUnit Unit; static constexpr bool SIDE_IDX = GATHER; static constexpr int B_K16 = NTN * 256;
    __device__ __forceinline__ void stage_idx(LAS unsigned char* lds, const Unit& u, int par, int wid, int lane) const {
        if (wid >= 4) __builtin_amdgcn_global_load_lds((const unsigned*)(tokl + (size_t)u.e * NTOK + u.pm * 256 + (wid - 4) * 64 + lane), (LAS unsigned*)(lds + SIDE_OFF + par * SIDE_BYTES + (wid - 4) * 256), 4, 0, 0);
    }
    __device__ __forceinline__ unsigned a_off_lds(LAS unsigned char* lds, const Unit& u, int par, int r, int C) const {
        const unsigned tok = ((const LAS unsigned*)(lds + SIDE_OFF + par * SIDE_BYTES))[r]; return (tok < (unsigned)NTOK ? tok : 0u) * 2048u + (unsigned)C * 2u;
    }
    const char* A; const char* Bt; const int* tokl; const LAS int* tb; const LAS int* cn; int G, c; size_t bstride;
    __device__ __forceinline__ bool next(int i, Unit& u) const {
        const int L = i * G + c, tile = L / NTN; if (tile >= tb[32]) return false;
        int e = -1;
        { const LAS i32x4* t4 = (const LAS i32x4*)tb;
#pragma unroll
          for (int k = 0; k < 8; ++k) { const i32x4 v = t4[k]; e += (v.x <= tile) + (v.y <= tile) + (v.z <= tile) + (v.w <= tile); } }
        u.e = e; u.pm = tile - tb[e]; u.pn = L % NTN; u.rowbase = tile * 256; u.cnt = cn[e]; return true;
    }
    __device__ __forceinline__ const char* a_base() const { return A; }
    __device__ __forceinline__ unsigned a_off(const Unit& u, int r, int C) const {
        if (GATHER) { int rl = u.pm * 256 + r; rl = rl < u.cnt ? rl : u.cnt - 1; const int tok = tokl[(size_t)u.e * NTOK + rl]; return (unsigned)tok * 2048u + (unsigned)C * 2u; }
        else return (unsigned)(u.rowbase + r) * 2048u + (unsigned)C * 2u;
    }
    __device__ __forceinline__ const char* b_ptr(const Unit& u) const { return Bt + (size_t)u.e * bstride + (size_t)u.pn * BM * 16; }
};
}

namespace att {
constexpr float SCALE = 0.08838834764831845f, CLOG = SCALE * 1.4426950408889634f;
constexpr float THR_RAW = 8.0f / SCALE;
constexpr int SHM_V = 16384, SHM_K = 16384;
constexpr int NKVB = 2;
constexpr int L_V = 0, L_K = NKVB * SHM_V, L_CV0 = NKVB * (SHM_V + SHM_K), L_WS = 98304, L_BS = L_WS + NWAVES * 64 * 4;
static_assert(L_CV0 + 32768 <= L_WS, "attention LDS");
constexpr int BS_STRIDE = 129;
constexpr int L_SEL = L_BS + 64 * BS_STRIDE * 4;
constexpr int L_UNI = L_SEL + 64 * 16;
constexpr int L_LIST = L_UNI + 32;
constexpr int L_END = L_LIST + 128 * 4;
static_assert(L_END <= MISC_OFF, "attention LDS");
#define KSWZ(row, colB) ((row) * 256 + ((colB) ^ (((row) & 7) << 4)))
#define SBAR() __builtin_amdgcn_sched_barrier(0)
__device__ __forceinline__ int crow(int r, int hi) { return (r & 3) + 8 * (r >> 2) + 4 * hi; }
__device__ __forceinline__ void qkt(f32x16& p0, f32x16& p1, const char* Ks, const bf16x8* qr, int r32, int hi) {
    p0 = f32x16{}; p1 = f32x16{};
#pragma unroll
    for (int d0 = 0; d0 < 8; ++d0) { const int cb = (d0 * 16 + hi * 8) * 2;
        const bf16x8 b0 = *reinterpret_cast<const bf16x8*>(Ks + KSWZ(r32, cb));
        const bf16x8 b1 = *reinterpret_cast<const bf16x8*>(Ks + KSWZ(32 + r32, cb));
        p0 = __builtin_amdgcn_mfma_f32_32x32x16_bf16(b0, qr[d0], p0, 0, 0, 0);
        p1 = __builtin_amdgcn_mfma_f32_32x32x16_bf16(b1, qr[d0], p1, 0, 0, 0); }
}
__device__ __forceinline__ int v_st(int k, int c) { const int kk = (k & ~0xC) | ((k & 4) << 1) | ((k & 8) >> 1); return ((kk >> 3) * 4 + (c >> 5)) * 512 + ((kk & 7) * 32 + (c & 31)) * 2; }
__device__ __forceinline__ int v_rd_base(int lane) { return ((lane & 3) << 3) | (((lane >> 2) & 3) << 6) | (((lane >> 4) & 1) << 5) | (((lane >> 5) & 1) << 8); }
constexpr int v_rd_off(int d0, int ks, int half) { return d0 * 512 + ks * 4096 + half * 2048; }
template <int OFF> __device__ __forceinline__ s16x4 tr_read(int vb) {
    s16x4 r; asm volatile("ds_read_b64_tr_b16 %0, %1 offset:%2" : "=&v"(r) : "v"(vb), "i"(OFF) : "memory"); return r;
}
template <int D0> __device__ __forceinline__ void pv_one(f32x16& od, int vb, bf16x8 pa0, bf16x8 pa1, bf16x8 pa2, bf16x8 pa3) {
    const s16x4 l0 = tr_read<v_rd_off(D0, 0, 0)>(vb), h0 = tr_read<v_rd_off(D0, 0, 1)>(vb), l1 = tr_read<v_rd_off(D0, 1, 0)>(vb), h1 = tr_read<v_rd_off(D0, 1, 1)>(vb);
    const s16x4 l2 = tr_read<v_rd_off(D0, 2, 0)>(vb), h2 = tr_read<v_rd_off(D0, 2, 1)>(vb), l3 = tr_read<v_rd_off(D0, 3, 0)>(vb), h3 = tr_read<v_rd_off(D0, 3, 1)>(vb);
    asm volatile("s_waitcnt lgkmcnt(0)" ::: "memory"); SBAR();
#define PKV(L, H) (bf16x8){L[0], L[1], L[2], L[3], H[0], H[1], H[2], H[3]}
    od = __builtin_amdgcn_mfma_f32_32x32x16_bf16(pa0, PKV(l0, h0), od, 0, 0, 0);
    od = __builtin_amdgcn_mfma_f32_32x32x16_bf16(pa1, PKV(l1, h1), od, 0, 0, 0);
    od = __builtin_amdgcn_mfma_f32_32x32x16_bf16(pa2, PKV(l2, h2), od, 0, 0, 0);
    od = __builtin_amdgcn_mfma_f32_32x32x16_bf16(pa3, PKV(l3, h3), od, 0, 0, 0);
#undef PKV
}
__device__ __forceinline__ void pv_d0(f32x16* o, int vb, bf16x8 pa0, bf16x8 pa1, bf16x8 pa2, bf16x8 pa3) {
    pv_one<0>(o[0], vb, pa0, pa1, pa2, pa3); pv_one<1>(o[1], vb, pa0, pa1, pa2, pa3); pv_one<2>(o[2], vb, pa0, pa1, pa2, pa3); pv_one<3>(o[3], vb, pa0, pa1, pa2, pa3);
}
__device__ __forceinline__ void pack_p(const f32x16& p0, const f32x16& p1, bf16x8& pa0, bf16x8& pa1, bf16x8& pa2, bf16x8& pa3) {
#define PK4(P, BASE, OUT) do { unsigned a0 = cvt_pk_bf16(P[BASE + 0], P[BASE + 1]), a1 = cvt_pk_bf16(P[BASE + 2], P[BASE + 3]);   \
    unsigned b0 = cvt_pk_bf16(P[BASE + 4], P[BASE + 5]), b1 = cvt_pk_bf16(P[BASE + 6], P[BASE + 7]);                              \
    auto r0 = __builtin_amdgcn_permlane32_swap(a0, b0, false, false); auto r1 = __builtin_amdgcn_permlane32_swap(a1, b1, false, false); \
    u32x4 w = {r0[0], r1[0], r0[1], r1[1]}; OUT = *reinterpret_cast<bf16x8*>(&w); } while (0)
    PK4(p0, 0, pa0); PK4(p0, 8, pa1); PK4(p1, 0, pa2); PK4(p1, 8, pa3);
#undef PK4
}
__device__ __forceinline__ float half_max(float v) { auto rr = __builtin_amdgcn_permlane32_swap(__float_as_uint(v), __float_as_uint(v), false, false); return fmaxf(__uint_as_float(rr[0]), __uint_as_float(rr[1])); }
__device__ __forceinline__ float half_sum(float v) { auto rr = __builtin_amdgcn_permlane32_swap(__float_as_uint(v), __float_as_uint(v), false, false); return __uint_as_float(rr[0]) + __uint_as_float(rr[1]); }

struct Ptrs { const bf16_t* Q; const bf16_t* KV; const bf16_t* KCMP; const bf16_t* VCMP; const float* GLOG; bf16_t* MIX; float* scr; };

template <int MODE>
__device__ __forceinline__ void branch_ref(char* lds, const bf16_t* Kb, const bf16_t* Vb, const bf16x8* qr, int ntiles, int qi, int qoff, int nmax,
                                       const unsigned (&selw)[4], float& m_reg, float& l_reg, float inv_l, f32x16* o, const int wid) {
    const int lane = fresh_lane(), tid = wid * 64 + lane, r32 = lane & 31, hi = lane >> 5;
    char* V_lds = lds + L_V; char* K_lds = lds + L_K;
    float* al_l = (float*)(lds + L_WS) + wid * 64 + 32;
    float* bs = (float*)(lds + L_BS);
    const int* tlist = (const int*)(lds + L_LIST);
    const int sr = tid >> 4, sc = (tid & 15) * 8, vst0 = v_st(sr, sc), vst1 = v_st(32 + sr, sc);
    const int vb0 = (int)(uintptr_t)V_lds + v_rd_base(lane);
    const int j0w = (qi - 8 > 0) ? qi - 8 : 0;
    bf16x8 vs0, vs1, ks0, ks1;
#define TILE_OF(i) (MODE <= 1 ? (i) : (MODE == 2 ? tlist[i] : j0w + (i)))
#define SLOADT(j) do { const size_t k0 = (size_t)(j) * 64; ks0 = *(const bf16x8*)(Kb + (k0 + sr) * 128 + sc); ks1 = *(const bf16x8*)(Kb + (k0 + 32 + sr) * 128 + sc); \
        if (MODE != 0) { vs0 = *(const bf16x8*)(Vb + (k0 + sr) * 128 + sc); vs1 = *(const bf16x8*)(Vb + (k0 + 32 + sr) * 128 + sc); } } while (0)
#define SWRITET(b) do { const int kc = sc * 2; *(bf16x8*)(K_lds + (b) * SHM_K + KSWZ(sr, kc)) = ks0; *(bf16x8*)(K_lds + (b) * SHM_K + KSWZ(32 + sr, kc)) = ks1; \
        if (MODE != 0) { *(bf16x8*)(V_lds + (b) * SHM_V + vst0) = vs0; *(bf16x8*)(V_lds + (b) * SHM_V + vst1) = vs1; } } while (0)
    SLOADT(TILE_OF(0)); SWRITET(0); __syncthreads();
    for (int i = 0; i < ntiles; ++i) {
        const int j = TILE_OF(i), buf = i & 1;
        if (i + 1 < ntiles) SLOADT(TILE_OF(i + 1));
        f32x16 p0, p1;
        qkt(p0, p1, K_lds + buf * SHM_K, qr, r32, hi);
        int lo = 0, hi_ = 63;
        if (MODE <= 1) hi_ = nmax - j * 64;
        else if (MODE == 2) { const int jw = j >> 5; const unsigned sw_ = jw == 0 ? selw[0] : jw == 1 ? selw[1] : jw == 2 ? selw[2] : selw[3]; const bool sel = (sw_ >> (j & 31)) & 1u; hi_ = sel ? (j == qi ? qoff : 63) : -1; }
        else { if (j == qi) hi_ = qoff; else if (j == qi - 8) lo = qoff + 1; }
        const int lo4 = lo - 4 * hi, hi4 = hi_ - 4 * hi;
        float pmax = -INFINITY;
#pragma unroll
        for (int r = 0; r < 16; ++r) { const int kc0 = (r & 3) + 8 * (r >> 2);
            p0[r] = (kc0 >= lo4 && kc0 <= hi4) ? p0[r] : -INFINITY; p1[r] = (kc0 + 32 >= lo4 && kc0 + 32 <= hi4) ? p1[r] : -INFINITY;
            pmax = fmaxf(pmax, fmaxf(p0[r], p1[r])); }
        float alpha = 1.f;
        if (MODE != 1) {
            pmax = half_max(pmax);
            const float mn = fmaxf(m_reg, pmax); alpha = fast_exp2((m_reg - mn) * CLOG); m_reg = mn;
        }
        const float mnC = -m_reg * CLOG;
        float ps = 0.f;
#pragma unroll
        for (int r = 0; r < 16; ++r) { p0[r] = fast_exp2(fmaf(p0[r], CLOG, mnC)); p1[r] = fast_exp2(fmaf(p1[r], CLOG, mnC)); ps += p0[r] + p1[r]; }
        if (MODE != 1) { ps = half_sum(ps); l_reg = l_reg * alpha + ps; }
        if (MODE == 1) {
#pragma unroll
            for (int r = 0; r < 16; ++r) { p0[r] *= inv_l; p1[r] *= inv_l; }
            unsigned* row = (unsigned*)bs + qoff * BS_STRIDE + j * 16 + hi;
#pragma unroll
            for (int a = 0; a < 4; ++a) {
                const float s0 = 2.f * (p0[4 * a] + p0[4 * a + 1] + p0[4 * a + 2]) + p0[4 * a + 3], s1 = 2.f * (p1[4 * a] + p1[4 * a + 1] + p1[4 * a + 2]) + p1[4 * a + 3];
                atomicAdd(row + 2 * a, (unsigned)(s0 * 67108864.f + 0.5f)); atomicAdd(row + 2 * a + 1, (unsigned)(p0[4 * a + 3] * 67108864.f + 0.5f));
                atomicAdd(row + 8 + 2 * a, (unsigned)(s1 * 67108864.f + 0.5f)); atomicAdd(row + 8 + 2 * a + 1, (unsigned)(p1[4 * a + 3] * 67108864.f + 0.5f));
            }
        }
        if (MODE != 0) {
            if (MODE != 1) {
                if (__any(alpha < 1.f)) { if (hi == 0) al_l[r32] = alpha; asm volatile("s_waitcnt lgkmcnt(0)" ::: "memory");
#pragma unroll
                    for (int d = 0; d < 4; ++d)
#pragma unroll
                        for (int r = 0; r < 16; ++r) o[d][r] *= al_l[crow(r, hi)]; }
            }
            bf16x8 pa0, pa1, pa2, pa3;
            pack_p(p0, p1, pa0, pa1, pa2, pa3);
            pv_d0(o, vb0 + buf * SHM_V, pa0, pa1, pa2, pa3);
        }
        if (i + 1 < ntiles) SWRITET(buf ^ 1);
        __syncthreads();
    }
#undef TILE_OF
#undef SLOADT
#undef SWRITET
}


struct Conv { const char* gsrc; const char* dsrc; unsigned char* gdst; unsigned char* ddst; int gn0, dn0, next, total; };
constexpr int L_CV1 = L_BS;
static_assert(64 * BS_STRIDE * 4 >= 32768, "conversion buffer 1");
__device__ __forceinline__ Conv conv_init(const float* wgu, const float* wd, unsigned char* ws, int c, bool on) {
    Conv cv;
    cv.gsrc = (const char*)(wgu + (size_t)(c >> 3) * 16 * 4096 + (c & 7) * 512);
    cv.gdst = ws + WS_WGU + (size_t)(c >> 3) * 4096 * 16;
    cv.dsrc = (const char*)(wd + (size_t)(c >> 2) * 16 * 2048 + (c & 3) * 512) - ((size_t)128 << 23);
    cv.ddst = ws + WS_WD + (size_t)(c >> 2) * 2048 * 16 - ((size_t)128 << 21);
    cv.gn0 = (c & 7) * 512; cv.dn0 = (c & 3) * 512; cv.next = 0; cv.total = on ? 192 : 0;
    return cv;
}
__device__ __forceinline__ void conv_issue(LAS unsigned char* ldsl, int cb, const Conv& cv, int L, const int wid, const int lane) {
    const bool gu = L < 128; const int sh = gu ? 14 : 13;
    const char* src = (gu ? cv.gsrc : cv.dsrc) + ((size_t)L << 23) + wid * 256;
    const unsigned voff = ((unsigned)(lane >> 4) << sh) + (unsigned)(lane & 15) * 16u;
    LAS unsigned char* d = ldsl + cb + wid * 4096;
    __builtin_amdgcn_global_load_lds((const unsigned*)(src + voff), (LAS unsigned*)d, 16, 0, 0);
    __builtin_amdgcn_global_load_lds((const unsigned*)(src + ((size_t)4 << sh) + voff), (LAS unsigned*)(d + 1024), 16, 0, 0);
    __builtin_amdgcn_global_load_lds((const unsigned*)(src + ((size_t)8 << sh) + voff), (LAS unsigned*)(d + 2048), 16, 0, 0);
    __builtin_amdgcn_global_load_lds((const unsigned*)(src + ((size_t)12 << sh) + voff), (LAS unsigned*)(d + 3072), 16, 0, 0);
}
typedef float f32x2 __attribute__((ext_vector_type(2)));
__device__ __forceinline__ unsigned cv_pk4(float a, float b, float c, float d) {
    f32x2 t0 = {a, b}, t1 = {c, d}; t0 *= 64.0f; t1 *= 64.0f;
    int p = __builtin_amdgcn_cvt_pk_fp8_f32(t0.x, t0.y, 0, false); p = __builtin_amdgcn_cvt_pk_fp8_f32(t1.x, t1.y, p, true); return (unsigned)p; }
__device__ __forceinline__ void conv_consume(LAS unsigned char* ldsl, int cb, const Conv& cv, int L, const int wid, const int lane) {
    const LAS float* bp = (const LAS float*)(ldsl + cb + wid * 4096 + lane * 4);
    float v[16];
#pragma unroll
    for (int j = 0; j < 16; ++j) v[j] = bp[j * 64];
    const bool gu = L < 128;
    const int n0 = (gu ? cv.gn0 : cv.dn0) + wid * 64;
    const int rowbase = gu ? (n0 < 2048 ? ((n0 >> 7) * 256 + (n0 & 127)) : (((n0 - 2048) >> 7) * 256 + 128 + (n0 & 127))) : n0;
    unsigned char* dst = (gu ? cv.gdst : cv.ddst) + ((size_t)L << 21) + (size_t)rowbase * 16;
    asm volatile("s_waitcnt lgkmcnt(0)" ::: "memory");
    u32x4 o;
    o.x = cv_pk4(v[0], v[1], v[2], v[3]); o.y = cv_pk4(v[4], v[5], v[6], v[7]); o.z = cv_pk4(v[8], v[9], v[10], v[11]); o.w = cv_pk4(v[12], v[13], v[14], v[15]);
    *(u32x4*)(dst + (unsigned)(lane * 16)) = o;
}
__device__ __forceinline__ void conv_tail(char* lds, Conv& cv, const int wid) {
    const int lane = fresh_lane();
    LAS unsigned char* ldsl = (LAS unsigned char*)(unsigned)(uintptr_t)lds;
    int is = cv.next, co = cv.next;
    for (int k = 0; k < 3 && is < cv.total; ++k, ++is) conv_issue(ldsl, (is & 3) * 32768, cv, is, wid, lane);
    while (co < cv.total) {
        if (is < cv.total) { conv_issue(ldsl, (is & 3) * 32768, cv, is, wid, lane); ++is; asm volatile("s_waitcnt vmcnt(12)" ::: "memory"); }
        else asm volatile("s_waitcnt vmcnt(0)" ::: "memory");
        conv_consume(ldsl, (co & 3) * 32768, cv, co, wid, lane); ++co;
    }
    cv.next = cv.total;
}

template <int MODE>
__device__ __forceinline__ void branch(char* lds, const bf16_t* Kb, const bf16_t* Vb, const bf16x8* qr, int ntiles, int qi, int qoff, int nmax,
                                       const unsigned (&selw)[4], float& m_reg, float& l_reg, float inv_l, f32x16* o, const int wid, Conv& cv) {
    const int lane = fresh_lane(), r32 = lane & 31, hi = lane >> 5;
    constexpr bool CONV = MODE >= 2;
    char* V_lds = lds + L_V; char* K_lds = lds + L_K;
    LAS unsigned char* ldsl = (LAS unsigned char*)(unsigned)(uintptr_t)lds;
    float* al_l = (float*)(lds + L_WS) + wid * 64 + 32;
    float* bs = (float*)(lds + L_BS);
    const int* tlist = (const int*)(lds + L_LIST);
    const int vb0 = (int)(uintptr_t)V_lds + v_rd_base(lane);
    const int j0w = (qi - 8 > 0) ? qi - 8 : 0;
    unsigned ksrc[2], vsrc[2];
#pragma unroll
    for (int i = 0; i < 2; ++i) { const int q = (i * 8 + wid) * 64 + lane;
        { const int row = q >> 4, c = (q & 15) ^ (row & 7); ksrc[i] = (unsigned)(row * 256 + c * 16); }
        { const int sub = q >> 5, within = q & 31, kk = (sub >> 2) * 8 + (within >> 2), k = (kk & ~0xC) | ((kk & 4) << 1) | ((kk & 8) >> 1), c = (sub & 3) * 32 + (within & 3) * 8; vsrc[i] = (unsigned)(k * 256 + c * 2); } }
#define TILE_OF(i) (MODE <= 1 ? (i) : (MODE == 2 ? tlist[i] : j0w + (i)))
#define ISSUE(j, b) do { const char* kg_ = (const char*)Kb + (size_t)(j) * 16384; const char* vg_ = (const char*)Vb + (size_t)(j) * 16384; \
        _Pragma("unroll") for (int _i = 0; _i < 2; ++_i) { \
            __builtin_amdgcn_global_load_lds((const unsigned*)(kg_ + ksrc[_i]), (LAS unsigned*)(ldsl + L_K + (b) * SHM_K + (_i * 8 + wid) * 1024), 16, 0, 0); \
            if (MODE != 0) __builtin_amdgcn_global_load_lds((const unsigned*)(vg_ + vsrc[_i]), (LAS unsigned*)(ldsl + L_V + (b) * SHM_V + (_i * 8 + wid) * 1024), 16, 0, 0); } } while (0)
    ISSUE(TILE_OF(0), 0);
    int buf = 0;
    bool cin = false;
    for (int i = 0; i < ntiles; ++i) {
        const int j = TILE_OF(i);
        if (CONV && cin) asm volatile("s_waitcnt vmcnt(4)" ::: "memory"); else asm volatile("s_waitcnt vmcnt(0)" ::: "memory");
        asm volatile("s_waitcnt lgkmcnt(0)" ::: "memory");
        __builtin_amdgcn_s_barrier();
        asm volatile("" ::: "memory");
        if (i + 1 < ntiles) ISSUE(TILE_OF(i + 1), buf ^ 1);
        f32x16 p0, p1;
        qkt(p0, p1, K_lds + buf * SHM_K, qr, r32, hi);
        bool boundary;
        if (MODE <= 1) boundary = (64 * j + 63 > 4 * qi - 2);
        else if (MODE == 2) boundary = (j == qi);
        else boundary = (j == qi) || (j == qi - 8);
        float pmax = -INFINITY; bool rowvalid = true;
        if (boundary) {
            int lo = 0, hi_ = 63;
            if (MODE <= 1) hi_ = nmax - j * 64;
            else if (MODE == 2) hi_ = qoff;
            else { if (j == qi) hi_ = qoff; else lo = qoff + 1; }
            const int lo4 = lo - 4 * hi, hi4 = hi_ - 4 * hi;
#pragma unroll
            for (int r = 0; r < 16; ++r) { const int kc0 = (r & 3) + 8 * (r >> 2);
                p0[r] = (kc0 >= lo4 && kc0 <= hi4) ? p0[r] : -INFINITY; p1[r] = (kc0 + 32 >= lo4 && kc0 + 32 <= hi4) ? p1[r] : -INFINITY;
                pmax = fmaxf(pmax, fmaxf(p0[r], p1[r])); }
        } else {
            if (MODE == 2) { const int jw = j >> 5; const unsigned sw_ = jw == 0 ? selw[0] : jw == 1 ? selw[1] : jw == 2 ? selw[2] : selw[3]; rowvalid = (sw_ >> (j & 31)) & 1u; }
#pragma unroll
            for (int r = 0; r < 16; ++r) pmax = fmaxf(pmax, fmaxf(p0[r], p1[r]));
            if (MODE == 2) pmax = rowvalid ? pmax : -INFINITY;
        }
        float alpha = 1.f;
        if (MODE != 1) {
            pmax = half_max(pmax);
            if (!__all(pmax - m_reg <= THR_RAW)) { const float mn = fmaxf(m_reg, pmax); alpha = fast_exp2((m_reg - mn) * CLOG); m_reg = mn; }
        }
        float mnC = -m_reg * CLOG;
        if (MODE == 2) mnC = rowvalid ? mnC : -INFINITY;
        float ps = 0.f;
#pragma unroll
        for (int r = 0; r < 16; ++r) { p0[r] = fast_exp2(fmaf(p0[r], CLOG, mnC)); p1[r] = fast_exp2(fmaf(p1[r], CLOG, mnC)); ps += p0[r] + p1[r]; }
        if (MODE != 1) { ps = half_sum(ps); l_reg = l_reg * alpha + ps; }
        if (MODE == 1) {
#pragma unroll
            for (int r = 0; r < 16; ++r) { p0[r] *= inv_l; p1[r] *= inv_l; }
            unsigned* row = (unsigned*)bs + qoff * BS_STRIDE + j * 16 + hi;
#pragma unroll
            for (int a = 0; a < 4; ++a) {
                const float s0 = 2.f * (p0[4 * a] + p0[4 * a + 1] + p0[4 * a + 2]) + p0[4 * a + 3], s1 = 2.f * (p1[4 * a] + p1[4 * a + 1] + p1[4 * a + 2]) + p1[4 * a + 3];
                atomicAdd(row + 2 * a, (unsigned)(s0 * 67108864.f + 0.5f)); atomicAdd(row + 2 * a + 1, (unsigned)(p0[4 * a + 3] * 67108864.f + 0.5f));
                atomicAdd(row + 8 + 2 * a, (unsigned)(s1 * 67108864.f + 0.5f)); atomicAdd(row + 8 + 2 * a + 1, (unsigned)(p1[4 * a + 3] * 67108864.f + 0.5f));
            }
        }
        if (MODE != 0) {
            if (MODE != 1) {
                if (__any(alpha < 1.f)) { if (hi == 0) al_l[r32] = alpha; asm volatile("s_waitcnt lgkmcnt(0)" ::: "memory");
#pragma unroll
                    for (int d = 0; d < 4; ++d)
#pragma unroll
                        for (int r = 0; r < 16; ++r) o[d][r] *= al_l[crow(r, hi)]; }
            }
            bf16x8 pa0, pa1, pa2, pa3;
            pack_p(p0, p1, pa0, pa1, pa2, pa3);
            if (CONV) {
                SBAR();
                const int cb = (i & 1) ? L_CV1 : L_CV0;
                if (i >= 2 && cv.next - 2 < cv.total) conv_consume(ldsl, cb, cv, cv.next - 2, wid, lane);
                cin = cv.next < cv.total;
                if (cin) conv_issue(ldsl, cb, cv, cv.next, wid, lane);
                ++cv.next;
                SBAR();
            }
            pv_d0(o, vb0 + buf * SHM_V, pa0, pa1, pa2, pa3);
        }
        buf ^= 1;
    }
    if (CONV) {
        asm volatile("s_waitcnt vmcnt(0)" ::: "memory");
        if (ntiles >= 2 && cv.next - 2 < cv.total) conv_consume(ldsl, ((ntiles - 2) & 1) ? L_CV1 : L_CV0, cv, cv.next - 2, wid, lane);
        if (ntiles >= 1 && cv.next - 1 < cv.total) conv_consume(ldsl, ((ntiles - 1) & 1) ? L_CV1 : L_CV0, cv, cv.next - 1, wid, lane);
        cv.next = cv.next < cv.total ? cv.next : cv.total;
    }
    asm volatile("s_waitcnt lgkmcnt(0)" ::: "memory");
    __builtin_amdgcn_s_barrier();
    asm volatile("" ::: "memory");
#undef TILE_OF
#undef ISSUE
}

template <int STAGE, bool CHECK = false>
__device__ __forceinline__ void finalize(char* lds, const f32x16* o, float f, float* scr, bf16_t* mixrow0  , const int wid, unsigned* err = nullptr) {
    const int lane = fresh_lane(), r32 = lane & 31, hi = lane >> 5;
    float* li_l = (float*)(lds + L_WS) + wid * 64;
    if (hi == 0) li_l[r32] = f;
    asm volatile("s_waitcnt lgkmcnt(0)" ::: "memory");
    int lb = hi * 4; asm volatile("" : "+v"(lb));
    float* sw = scr + (size_t)(wid * 32 + lb) * 128 + r32;
    bf16_t* mw = mixrow0 + (size_t)lb * 2048 + r32;
#pragma unroll
    for (int r = 0; r < 16; ++r) { const int orc = (r & 3) + 8 * (r >> 2); const float fr_ = li_l[orc + lb];
#pragma unroll
        for (int d0 = 0; d0 < 4; ++d0) {
            float* p = sw + orc * 128 + d0 * 32;
            float v = o[d0][r] * fr_;
            if (STAGE >= 1) v += *p;
            if (STAGE <= 1) *p = v;
            else { bf16_t* mp = mw + (size_t)orc * 2048 + d0 * 32;
                if (CHECK) { const float old = __uint_as_float((unsigned)(*mp) << 16); if (!(fabsf(old - v) <= 0.02f * fabsf(v) + 2e-3f)) __hip_atomic_store(err, 1u, RLX_AGENT); }
                *mp = (bf16_t)(cvt_pk_bf16(v, v) & 0xffffu); }
        } }
}


typedef unsigned u32x8 __attribute__((ext_vector_type(8)));
__device__ __forceinline__ void accum_out(char* lds, const f32x16* o, float f, u32x8* out, const int wid, const bool first) {
    const int lane = fresh_lane(), r32 = lane & 31, hi = lane >> 5;
    float* li_l = (float*)(lds + L_WS) + wid * 64;
    if (hi == 0) li_l[r32] = f;
    asm volatile("s_waitcnt lgkmcnt(0)" ::: "memory");
#pragma unroll
    for (int k = 0; k < 8; ++k) { const float f0 = li_l[crow(2 * k, hi)], f1 = li_l[crow(2 * k + 1, hi)];
#pragma unroll
        for (int d0 = 0; d0 < 4; ++d0) { const unsigned pk = out[d0][k]; const float a = first ? 0.f : bf_lo(pk), b = first ? 0.f : bf_hi(pk);
            out[d0][k] = cvt_pk_bf16(fmaf(o[d0][2 * k], f0, a), fmaf(o[d0][2 * k + 1], f1, b)); } }
}
template <bool CHECK>
__device__ __forceinline__ void store_out(char* lds, const u32x8* out, bf16_t* mixrow0, const int wid, unsigned* err) {
    const int lane = fresh_lane(), r32 = lane & 31, hi = lane >> 5;
    unsigned short* st = (unsigned short*)(lds + wid * 8192);
#pragma unroll
    for (int k = 0; k < 8; ++k) { const int row0 = crow(2 * k, hi), row1 = crow(2 * k + 1, hi);
#pragma unroll
        for (int d0 = 0; d0 < 4; ++d0) { const unsigned pk = out[d0][k]; st[row0 * 128 + d0 * 32 + r32] = (unsigned short)(pk & 0xffffu); st[row1 * 128 + d0 * 32 + r32] = (unsigned short)(pk >> 16); } }
    asm volatile("s_waitcnt lgkmcnt(0)" ::: "memory");
#pragma unroll
    for (int q = 0; q < 8; ++q) { const int idx = q * 64 + lane, row = idx >> 4, ch = idx & 15;
        const u32x4 v = *(const u32x4*)(st + row * 128 + ch * 8);
        u32x4* gp = (u32x4*)(mixrow0 + (size_t)row * 2048 + ch * 8);
        if (CHECK) { const u32x4 old = *gp; const unsigned a[4] = {old.x, old.y, old.z, old.w}, b[4] = {v.x, v.y, v.z, v.w};
#pragma unroll
            for (int k = 0; k < 4; ++k) { const float x0 = bf_lo(a[k]), x1 = bf_hi(a[k]), y0 = bf_lo(b[k]), y1 = bf_hi(b[k]);
                if (!(fabsf(x0 - y0) <= 0.03f * fabsf(y0) + 3e-3f) || !(fabsf(x1 - y1) <= 0.03f * fabsf(y1) + 3e-3f)) __hip_atomic_store(err, 1u, RLX_AGENT); } }
        *gp = v; }
}

template <int IMPL, bool CHECK>
__device__ __forceinline__ void attn_item(char* lds, const Ptrs& P, int b, int g, int qi, const int wid, unsigned* err, Conv& cv) {
    const int lane = fresh_lane(), tid = wid * 64 + lane, r32 = lane & 31, hi = lane >> 5;
    const int hh = wid >> 1, head = g * 4 + hh, qoff = (wid & 1) * 32 + r32, t = qi * 64 + qoff;
    const size_t tok = (size_t)b * SEQ + t;
    bf16x8 qr[8];
    { const bf16_t* Qw = P.Q + tok * 1024 + head * 128 + hi * 8;
#pragma unroll
      for (int d0 = 0; d0 < 8; ++d0) qr[d0] = *(const bf16x8*)(Qw + d0 * 16); }
    const float* gl = P.GLOG + tok * 32 + head * 3;
    const float g_c = sigmoidf_(gl[0]), g_s = sigmoidf_(gl[1]), g_w = sigmoidf_(gl[2]);
    const size_t kvo = (size_t)((b * 2 + g) * SEQ) * 128, cmo = (size_t)((b * 2 + g) * NCMP) * 128;
    const bf16_t* Ks = P.KV + 2 * (KV_STRIDE / 2) + kvo; const bf16_t* Vs = P.KV + 3 * (KV_STRIDE / 2) + kvo;
    const bf16_t* Kw = P.KV + 4 * (KV_STRIDE / 2) + kvo; const bf16_t* Vw = P.KV + 5 * (KV_STRIDE / 2) + kvo;
    const bf16_t* Kc = P.KCMP + cmo; const bf16_t* Vc = P.VCMP + cmo;
    float* bs = (float*)(lds + L_BS);
    unsigned* selm = (unsigned*)(lds + L_SEL); unsigned* uni = (unsigned*)(lds + L_UNI); int* tlist = (int*)(lds + L_LIST);
    for (int i = tid; i < 64 * BS_STRIDE; i += 512) ((unsigned*)bs)[i] = 0u;
    if (tid < 8) uni[tid] = 0u;
    __syncthreads();
    bf16_t* mixrow0 = P.MIX + ((size_t)b * SEQ + qi * 64 + (wid & 1) * 32) * 2048 + head * 128;
    unsigned selw[4] = {0u, 0u, 0u, 0u};
    f32x16 o[4];
    u32x8 out[4];
    const int nmax = (t - 31) >> 4;
    const int ntc = ((4 * qi + 2) >> 6) + 1;
    float m_c = -1e30f, l_c = 0.f;
    if (IMPL == 0) branch_ref<0>(lds, Kc, Vc, qr, ntc, qi, qoff, nmax, selw, m_c, l_c, 0.f, o, wid); else branch<0>(lds, Kc, Vc, qr, ntc, qi, qoff, nmax, selw, m_c, l_c, 0.f, o, wid, cv);
    const float inv_lc = l_c > 0.f ? 1.0f / l_c : 0.f;
#pragma unroll
    for (int d = 0; d < 4; ++d) o[d] = f32x16{};
    if (IMPL == 0) branch_ref<1>(lds, Kc, Vc, qr, ntc, qi, qoff, nmax, selw, m_c, l_c, inv_lc, o, wid); else branch<1>(lds, Kc, Vc, qr, ntc, qi, qoff, nmax, selw, m_c, l_c, inv_lc, o, wid, cv);
    if (IMPL == 1) accum_out(lds, o, g_c, out, wid, true); else finalize<0>(lds, o, g_c, P.scr, mixrow0, wid);
    __syncthreads();
    if (IMPL == 0) {
    {
        const int cur = qi;
        for (int qq = 0; qq < 8; ++qq) {
            const int q = wid * 8 + qq;
            unsigned mk0 = 0u, mk1 = 0u, mk2 = 0u, mk3 = 0u;
#define MK_SET(idx) do { const int _w = (idx) >> 5; const unsigned _b = 1u << ((idx) & 31); mk0 |= _w == 0 ? _b : 0u; mk1 |= _w == 1 ? _b : 0u; mk2 |= _w == 2 ? _b : 0u; mk3 |= _w == 3 ? _b : 0u; } while (0)
            if (cur <= 15) { mk0 = (1u << (cur + 1)) - 1u; }
            else {
                MK_SET(0); MK_SET(cur); MK_SET(cur - 1);
                const int j0 = lane, j1 = lane + 64;
                const unsigned* bsu = (const unsigned*)bs;
                unsigned s0 = (j0 >= 1 && j0 <= cur - 2) ? bsu[q * BS_STRIDE + j0] + 1u : 0u;
                unsigned s1 = (j1 <= cur - 2) ? bsu[q * BS_STRIDE + j1] + 1u : 0u;
                for (int it = 0; it < 13; ++it) {
                    unsigned bv; int bi;
                    if (s1 > s0) { bv = s1; bi = j1; } else { bv = s0; bi = j0; }
#pragma unroll
                    for (int off = 1; off < 64; off <<= 1) { const unsigned ov = (unsigned)__shfl_xor((int)bv, off); const int oi = __shfl_xor(bi, off); if (ov > bv || (ov == bv && oi < bi)) { bv = ov; bi = oi; } }
                    bi = __builtin_amdgcn_readfirstlane(bi);
                    MK_SET(bi);
                    if (bi == j0) s0 = 0u;
                    if (bi == j1) s1 = 0u;
                }
            }
#undef MK_SET
            if (lane < 4) { const unsigned v = lane == 0 ? mk0 : lane == 1 ? mk1 : lane == 2 ? mk2 : mk3; selm[q * 4 + lane] = v; atomicOr(&uni[lane], v); }
        }
    }
    } else {
    {
        const int cur = qi;
        if (cur <= 15) {
            if (lane < 4) { const unsigned v = lane == 0 ? ((1u << (cur + 1)) - 1u) : 0u;
#pragma unroll
                for (int qq = 0; qq < 8; ++qq) selm[(wid * 8 + qq) * 4 + lane] = v;
                atomicOr(&uni[lane], v); }
        } else {
            const unsigned* bsu = (const unsigned*)bs; const int j0 = lane, j1 = lane + 64;
            const bool v0 = j0 >= 1 && j0 <= cur - 2, v1 = j1 <= cur - 2;
#pragma unroll 1
            for (int qb = 0; qb < 8; qb += 4) {
                unsigned s0[4], s1[4]; unsigned long long ma[4], mb[4];
#pragma unroll
                for (int u = 0; u < 4; ++u) { const int q = wid * 8 + qb + u;
                    s0[u] = v0 ? bsu[q * BS_STRIDE + j0] + 1u : 0u; s1[u] = v1 ? bsu[q * BS_STRIDE + j1] + 1u : 0u;
                    ma[u] = 1ull; mb[u] = 0ull;
                    if (cur < 64) ma[u] |= 1ull << cur; else mb[u] |= 1ull << (cur - 64);
                    if (cur - 1 < 64) ma[u] |= 1ull << (cur - 1); else mb[u] |= 1ull << (cur - 65); }
#pragma unroll 1
                for (int it = 0; it < 13; ++it) {
#pragma unroll
                    for (int u = 0; u < 4; ++u) {
                        unsigned v = s0[u] > s1[u] ? s0[u] : s1[u];
                        { unsigned t;
                          t = (unsigned)__builtin_amdgcn_update_dpp(0, (int)v, 0x111, 0xf, 0xf, false); v = v > t ? v : t;
                          t = (unsigned)__builtin_amdgcn_update_dpp(0, (int)v, 0x112, 0xf, 0xf, false); v = v > t ? v : t;
                          t = (unsigned)__builtin_amdgcn_update_dpp(0, (int)v, 0x114, 0xf, 0xf, false); v = v > t ? v : t;
                          t = (unsigned)__builtin_amdgcn_update_dpp(0, (int)v, 0x118, 0xf, 0xf, false); v = v > t ? v : t;
                          t = (unsigned)__builtin_amdgcn_update_dpp(0, (int)v, 0x142, 0xa, 0xf, false); v = v > t ? v : t;
                          t = (unsigned)__builtin_amdgcn_update_dpp(0, (int)v, 0x143, 0xc, 0xf, false); v = v > t ? v : t; }
                        const unsigned m = (unsigned)__builtin_amdgcn_readlane((int)v, 63);
                        const unsigned long long b0 = __ballot(s0[u] == m), b1 = __ballot(s1[u] == m);
                        if (b0) { const int idx = __builtin_ctzll(b0); ma[u] |= 1ull << idx; if (lane == idx) s0[u] = 0u; }
                        else    { const int idx = __builtin_ctzll(b1); mb[u] |= 1ull << idx; if (lane == idx) s1[u] = 0u; }
                    }
                }
#pragma unroll
                for (int u = 0; u < 4; ++u) { const int q = wid * 8 + qb + u;
                    if (lane < 4) { const unsigned v = lane == 0 ? (unsigned)ma[u] : lane == 1 ? (unsigned)(ma[u] >> 32) : lane == 2 ? (unsigned)mb[u] : (unsigned)(mb[u] >> 32); selm[q * 4 + lane] = v; atomicOr(&uni[lane], v); } }
            }
        }
    }
    }
    __syncthreads();
    if (tid < 128) {
        const unsigned w = uni[tid >> 5]; const bool on = (w >> (tid & 31)) & 1u;
        if (on) { int pos = __popc(w & ((1u << (tid & 31)) - 1u)); for (int k = 0; k < (tid >> 5); ++k) pos += __popc(uni[k]); tlist[pos] = tid; }
    }
    const int nsel = __popc(uni[0]) + __popc(uni[1]) + __popc(uni[2]) + __popc(uni[3]);
#pragma unroll
    for (int k = 0; k < 4; ++k) selw[k] = selm[qoff * 4 + k];
    __syncthreads();
    { float m_s = -1e30f, l_s = 0.f;
#pragma unroll
      for (int d = 0; d < 4; ++d) o[d] = f32x16{};
      if (IMPL == 0) branch_ref<2>(lds, Ks, Vs, qr, nsel, qi, qoff, 0, selw, m_s, l_s, 0.f, o, wid); else branch<2>(lds, Ks, Vs, qr, nsel, qi, qoff, 0, selw, m_s, l_s, 0.f, o, wid, cv);
      if (IMPL == 1) accum_out(lds, o, l_s > 0.f ? g_s / l_s : 0.f, out, wid, false); else finalize<1>(lds, o, l_s > 0.f ? g_s / l_s : 0.f, P.scr, mixrow0, wid); }
    { float m_w = -1e30f, l_w = 0.f;
#pragma unroll
      for (int d = 0; d < 4; ++d) o[d] = f32x16{};
      const int j0w = (qi - 8 > 0) ? qi - 8 : 0;
      if (IMPL == 0) branch_ref<3>(lds, Kw, Vw, qr, qi - j0w + 1, qi, qoff, 0, selw, m_w, l_w, 0.f, o, wid); else branch<3>(lds, Kw, Vw, qr, qi - j0w + 1, qi, qoff, 0, selw, m_w, l_w, 0.f, o, wid, cv);
      if (IMPL == 1) { accum_out(lds, o, l_w > 0.f ? g_w / l_w : 0.f, out, wid, false); store_out<CHECK>(lds, out, mixrow0, wid, err); }
      else finalize<2, CHECK>(lds, o, l_w > 0.f ? g_w / l_w : 0.f, P.scr, mixrow0, wid, err); }
    __syncthreads();
}
}

struct Frame {
    LAS unsigned char* lds; char* ldsg;
    unsigned* ctl; unsigned char* ws;
    int wave, G, c;
};
#define FRESH_TID() const int lane = fresh_lane(); const int tid = F.wave * 64 + lane; (void)tid; (void)lane
__constant__ float c_inv_freq[16] = {1.0f, 0.44036659598350525f, 0.1939227432012558f, 0.08539710193872452f, 0.03760603070259094f, 0.016560440883040428f, 0.007292664609849453f,
    0.0032114461064338684f, 0.0014142135623842478f, 0.0006227724370546639f, 0.00027424818836152554f, 0.00012076973507646471f, 5.3182957344688475e-05f, 2.34199997066753e-05f,
    1.0313385246263351e-05f, 4.541670477919979e-06f};

template <int MODE> __device__ __forceinline__ int rowmap(int n) {
    if (MODE == 1) return n < 2560 ? n : (n < 2584 ? 3584 + (n - 2560) : n - 24);
    if (MODE == 2) return n < 2048 ? ((n >> 7) * 256 + (n & 127)) : (((n - 2048) >> 7) * 256 + 128 + ((n - 2048) & 127));
    return n;
}
struct TrMat { const float* W; bf16_t* WT; int K, N, ldt, mode, nkt, nnt; };
__device__ __forceinline__ void tr_load(const TrMat& M, int kt, int nt, int w, int lane, f32x4 (&v)[8]) {
    const int n = nt * 128 + (lane & 31) * 4, kb = kt * 128 + w * 16 + (lane >> 5) * 8;
    const bool ok = n < M.N; const float* p = M.W + (size_t)kb * M.N + (ok ? n : 0);
#pragma unroll
    for (int i = 0; i < 8; ++i) v[i] = *(const f32x4*)(p + (size_t)i * M.N);
}
__device__ __forceinline__ void tr_lds_write(LAS unsigned* buf, int w, int lane, const f32x4 (&v)[8]) {
#pragma unroll
    for (int i2 = 0; i2 < 4; ++i2) { const int kp = w * 8 + (lane >> 5) * 4 + i2;
        u32x4 o; o.x = cvt_pk_bf16(v[2 * i2][0], v[2 * i2 + 1][0]); o.y = cvt_pk_bf16(v[2 * i2][1], v[2 * i2 + 1][1]); o.z = cvt_pk_bf16(v[2 * i2][2], v[2 * i2 + 1][2]); o.w = cvt_pk_bf16(v[2 * i2][3], v[2 * i2 + 1][3]);
        *(LAS u32x4*)(buf + kp * 128 + (((lane & 31) * 4) ^ (4 * ((kp >> 2) & 7)))) = o; }
}
__device__ __forceinline__ void tr_store(const TrMat& M, int kt, int nt, const LAS unsigned* buf, int tid) {
#pragma unroll
    for (int q = 0; q < 4; ++q) { const int idx = tid + 512 * q, nl = idx >> 4, kg = idx & 15, n = nt * 128 + nl;
        u32x4 o; const LAS unsigned* b = buf + (kg * 4) * 128 + (nl ^ (4 * (kg & 7)));
        o.x = b[0]; o.y = b[128]; o.z = b[256]; o.w = b[384];
        if (n < M.N) { const int row = M.mode == 1 ? rowmap<1>(n) : n; *(u32x4*)(M.WT + (size_t)row * M.ldt + kt * 128 + kg * 8) = o; } }
}
__device__ __forceinline__ unsigned pk4_fp8(float a, float b, float c, float d) { int p = __builtin_amdgcn_cvt_pk_fp8_f32(a, b, 0, false); p = __builtin_amdgcn_cvt_pk_fp8_f32(c, d, p, true); return (unsigned)p; }
__device__ __forceinline__ void tr_lds_write8(LAS unsigned* buf, int w, int lane, const f32x4 (&v)[8]) {
#pragma unroll
    for (int i2 = 0; i2 < 2; ++i2) { const int kq = w * 4 + (lane >> 5) * 2 + i2;
        u32x4 o;
#pragma unroll
        for (int j = 0; j < 4; ++j) o[j] = pk4_fp8(v[4 * i2][j] * 64.0f, v[4 * i2 + 1][j] * 64.0f, v[4 * i2 + 2][j] * 64.0f, v[4 * i2 + 3][j] * 64.0f);
        *(LAS u32x4*)(buf + kq * 128 + (((lane & 31) * 4) ^ (4 * ((kq >> 2) & 7)))) = o; }
}
__device__ __forceinline__ void tr_store8(const TrMat& M, int kt, int nt, const LAS unsigned* buf, int tid) {
#pragma unroll
    for (int q = 0; q < 2; ++q) { const int idx = tid + 512 * q, nl = idx >> 3, kg = idx & 7, n = nt * 128 + nl;
        u32x4 o; const LAS unsigned* b = buf + (kg * 4) * 128 + (nl ^ (4 * kg));
        o.x = b[0]; o.y = b[128]; o.z = b[256]; o.w = b[384];
        const int row = M.mode == 2 ? rowmap<2>(n) : n; *(u32x4*)((unsigned char*)M.WT + ((size_t)(kt * 8 + kg) * M.N + row) * 16) = o; }
}
__device__ __forceinline__ bool tr_pick(const Frame& F, const Args& A, int id, TrMat& M, int& kt, int& nt) {
    constexpr int T_GU = 16 * 32, T_DN = 16 * 16, T_IN = 16 * 29, T_OUT = 16 * 16, T_W1 = 32 * 2, T_PW = 2 * 2, T_W2 = 2;
    int r = id;
    if (r < 32 * T_GU) { const int e = r / T_GU; r %= T_GU; M = TrMat{A.in[I_WGU] + (size_t)e * 2048 * 4096, (bf16_t*)(F.ws + WS_WGU + (size_t)e * 4096 * 2048), 2048, 4096, 2048, 2, 16, 32}; }
    else if ((r -= 32 * T_GU) < 32 * T_DN) { const int e = r / T_DN; r %= T_DN; M = TrMat{A.in[I_WD] + (size_t)e * 2048 * 2048, (bf16_t*)(F.ws + WS_WD + (size_t)e * 2048 * 2048), 2048, 2048, 2048, 3, 16, 16}; }
    else if ((r -= 32 * T_DN) < T_IN) { M = TrMat{A.in[I_WIN], (bf16_t*)(F.ws + WS_WINT), 2048, 3608, 2048, 1, 16, 29}; }
    else if ((r -= T_IN) < T_OUT) { M = TrMat{A.in[I_WOUT], (bf16_t*)(F.ws + WS_WOUTT), 2048, 2048, 2048, 0, 16, 16}; }
    else if ((r -= T_OUT) < 2 * T_W1) { const int kv = r / T_W1; r %= T_W1; M = TrMat{kv ? A.in[I_CVW1] : A.in[I_CKW1], (bf16_t*)(F.ws + WS_W1T) + (size_t)kv * 256 * 4096, 4096, 256, 4096, 0, 32, 2}; }
    else if ((r -= 2 * T_W1) < 4 * T_PW) { const int g = r / T_PW; r %= T_PW; M = TrMat{A.in[I_POOLW] + (size_t)g * 65536, (bf16_t*)(F.ws + WS_PWT) + (size_t)g * 65536, 256, 256, 256, 0, 2, 2}; }
    else if ((r -= 4 * T_PW) < 2 * T_W2) { const int kv = r / T_W2; r %= T_W2; M = TrMat{kv ? A.in[I_CVW2] : A.in[I_CKW2], (bf16_t*)(F.ws + WS_W2T) + (size_t)kv * 128 * 256, 256, 128, 256, 0, 2, 1}; }
    else return false;
    kt = r / M.nnt; nt = r % M.nnt; return true;
}
constexpr int NMOE_TILES = 32 * (16 * 32 + 16 * 16);
__device__ __forceinline__ void convert_tiles(const Frame& F, const Args& A, int first, int stride, int end) {
    FRESH_TID();
    LAS unsigned* tb0 = (LAS unsigned*)F.lds; TrMat MA, MB; int ktA = 0, ntA = 0, ktB = 0, ntB = 0; f32x4 vA[8], vB[8];
    int id = first;
    bool haveA = id < end && tr_pick(F, A, id, MA, ktA, ntA); if (haveA) tr_load(MA, ktA, ntA, F.wave, lane, vA);
    bool haveB = id + stride < end && tr_pick(F, A, id + stride, MB, ktB, ntB); if (haveB) tr_load(MB, ktB, ntB, F.wave, lane, vB);
    id += 2 * stride;
    while (haveA) {
        { LAS unsigned* buf = tb0;
          if (MA.mode >= 2) tr_lds_write8(buf, F.wave, lane, vA); else tr_lds_write(buf, F.wave, lane, vA);
          __syncthreads();
          const TrMat Mc = MA; const int ktc = ktA, ntc = ntA;
          haveA = id < end && tr_pick(F, A, id, MA, ktA, ntA); if (haveA) tr_load(MA, ktA, ntA, F.wave, lane, vA);
          if (Mc.mode >= 2) tr_store8(Mc, ktc, ntc, buf, tid); else tr_store(Mc, ktc, ntc, buf, tid); }
        if (!haveB) break;
        { LAS unsigned* buf = tb0 + 8192;
          if (MB.mode >= 2) tr_lds_write8(buf, F.wave, lane, vB); else tr_lds_write(buf, F.wave, lane, vB);
          __syncthreads();
          const TrMat Mc = MB; const int ktc = ktB, ntc = ntB;
          haveB = id + stride < end && tr_pick(F, A, id + stride, MB, ktB, ntB); if (haveB) tr_load(MB, ktB, ntB, F.wave, lane, vB);
          if (Mc.mode >= 2) tr_store8(Mc, ktc, ntc, buf, tid); else tr_store(Mc, ktc, ntc, buf, tid); }
        id += 2 * stride;
    }
    __syncthreads();
}
__device__ __forceinline__ void posb_partials(const Frame& F, const Args& A, int rank, int n) {
    FRESH_TID();
    float* pb = (float*)(F.ws + WS_POSB64);
    for (long i = (long)rank * 512 + tid; i < 64 * 512; i += (long)n * 512) { const int o = (int)(i & 511), ks = (int)(i >> 9), kv = o >> 8, h = o & 255;
        const float* pos = kv ? A.in[I_CVPOS] : A.in[I_CKPOS]; const float* w1 = kv ? A.in[I_CVW1] : A.in[I_CKW1]; float s0 = 0.f, s1 = 0.f, s2 = 0.f, s3 = 0.f;
#pragma unroll 4
        for (int r = ks * 64; r < ks * 64 + 64; r += 4) { s0 = fmaf(pos[r], w1[(size_t)r * 256 + h], s0); s1 = fmaf(pos[r + 1], w1[(size_t)(r + 1) * 256 + h], s1); s2 = fmaf(pos[r + 2], w1[(size_t)(r + 2) * 256 + h], s2); s3 = fmaf(pos[r + 3], w1[(size_t)(r + 3) * 256 + h], s3); }
        pb[i] = (s0 + s1) + (s2 + s3); }
}
__device__ __forceinline__ void phase0(const Frame& F, const Args& A) {
    FRESH_TID();
    const int gw = F.c * NWAVES + F.wave, NGW = F.G * NWAVES;
    const long gt = (long)F.c * 512 + tid, NT = (long)F.G * 512;
    { const float* x = A.in[I_X]; const float* g1 = A.in[I_N1G]; bf16_t* H = (bf16_t*)(F.ws + WS_H);
      for (int row = gw; row < NTOK; row += 2 * NGW) {
        const bool hasB = row + NGW < NTOK; const int rowB = hasB ? row + NGW : row;
        const f32x4* xa = (const f32x4*)(x + (size_t)row * DM) + lane; const f32x4* xb = (const f32x4*)(x + (size_t)rowB * DM) + lane; f32x4 va[8], vb[8]; float sa = 0.f, sb = 0.f;
#pragma unroll
        for (int j = 0; j < 8; ++j) { va[j] = xa[64 * j]; vb[j] = xb[64 * j]; }
#pragma unroll
        for (int j = 0; j < 8; ++j) { sa += (va[j][0] * va[j][0] + va[j][1] * va[j][1]) + (va[j][2] * va[j][2] + va[j][3] * va[j][3]); sb += (vb[j][0] * vb[j][0] + vb[j][1] * vb[j][1]) + (vb[j][2] * vb[j][2] + vb[j][3] * vb[j][3]); }
        const float ra = rsqrtf(wave_sum(sa) * (1.0f / DM) + 1e-5f), rb = rsqrtf(wave_sum(sb) * (1.0f / DM) + 1e-5f);
        u32x2* oa = (u32x2*)(H + (size_t)row * DM) + lane; u32x2* ob = (u32x2*)(H + (size_t)rowB * DM) + lane;
#pragma unroll
        for (int j = 0; j < 8; ++j) { const f32x4 gg = ((const f32x4*)g1)[64 * j + lane]; u32x2 w;
            w.x = cvt_pk_bf16(va[j][0] * ra * gg[0], va[j][1] * ra * gg[1]); w.y = cvt_pk_bf16(va[j][2] * ra * gg[2], va[j][3] * ra * gg[3]); oa[64 * j] = w;
            if (hasB) { w.x = cvt_pk_bf16(vb[j][0] * rb * gg[0], vb[j][1] * rb * gg[1]); w.y = cvt_pk_bf16(vb[j][2] * rb * gg[2], vb[j][3] * rb * gg[3]); ob[64 * j] = w; } }
      } }
    convert_tiles(F, A, (F.G == 256 ? NMOE_TILES : 0) + F.c, F.G, 1 << 30);
    { u32x4* z = (u32x4*)((bf16_t*)(F.ws + WS_WINT) + (size_t)3608 * 2048); const long n16 = (long)(NINP - 3608) * 2048 * 2 / 16;
      for (long i = gt; i < n16; i += NT) z[i] = (u32x4){0u, 0u, 0u, 0u}; }
    { float* tc = (float*)(F.ws + WS_COS); float* tsn = (float*)(F.ws + WS_SIN);
      for (long i = gt; i < 8208 * 16; i += NT) { const int pos = (int)(i >> 4), k = (int)(i & 15);
        const float ang = (float)pos * c_inv_freq[k]; double xr = (double)ang * 0.15915494309189535; xr -= __builtin_rint(xr);
        tc[i] = __builtin_amdgcn_cosf((float)xr); tsn[i] = __builtin_amdgcn_sinf((float)xr); } }
}

struct RowJob { bf16_t* p; u32x4 raw; f32x4 g0, g1, c0, c1, s0, s1; };
__device__ __forceinline__ void rowjob_issue(RowJob& J, const Frame& F, const Args& A, int row, int sub) {
    constexpr int NQ = NTOK * 8, NK = NB * NGRP * SEQ;
    bf16_t* Q = (bf16_t*)(F.ws + WS_Q); bf16_t* KS = (bf16_t*)(F.ws + WS_KV + 2 * KV_STRIDE); bf16_t* KW = (bf16_t*)(F.ws + WS_KV + 4 * KV_STRIDE);
    const float* tc = (const float*)(F.ws + WS_COS); const float* tsn = (const float*)(F.ws + WS_SIN);
    const float* gain; int pos;
    if (row < NQ) { J.p = Q + (size_t)row * 128; gain = A.in[I_QNG]; pos = (row >> 3) & (SEQ - 1); }
    else if (row < NQ + NK) { const int r = row - NQ; J.p = KS + (size_t)r * 128; gain = A.in[I_KNS]; pos = r & (SEQ - 1); }
    else { const int r = row - NQ - NK; J.p = KW + (size_t)r * 128; gain = A.in[I_KNW]; pos = r & (SEQ - 1); }
    J.raw = *(const u32x4*)(J.p + sub * 8);
    J.g0 = *(const f32x4*)(gain + sub * 8); J.g1 = *(const f32x4*)(gain + sub * 8 + 4);
    const int ti = pos * 16 + (sub & 1) * 8;
    J.c0 = *(const f32x4*)(tc + ti); J.c1 = *(const f32x4*)(tc + ti + 4); J.s0 = *(const f32x4*)(tsn + ti); J.s1 = *(const f32x4*)(tsn + ti + 4);
}
__device__ __forceinline__ void rowjob_finish(const RowJob& J, int sub) {
    const u32x4 raw = J.raw;
    float x[8] = {bf_lo(raw.x), bf_hi(raw.x), bf_lo(raw.y), bf_hi(raw.y), bf_lo(raw.z), bf_hi(raw.z), bf_lo(raw.w), bf_hi(raw.w)};
    float ss = 0.f;
#pragma unroll
    for (int j = 0; j < 8; ++j) ss += x[j] * x[j];
    ss += __shfl_xor(ss, 1); ss += __shfl_xor(ss, 2); ss += __shfl_xor(ss, 4); ss += __shfl_xor(ss, 8);
    const float rstd = rsqrtf(ss * (1.0f / 128.0f) + 1e-6f);
#pragma unroll
    for (int j = 0; j < 8; ++j) x[j] = x[j] * rstd * (j < 4 ? J.g0[j] : J.g1[j - 4]);
#pragma unroll
    for (int j = 0; j < 8; ++j) { const float other = __shfl_xor(x[j], 2); const float cs = j < 4 ? J.c0[j] : J.c1[j - 4], sn = j < 4 ? J.s0[j] : J.s1[j - 4];
        const float rot = (sub < 2) ? (x[j] * cs - other * sn) : (x[j] * cs + other * sn); x[j] = sub < 4 ? rot : x[j]; }
    u32x4 w; w.x = cvt_pk_bf16(x[0], x[1]); w.y = cvt_pk_bf16(x[2], x[3]); w.z = cvt_pk_bf16(x[4], x[5]); w.w = cvt_pk_bf16(x[6], x[7]);
    *(u32x4*)(J.p + sub * 8) = w;
}
__device__ __forceinline__ void norm_rope_rows(const Frame& F, const Args& A, int ec, int eG) {
    FRESH_TID();
    const int gw = ec * NWAVES + F.wave, NGW = eG * NWAVES, sub = lane & 15, rsel = lane >> 4;
    constexpr int NITEM = (NTOK * 8 + 2 * NB * NGRP * SEQ) / 4;
    for (int it = gw; it < NITEM; it += 2 * NGW) {
        RowJob JA, JB; const bool hasB = it + NGW < NITEM;
        rowjob_issue(JA, F, A, it * 4 + rsel, sub);
        if (hasB) rowjob_issue(JB, F, A, (it + NGW) * 4 + rsel, sub);
        rowjob_finish(JA, sub);
        if (hasB) rowjob_finish(JB, sub);
    }
}
template <int W> __device__ __forceinline__ void pool_item(const bf16_t* PIN, bf16_t* DP, int tok, int c8) {
    const int s = tok & (SEQ - 1);
    u32x4 raw[W];
#pragma unroll
    for (int j = 0; j < W; ++j) { const int jj = j <= s ? j : s; raw[j] = *(const u32x4*)(PIN + (size_t)(tok - jj) * 1024 + c8 * 8); }
    float acc[8] = {0.f, 0.f, 0.f, 0.f, 0.f, 0.f, 0.f, 0.f};
#pragma unroll
    for (int j = 0; j < W; ++j) { const float wg = j <= s ? 1.f : 0.f; const u32x4 r = raw[j];
        acc[0] = fmaf(bf_lo(r.x), wg, acc[0]); acc[1] = fmaf(bf_hi(r.x), wg, acc[1]); acc[2] = fmaf(bf_lo(r.y), wg, acc[2]); acc[3] = fmaf(bf_hi(r.y), wg, acc[3]);
        acc[4] = fmaf(bf_lo(r.z), wg, acc[4]); acc[5] = fmaf(bf_hi(r.z), wg, acc[5]); acc[6] = fmaf(bf_lo(r.w), wg, acc[6]); acc[7] = fmaf(bf_hi(r.w), wg, acc[7]); }
    const u32x4 r0 = raw[0]; const float cur[8] = {bf_lo(r0.x), bf_hi(r0.x), bf_lo(r0.y), bf_hi(r0.y), bf_lo(r0.z), bf_hi(r0.z), bf_lo(r0.w), bf_hi(r0.w)};
    const float inv = 1.0f / (float)((s + 1 < W) ? s + 1 : W); float d[8];
#pragma unroll
    for (int k = 0; k < 8; ++k) d[k] = acc[k] * inv - cur[k];
    u32x4 o; o.x = cvt_pk_bf16(d[0], d[1]); o.y = cvt_pk_bf16(d[2], d[3]); o.z = cvt_pk_bf16(d[4], d[5]); o.w = cvt_pk_bf16(d[6], d[7]);
    *(u32x4*)(DP + (size_t)tok * 1024 + c8 * 8) = o;
}
__device__ __forceinline__ void pool_diffs(const Frame& F, int ec, int eG) {
    const bf16_t* PIN = (const bf16_t*)(F.ws + WS_PIN); bf16_t* DP = (bf16_t*)(F.ws + WS_DP);
    FRESH_TID();
    const long gt = (long)ec * 512 + tid, NT = (long)eG * 512;
    for (long i = gt; i < 4L * NTOK * 32; i += NT) {
        const int g = (int)(i >> 19), tok = (int)((i >> 5) & (NTOK - 1)), c8 = g * 32 + (int)(i & 31);
        if (g == 0) pool_item<2>(PIN, DP, tok, c8); else if (g == 1) pool_item<4>(PIN, DP, tok, c8); else if (g == 2) pool_item<8>(PIN, DP, tok, c8); else pool_item<16>(PIN, DP, tok, c8);
    }
}
__device__ __forceinline__ void cmp_bias_total(const Frame& F, const Args& A) {
    FRESH_TID();
    const float* posb = (const float*)(F.ws + WS_POSB64); float* bt = (float*)(F.ws + WS_POSB + 65536 - 2048);
#pragma unroll
    for (int q = 0; q < 8; ++q) { const int o = q * 64 + lane; float sacc = (o < 256 ? A.in[I_CKB1] : A.in[I_CVB1])[o & 255];
        for (int p = 0; p < 64; ++p) sacc += posb[p * 512 + o];
        bt[o] = sacc; }
}
__device__ __forceinline__ void cmp_layer2(const Frame& F, const Args& A, int kv, int rg) {
    FRESH_TID();
    const int w = F.wave, l15 = lane & 15, q4 = lane >> 4;
    const float* HP = (const float*)(F.ws + WS_ACT); const bf16_t* W2T = (const bf16_t*)(F.ws + WS_W2T) + (size_t)kv * 128 * 256;
    const float* bt = (const float*)(F.ws + WS_POSB + 65536 - 2048) + kv * 256;
    LAS f32x4* red = (LAS f32x4*)F.lds;
    { const int rowA = rg * 16 + l15, k0 = w * 32 + q4 * 8;
      f32x4 h0 = *(const f32x4*)(bt + k0), h1 = *(const f32x4*)(bt + k0 + 4);
#pragma unroll
      for (int p = 0; p < 4; ++p) { const float* src = HP + ((size_t)(p * 2 + kv) * 2048 + rowA) * 256 + k0; h0 += *(const f32x4*)src; h1 += *(const f32x4*)(src + 4); }
      float g[8];
#pragma unroll
      for (int j = 0; j < 8; ++j) { const float x = j < 4 ? h0[j] : h1[j - 4]; const float uu = 0.7978845608028654f * (x + 0.044715f * x * x * x);
          g[j] = x * fast_rcp(1.0f + fast_exp2(-2.885390081777927f * uu)); }
      auto f2b = [](float f) -> unsigned { unsigned u = __float_as_uint(f); return (u + 0x7fffu + ((u >> 16) & 1u)) >> 16; };
      u32x4 aw; aw.x = f2b(g[0]) | (f2b(g[1]) << 16); aw.y = f2b(g[2]) | (f2b(g[3]) << 16); aw.z = f2b(g[4]) | (f2b(g[5]) << 16); aw.w = f2b(g[6]) | (f2b(g[7]) << 16);
      const bf16x8 a = *reinterpret_cast<const bf16x8*>(&aw);
#pragma unroll
      for (int nt = 0; nt < 8; ++nt) { const bf16x8 b = *(const bf16x8*)(W2T + (size_t)(nt * 16 + l15) * 256 + w * 32 + q4 * 8);
          const f32x4 z = {0.f, 0.f, 0.f, 0.f}; red[(w * 8 + nt) * 64 + lane] = __builtin_amdgcn_mfma_f32_16x16x32_bf16(a, b, z, 0, 0, 0); } }
    __syncthreads();
    if (w == 0) {
        bf16_t* OUT = (bf16_t*)(F.ws + WS_CMP + (kv ? 512 * 1024 : 0));
        const float* b2 = kv ? A.in[I_CVB2] : A.in[I_CKB2]; const float* gain = A.in[I_KNC];
        const float* tc = (const float*)(F.ws + WS_COS); const float* tsn = (const float*)(F.ws + WS_SIN);
        f32x4 acc[8]; float bb[8], gg[8];
#pragma unroll
        for (int nt = 0; nt < 8; ++nt) { f32x4 t = red[nt * 64 + lane];
#pragma unroll
            for (int ww = 1; ww < 8; ++ww) t += red[(ww * 8 + nt) * 64 + lane];
            acc[nt] = t; bb[nt] = b2[nt * 16 + l15]; gg[nt] = gain[nt * 16 + l15]; }
#pragma unroll
        for (int r = 0; r < 4; ++r) {
            const int m = rg * 16 + q4 * 4 + r, n = m & 511;
            float v[8]; float ss = 0.f;
#pragma unroll
            for (int nt = 0; nt < 8; ++nt) { v[nt] = acc[nt][r] + bb[nt]; ss += v[nt] * v[nt]; }
            if (kv == 0) {
                ss += __shfl_xor(ss, 1); ss += __shfl_xor(ss, 2); ss += __shfl_xor(ss, 4); ss += __shfl_xor(ss, 8);
                const float rstd = rsqrtf(ss * (1.0f / 128.0f) + 1e-6f);
#pragma unroll
                for (int nt = 0; nt < 8; ++nt) v[nt] = v[nt] * rstd * gg[nt];
                const int pos = n * 16 + 31; const float cs = tc[pos * 16 + l15], sn = tsn[pos * 16 + l15];
                const float x1 = v[0], x2 = v[1]; v[0] = x1 * cs - x2 * sn; v[1] = x2 * cs + x1 * sn;
            }
#pragma unroll
            for (int nt = 0; nt < 8; ++nt) { const float o = (n == 511) ? 0.f : v[nt]; OUT[(size_t)m * 128 + nt * 16 + l15] = (bf16_t)(cvt_pk_bf16(o, o) & 0xffffu); }
        }
    }
    __syncthreads();
}

__device__ __forceinline__ void phase5(const Frame& F, const Args& A) {
    FRESH_TID();
    const int w = F.wave;
    LAS float* xs = (LAS float*)F.lds;
    LAS float* red = (LAS float*)(F.lds + LTAB_OFF);
    LAS int* hist = (LAS int*)(F.lds + LTAB_OFF + 16384);
    LAS int* base = hist + 32;
    const float* X1 = A.in[I_X]; const bf16_t* ATT = (const bf16_t*)(F.ws + WS_H); const float* g2 = A.in[I_N2G]; const float* Wr = A.in[I_WR]; const float* br = A.in[I_BR];
    unsigned char* H2 = (unsigned char*)(F.ws + WS_H2);
    unsigned* slot = (unsigned*)(F.ws + WS_SLOT); int* tokl = (int*)(F.ws + WS_TOKL); float* wl = (float*)(F.ws + WS_WL);
    unsigned* counts = F.ctl + CW_CNT;
    constexpr int XS = 2050;
    float wr0[64], wr1[64];
    { const float* wb = Wr + (size_t)(256 * w + (lane >> 4)) * 32 + (lane & 15);
#pragma unroll
      for (int s = 0; s < 64; ++s) { wr0[s] = wb[(size_t)s * 128]; wr1[s] = wb[(size_t)s * 128 + 16]; } }
    LAS unsigned* rec = (LAS unsigned*)(F.lds + LTAB_OFF + 16384 + 512);
    int ci = 0;
    for (int ch = F.c; ch < NTOK / 16; ch += F.G, ++ci) {
        if ((ci & 3) == 0 && tid < 32) hist[tid] = 0;
        { const int tok0 = ch * 16 + 2 * w;
#pragma unroll 1
          for (int half = 0; half < 2; ++half) {
              const f32x4* xr = (const f32x4*)(X1 + (size_t)(tok0 + half) * DM) + lane; const u32x2* ar = (const u32x2*)(ATT + (size_t)(tok0 + half) * DM) + lane; f32x4 v[8]; u32x2 a[8]; float ssq = 0.f;
#pragma unroll
              for (int j = 0; j < 8; ++j) { v[j] = xr[64 * j]; a[j] = ar[64 * j]; }
#pragma unroll
              for (int j = 0; j < 8; ++j) { v[j][0] += bf_lo(a[j].x); v[j][1] += bf_hi(a[j].x); v[j][2] += bf_lo(a[j].y); v[j][3] += bf_hi(a[j].y);
                  ssq += (v[j][0] * v[j][0] + v[j][1] * v[j][1]) + (v[j][2] * v[j][2] + v[j][3] * v[j][3]); }
              const float rs = rsqrtf(wave_sum(ssq) * (1.0f / DM) + 1e-5f);
              unsigned* oo = (unsigned*)(H2 + (size_t)(tok0 + half) * DM) + lane;
#pragma unroll
              for (int j = 0; j < 8; ++j) { const f32x4 gg = ((const f32x4*)g2)[64 * j + lane];
                  const float y0 = v[j][0] * rs * gg[0], y1 = v[j][1] * rs * gg[1], y2 = v[j][2] * rs * gg[2], y3 = v[j][3] * rs * gg[3];
                  oo[64 * j] = pk4_fp8(y0, y1, y2, y3); LAS f32x2* d = (LAS f32x2*)(xs + (2 * w + half) * XS + (64 * j + lane) * 4); d[0] = (f32x2){y0, y1}; d[1] = (f32x2){y2, y3}; }
          }
        }
        __syncthreads();
        { f32x4 a0 = {0.f, 0.f, 0.f, 0.f}, a1 = {0.f, 0.f, 0.f, 0.f};
          const LAS float* xa = xs + (lane & 15) * XS + 256 * w + (lane >> 4);
#pragma unroll
          for (int s = 0; s < 64; ++s) { const float a = xa[4 * s];
              a0 = __builtin_amdgcn_mfma_f32_16x16x4f32(a, wr0[s], a0, 0, 0, 0); a1 = __builtin_amdgcn_mfma_f32_16x16x4f32(a, wr1[s], a1, 0, 0, 0); }
#pragma unroll
          for (int r = 0; r < 4; ++r) { red[(w * 16 + (lane >> 4) * 4 + r) * 32 + (lane & 15)] = a0[r]; red[(w * 16 + (lane >> 4) * 4 + r) * 32 + 16 + (lane & 15)] = a1[r]; } }
        __syncthreads();
        const int tl = tid >> 5, e = tid & 31, tok = ch * 16 + tl;
        float lg = br[e];
#pragma unroll
        for (int k = 0; k < 8; ++k) lg += red[(k * 16 + tl) * 32 + e];
        float tv[4]; int ti[4];
#pragma unroll
        for (int r = 0; r < 4; ++r) { float bv = lg; int bi = e;
#pragma unroll
            for (int off = 1; off < 32; off <<= 1) { const float ov = __shfl_xor(bv, off); const int oi = __shfl_xor(bi, off); if (ov > bv || (ov == bv && oi < bi)) { bv = ov; bi = oi; } }
            tv[r] = bv; ti[r] = bi; if (e == bi) lg = -INFINITY; }
        const float e1 = __expf(tv[1] - tv[0]), e2 = __expf(tv[2] - tv[0]), e3 = __expf(tv[3] - tv[0]); const float inv = 1.0f / (1.0f + e1 + e2 + e3);
        const int my_e = e == 0 ? ti[0] : e == 1 ? ti[1] : e == 2 ? ti[2] : ti[3];
        const float my_w = (e == 0 ? 1.0f : e == 1 ? e1 : e == 2 ? e2 : e3) * inv;
        if (e < 4) { const int lr = atomicAdd((int*)&hist[my_e], 1); LAS unsigned* r = rec + (((ci & 3) * 64) + tl * 4 + e) * 4;
            r[0] = (unsigned)tok * 4u + (unsigned)e; r[1] = (unsigned)my_e; r[2] = __float_as_uint(my_w); r[3] = (unsigned)lr; }
        const bool lastc = ch + F.G >= NTOK / 16;
        if ((ci & 3) == 3 || lastc) {
            __syncthreads();
            if (tid < 32) { const int hcnt = hist[tid]; base[tid] = hcnt > 0 ? (int)__hip_atomic_fetch_add(counts + 64 * tid, (unsigned)hcnt, RLX_AGENT) : 0; }
            __syncthreads();
            const int nrec = ((ci & 3) + 1) * 64;
            if (tid < nrec) { const LAS unsigned* r = rec + tid * 4; const unsigned ts = r[0], ee = r[1], wb = r[2]; const int rank = base[ee] + (int)r[3];
                __hip_atomic_store((unsigned*)tokl + (size_t)ee * NTOK + rank, ts >> 2, RLX_AGENT); __hip_atomic_store((unsigned*)wl + (size_t)ee * NTOK + rank, wb, RLX_AGENT);
                slot[ts] = (ee << 16) | (unsigned)rank; }
        }
        __syncthreads();
    }
}

__device__ __forceinline__ void moe_tables(const Frame& F) {
    FRESH_TID();
    LAS int* tb = (LAS int*)(F.lds + LTAB_OFF); LAS int* cn = tb + 64;
    if (tid < 32) cn[tid] = (int)__hip_atomic_load(F.ctl + CW_CNT + 64 * tid, RLX_AGENT);
    __syncthreads();
    if (tid == 0) { int acc = 0;
        for (int e = 0; e < 32; ++e) { tb[e] = acc; acc += (cn[e] + 255) >> 8; }
        tb[32] = acc; }
    __syncthreads();
}
__device__ __forceinline__ void phase8(const Frame& F, const Args& A) {
    FRESH_TID();
    const int gw = F.c * NWAVES + F.wave, NGW = F.G * NWAVES;
    const LAS int* tb = (const LAS int*)(F.lds + LTAB_OFF);
    const unsigned* slot = (const unsigned*)(F.ws + WS_SLOT); const bf16_t* Y = (const bf16_t*)(F.ws + WS_YBUF); float* out = A.out;
    for (int tok = gw; tok < NTOK; tok += NGW) {
        const u32x4 sl = *(const u32x4*)(slot + (size_t)tok * 4);
        const size_t r0 = (size_t)tb[sl.x >> 16] * 256 + (sl.x & 0xffffu), r1 = (size_t)tb[sl.y >> 16] * 256 + (sl.y & 0xffffu), r2 = (size_t)tb[sl.z >> 16] * 256 + (sl.z & 0xffffu), r3 = (size_t)tb[sl.w >> 16] * 256 + (sl.w & 0xffffu);
        f32x4* xo = (f32x4*)(out + (size_t)tok * DM) + lane; const f32x4* xi = (const f32x4*)(A.in[I_X] + (size_t)tok * DM) + lane; const u32x2* at = (const u32x2*)((const bf16_t*)(F.ws + WS_H) + (size_t)tok * DM) + lane;
        const u32x2* y0 = (const u32x2*)(Y + r0 * DM) + lane; const u32x2* y1 = (const u32x2*)(Y + r1 * DM) + lane; const u32x2* y2 = (const u32x2*)(Y + r2 * DM) + lane; const u32x2* y3 = (const u32x2*)(Y + r3 * DM) + lane;
#pragma unroll
        for (int j = 0; j < 8; ++j) { f32x4 v = xi[64 * j]; const u32x2 t = at[64 * j]; v[0] += bf_lo(t.x); v[1] += bf_hi(t.x); v[2] += bf_lo(t.y); v[3] += bf_hi(t.y);
            const u32x2 a = y0[64 * j], b = y1[64 * j], c = y2[64 * j], d = y3[64 * j];
            v[0] += (bf_lo(a.x) + bf_lo(b.x)) + (bf_lo(c.x) + bf_lo(d.x)); v[1] += (bf_hi(a.x) + bf_hi(b.x)) + (bf_hi(c.x) + bf_hi(d.x));
            v[2] += (bf_lo(a.y) + bf_lo(b.y)) + (bf_lo(c.y) + bf_lo(d.y)); v[3] += (bf_hi(a.y) + bf_hi(b.y)) + (bf_hi(c.y) + bf_hi(d.y));
            xo[64 * j] = v; }
    }
}

constexpr int NPHASE = 10;
__global__ void __launch_bounds__(NWAVES * 64, 2) hybrid_fwd(Args args) {
    extern __shared__ __attribute__((aligned(16))) unsigned char lds[];
    Frame F;
    F.lds = (LAS unsigned char*)lds; F.ldsg = (char*)lds;
    F.wave = __builtin_amdgcn_readfirstlane((int)(threadIdx.x >> 6));
    F.G = gridDim.x; F.c = blockIdx.x;
    F.ws = args.ws; F.ctl = (unsigned*)(args.ws + WS_CTL);
    volatile LAS unsigned* MISC = (volatile LAS unsigned*)(F.lds + MISC_OFF);
    { const int l0 = fresh_lane(); if (F.wave == 0) MISC[l0] = 0u; }
    __syncthreads();
    XcdBarrier bar; bar.bar = F.ctl + CW_BAR; bar.x = 0; bar.st = nullptr;
    if (args.use_bar) bar = xcd_barrier_post(F.ctl + CW_BAR, MISC + 8, F.wave == 0 && fresh_lane() == 0);
    const int lo = args.ph_lo, hi = args.ph_hi;
#ifndef PHASE_MASK
#define PHASE_MASK 0x3ff
#endif
#define IN(k) ((((PHASE_MASK) >> (k)) & 1) && lo <= (k) && (k) < hi)
#ifndef DBL_MASK
#define DBL_MASK 0
#endif
#define DBL(k) (((DBL_MASK) >> (k)) & 1)
#define SEAM(k) do { if (IN(k) && IN((k) + 1)) xcd_barrier(bar, F.wave == 0 && fresh_lane() == 0); } while (0)

    if (IN(0)) { for (int rep = 0; rep <= DBL(0); ++rep) phase0(F, args); }
    SEAM(0);
    if (IN(1)) for (int rep = 0; rep <= DBL(1); ++rep) {
        pg8::DenseSched S; S.init(F.ws + WS_H, DM, F.ws + WS_WINT, NTOK, NINP, DM, F.G, F.c);
        epi::InProj E{(bf16_t*)(F.ws + WS_Q), (bf16_t*)(F.ws + WS_KV), (bf16_t*)(F.ws + WS_PIN), (float*)(F.ws + WS_GLOG)};
        pg8::gemm_phase(F.lds, S, E, DM * 2, F.wave);
        if (rep == 0) { if (F.G == 256) { if (F.c >= 192) posb_partials(F, args, F.c - 192, 64); } else posb_partials(F, args, F.c, F.G); }
    }
    SEAM(1);
    if (IN(2)) {
        const bool split = F.G >= 128;
        if (!split || F.c < 64) {
            pg8::CmpSched S{(const char*)(F.ws + WS_KV), (const char*)(F.ws + WS_W1T), split ? 64 : F.G, F.c};
            epi::CmpHid E{(float*)(F.ws + WS_ACT)};
            pg8::gemm_phase(F.lds, S, E, 8192, F.wave, 16);
        }
        if (!split || F.c >= 64) { const int ec = split ? F.c - 64 : F.c, eG = split ? F.G - 64 : F.G;
            if (ec == 0 && F.wave == 0) cmp_bias_total(F, args);
            norm_rope_rows(F, args, ec, eG); pool_diffs(F, ec, eG); }
    }
    SEAM(2);
    if (IN(3)) { for (int L = F.c; L < 256; L += F.G) cmp_layer2(F, args, L >> 7, L & 127); }
    SEAM(3);
    if (IN(4)) for (int rep = 0; rep <= DBL(4); ++rep) {
        { pg8::PoolSched S{(const char*)(F.ws + WS_DP), (const char*)(F.ws + WS_PWT), F.G, F.c};
          epi::Pool E{(bf16_t*)(F.ws + WS_MIX), args.in[I_POOLS]};
          pg8::gemm_phase(F.lds, S, E, 512, F.wave); }
        __syncthreads();
        att::Ptrs P{(const bf16_t*)(F.ws + WS_Q), (const bf16_t*)(F.ws + WS_KV), (const bf16_t*)(F.ws + WS_CMP), (const bf16_t*)(F.ws + WS_CMP + 512 * 1024),
                    (const float*)(F.ws + WS_GLOG), (bf16_t*)(F.ws + WS_MIX), (float*)(F.ws + WS_ASCR) + (size_t)F.c * 256 * 128};
        att::Conv cv = att::conv_init(args.in[I_WGU], args.in[I_WD], F.ws, F.c, F.G == 256 && rep == 0);
        for (int r = 0;; ++r) { const int k = r * F.G + ((r & 1) ? (F.G - 1 - F.c) : F.c); if (k >= 512) break;
            const int qi = 127 - (k >> 2), bg = k & 3;
#if ATT_CHECK
            att::attn_item<0, false>(F.ldsg, P, bg >> 1, bg & 1, qi, F.wave, F.ctl + CW_ERR, cv); att::attn_item<1, true>(F.ldsg, P, bg >> 1, bg & 1, qi, F.wave, F.ctl + CW_ERR, cv);
#else
            att::attn_item<1, false>(F.ldsg, P, bg >> 1, bg & 1, qi, F.wave, F.ctl + CW_ERR, cv);
#endif
        }
        att::conv_tail(F.ldsg, cv, F.wave);
        __syncthreads();
    }
    SEAM(4);
    if (IN(5)) for (int rep = 0; rep <= DBL(5); ++rep) {
        pg8::DenseSched S; S.init(F.ws + WS_MIX, DM, F.ws + WS_WOUTT, NTOK, DM, DM, F.G, F.c);
        epi::OutProj E{(bf16_t*)(F.ws + WS_H)};
        pg8::gemm_phase(F.lds, S, E, DM * 2, F.wave);
    }
    SEAM(5);
    if (IN(6)) { phase5(F, args); }
    SEAM(6);
    if (IN(7)) for (int rep = 0; rep <= DBL(7); ++rep) {
        moe_tables(F);
        pg8::MoeSched<16, true> S{(const char*)(F.ws + WS_H2), (const char*)(F.ws + WS_WGU), (const int*)(F.ws + WS_TOKL), (const LAS int*)(F.lds + LTAB_OFF), (const LAS int*)(F.lds + LTAB_OFF) + 64, F.G, F.c, (size_t)4096 * 2048};
        epi::GateUp E{(unsigned char*)(F.ws + WS_ACT), args.in[I_BGU]};
        pg8::gemm_phase(F.lds, S, E, DM, F.wave);
    }
    SEAM(7);
    if (IN(8)) for (int rep = 0; rep <= DBL(8); ++rep) {
        moe_tables(F);
        pg8::MoeSched<8, false> S{(const char*)(F.ws + WS_ACT), (const char*)(F.ws + WS_WD), nullptr, (const LAS int*)(F.lds + LTAB_OFF), (const LAS int*)(F.lds + LTAB_OFF) + 64, F.G, F.c, (size_t)2048 * 2048};
        epi::Down E{(bf16_t*)(F.ws + WS_YBUF), args.in[I_BD], (const float*)(F.ws + WS_WL)};
        pg8::gemm_phase(F.lds, S, E, DFF, F.wave);
    }
    SEAM(8);
    if (IN(9)) { moe_tables(F); phase8(F, args);
#if ATT_CHECK
        if (__hip_atomic_load(F.ctl + CW_ERR, RLX_AGENT) != 0u && F.c == 0 && F.wave == 0) { VM_WAIT(); args.out[fresh_lane()] = __builtin_nanf(""); }
#endif
    }
#undef IN
#undef SEAM
}

#ifndef N_LAUNCH_MODE
#define N_LAUNCH_MODE 1
#endif
extern "C" void kernel_launch(void* const* d_in, const int* in_sizes, int n_in, void* d_out, int out_size, void* d_ws, size_t ws_size, hipStream_t stream) {
    static int grid = 0;
    if (grid == 0) {
        if (n_in != 27 || out_size != NTOK * DM || ws_size < WS_END) { fprintf(stderr, "kernel_launch: unexpected shapes (n_in %d out %d ws %zu)\n", n_in, out_size, ws_size); grid = -1; return; }
        int dev = 0, cus = 0, per_cu = 0;
        if (hipGetDevice(&dev) != hipSuccess || hipDeviceGetAttribute(&cus, hipDeviceAttributeMultiprocessorCount, dev) != hipSuccess) { grid = -1; return; }
        if (hipFuncSetAttribute((const void*)hybrid_fwd, hipFuncAttributeMaxDynamicSharedMemorySize, LDS_BYTES) != hipSuccess) { fprintf(stderr, "kernel_launch: hipFuncSetAttribute failed\n"); grid = -1; return; }
        if (hipOccupancyMaxActiveBlocksPerMultiprocessor(&per_cu, (const void*)hybrid_fwd, NWAVES * 64, LDS_BYTES) != hipSuccess || per_cu < 1) { fprintf(stderr, "kernel_launch: occupancy query says %d\n", per_cu); }
        (void)hipGetLastError();
        grid = cus;
    }
    if (grid < 0) return;
    (void)hipMemsetAsync((char*)d_ws + WS_CTL, 0, CTL_ZERO_BYTES, stream);
    Args a{};
    for (int i = 0; i < 27; ++i) a.in[i] = (const float*)d_in[i];
    a.out = (float*)d_out; a.ws = (unsigned char*)d_ws; a.pad = 0;
    if (N_LAUNCH_MODE == 1) {
        a.ph_lo = 0; a.ph_hi = NPHASE; a.use_bar = 1;
        hipLaunchKernelGGL(hybrid_fwd, dim3(grid), dim3(NWAVES * 64), LDS_BYTES, stream, a);
    } else {
        for (int p = 0; p < NPHASE; ++p) { a.ph_lo = p; a.ph_hi = p + 1; a.use_bar = 0;
            hipLaunchKernelGGL(hybrid_fwd, dim3(grid), dim3(NWAVES * 64), LDS_BYTES, stream, a); }
    }
}
```

```cpp
#include <hip/hip_runtime.h>
#include <cstdio>
#include <cstdint>

#define LAS __attribute__((address_space(3)))
#define GAS __attribute__((address_space(1)))
typedef unsigned short bf16_t;
typedef short bf16x8 __attribute__((ext_vector_type(8)));
typedef short s16x4 __attribute__((ext_vector_type(4)));
typedef float f32x4 __attribute__((ext_vector_type(4)));
typedef float f32x2 __attribute__((ext_vector_type(2)));
typedef float f32x16 __attribute__((ext_vector_type(16)));
typedef unsigned u32x4 __attribute__((ext_vector_type(4)));
typedef unsigned u32x2 __attribute__((ext_vector_type(2)));
typedef int i32x4 __attribute__((ext_vector_type(4)));
typedef int i32x8 __attribute__((ext_vector_type(8)));

constexpr int NB = 2, SEQ = 8192, NTOK = NB * SEQ, DM = 2048, NHEAD = 8, HD = 128, NGRP = 2, NEXP = 32, DFF = 2048;
constexpr int NINP = 3840;
constexpr int NCMP = 512;
constexpr int ACT_ROWS = 4 * NTOK + NEXP * 256;
constexpr int NWAVES = 8;

constexpr size_t MiB = 1u << 20;
constexpr size_t WS_CTL = 0, CTL_ZERO_BYTES = 1 * MiB;
constexpr size_t WS_COS = 1 * MiB, WS_SIN = 2 * MiB;
constexpr size_t WS_POSB64 = 2 * MiB + 655360;
constexpr size_t WS_POSB = 3 * MiB;
constexpr size_t WS_W2T = 3 * MiB + 65536;
constexpr size_t WS_WINT = 4 * MiB;
constexpr size_t WS_WOUTT = 20 * MiB;
constexpr size_t WS_W1T = 28 * MiB;
constexpr size_t WS_PWT = 32 * MiB;
constexpr size_t WS_H = 34 * MiB;
constexpr size_t WS_Q = 98 * MiB;
constexpr size_t WS_KV = 130 * MiB, KV_STRIDE = 9 * MiB;
constexpr size_t WS_PIN = 184 * MiB;
constexpr size_t WS_DP = 216 * MiB;
constexpr size_t WS_GLOG = 248 * MiB;
constexpr size_t WS_HID = 250 * MiB;
constexpr size_t WS_CMP = 252 * MiB;
constexpr size_t WS_MIX = 254 * MiB;
constexpr size_t WS_ASCR = 318 * MiB;
constexpr size_t WS_H2 = 350 * MiB;
constexpr size_t WS_SLOT = 414 * MiB;
constexpr size_t WS_TOKL = 415 * MiB;
constexpr size_t WS_WL = 417 * MiB;
constexpr size_t WS_ACT = 420 * MiB;
constexpr size_t WS_YBUF = 708 * MiB;
constexpr size_t WS_WGU = 1024 * MiB;
constexpr size_t WS_WD = 1536 * MiB;
constexpr size_t WS_END = 1792 * MiB;

constexpr int CW_BAR = 4096;
constexpr int CW_CNT = 8192;
constexpr int CW_ERR = 12288;
#ifndef ATT_CHECK
#define ATT_CHECK 0
#endif

constexpr int RING_BYTES = 131072;
constexpr int LTAB_OFF = 133120;
constexpr int SIDE_OFF = LTAB_OFF + 2048, SIDE_BYTES = 4096;
constexpr int MISC_OFF = LTAB_OFF + 24576;
constexpr int LDS_BYTES = MISC_OFF + 256;

#define RLX_AGENT __ATOMIC_RELAXED, __HIP_MEMORY_SCOPE_AGENT
#define LDS_WAIT() asm volatile("s_waitcnt lgkmcnt(0)" ::: "memory")
#define VM_WAIT() asm volatile("s_waitcnt vmcnt(0)" ::: "memory")
__device__ __forceinline__ unsigned cvt_pk_bf16(float lo, float hi) { unsigned r; asm volatile("v_cvt_pk_bf16_f32 %0, %1, %2" : "=v"(r) : "v"(lo), "v"(hi)); return r; }
__device__ __forceinline__ unsigned cvt_pk_bf16_mfma(float lo, float hi) { unsigned r; asm volatile("v_cvt_pk_bf16_f32 %0, %1, %2\n\ts_nop 1" : "=v"(r) : "v"(lo), "v"(hi)); return r; }
__device__ __forceinline__ float bf_lo(unsigned u) { return __uint_as_float(u << 16); }
__device__ __forceinline__ float bf_hi(unsigned u) { return __uint_as_float(u & 0xffff0000u); }
__device__ __forceinline__ float fast_exp2(float x) { return __builtin_amdgcn_exp2f(x); }
__device__ __forceinline__ float fast_rcp(float x) { return __builtin_amdgcn_rcpf(x); }
__device__ __forceinline__ float sigmoidf_(float x) { return fast_rcp(1.0f + fast_exp2(-1.4426950408889634f * x)); }
__device__ __forceinline__ float wave_sum(float v) {
#define WS_STEP(ctrl, rmask) v += __int_as_float(__builtin_amdgcn_update_dpp(0, __float_as_int(v), ctrl, rmask, 0xf, false))
    WS_STEP(0x111, 0xf); WS_STEP(0x112, 0xf); WS_STEP(0x114, 0xf); WS_STEP(0x118, 0xf); WS_STEP(0x142, 0xa); WS_STEP(0x143, 0xc);
#undef WS_STEP
    return __int_as_float(__builtin_amdgcn_readlane(__float_as_int(v), 63));
}
__device__ __forceinline__ int fresh_lane() { int l; asm volatile("v_mbcnt_lo_u32_b32 %0, -1, 0\n\tv_mbcnt_hi_u32_b32 %0, -1, %0" : "=v"(l)); return l; }

#define XB_TMO      128
#define XB_XCNT(j)  (256  + 64 * (j))
#define XB_XSUB(j)  (1280 + 64 * (j))
#define XB_XGEN(j)  (2304 + 64 * (j))
#define XB_TOP      3328
#define XB_TOPGEN   3392
#define XCD_BAR_WORDS 3456
#define XB_SPIN_CAP (1u << 20)
__device__ __forceinline__ unsigned xb_ld(unsigned* p)              { return __hip_atomic_load(p, __ATOMIC_RELAXED, __HIP_MEMORY_SCOPE_AGENT); }
__device__ __forceinline__ unsigned xb_add(unsigned* p, unsigned v) { return __hip_atomic_fetch_add(p, v, __ATOMIC_RELAXED, __HIP_MEMORY_SCOPE_AGENT); }
__device__ __forceinline__ unsigned xb_xcc_id() { return (unsigned)__builtin_amdgcn_s_getreg((3 << 11) | 20) & 0xFu; }
#define XB_SPIN(cond, bar) do { unsigned _sp = 0; while (cond) { __builtin_amdgcn_s_sleep(1); \
    if ((++_sp & 255u) == 0u) { if (xb_ld(&(bar)[XB_TMO])) break; if (_sp > XB_SPIN_CAP) { atomicAdd(&(bar)[XB_TMO], 1u); break; } } } } while (0)
struct XcdBarrier { unsigned* bar; unsigned x; volatile LAS unsigned* st; };
__device__ __forceinline__ XcdBarrier xcd_barrier_post(unsigned* bar, volatile LAS unsigned* st, bool t0) {
    XcdBarrier b; b.bar = bar; b.x = xb_xcc_id(); b.st = st;
    if (t0) (void)xb_add(&bar[XB_XCNT(b.x)], 1u);
    return b;
}
__device__ __forceinline__ void xcd_barrier_complete(unsigned* bar, unsigned x, unsigned& nloc, unsigned& nx) {
    const unsigned G = gridDim.x * gridDim.y * gridDim.z;
    unsigned sum, cnt, mine, sp = 0u;
    for (;;) {
        sum = 0u; cnt = 0u; mine = 0u;
#pragma unroll
        for (unsigned j = 0; j < 16; ++j) { const unsigned c = xb_ld(&bar[XB_XCNT(j)]); sum += c; cnt += (c > 0u) ? 1u : 0u; mine = (j == x) ? c : mine; }
        if (sum == G) break;
        __builtin_amdgcn_s_sleep(1);
        if ((++sp & 255u) == 0u) { if (xb_ld(&bar[XB_TMO])) break; if (sp > XB_SPIN_CAP) { atomicAdd(&bar[XB_TMO], 1u); break; } }
    }
    nloc = mine > 0u ? mine : 1u; nx = cnt > 0u ? cnt : 1u;
}
__device__ __forceinline__ void xcd_barrier(const XcdBarrier& b, bool t0) {
    asm volatile("s_waitcnt vmcnt(0)" ::: "memory");
    __syncthreads();
    if (t0) {
        unsigned* bar = b.bar;
        __builtin_amdgcn_s_waitcnt(0);
        unsigned nloc = b.st[0], nx = b.st[1];
        if (nloc == 0u) { xcd_barrier_complete(bar, b.x, nloc, nx); b.st[0] = nloc; b.st[1] = nx; }
        const unsigned old = xb_add(&bar[XB_XSUB(b.x)], 1u);
        const unsigned gen = old / nloc;
        if (old + 1u == (gen + 1u) * nloc) {
            __builtin_amdgcn_fence(__ATOMIC_RELEASE, "agent");
            asm volatile("s_waitcnt vmcnt(0)" ::: "memory");
            const unsigned og = xb_add(&bar[XB_TOP], 1u);
            const unsigned tg = og / nx;
            if (og + 1u == (tg + 1u) * nx) xb_add(&bar[XB_TOPGEN], 1u);
            else XB_SPIN(xb_ld(&bar[XB_TOPGEN]) == tg, bar);
            __builtin_amdgcn_fence(__ATOMIC_ACQUIRE, "agent");
            xb_add(&bar[XB_XGEN(b.x)], 1u);
            asm volatile("s_waitcnt vmcnt(0)" ::: "memory");
        } else {
            XB_SPIN(xb_ld(&bar[XB_XGEN(b.x)]) == gen, bar);
            __builtin_amdgcn_fence(__ATOMIC_ACQUIRE, "agent");
            asm volatile("s_waitcnt vmcnt(0)" ::: "memory");
        }
    }
    __syncthreads();
}

struct Args {
    const float* in[27];
    float* out;
    unsigned char* ws;
    int ph_lo, ph_hi;
    int use_bar, pad;
};
enum { I_X = 0, I_N1G, I_WIN, I_QNG, I_KNC, I_KNS, I_KNW, I_CKPOS, I_CKW1, I_CKB1, I_CKW2, I_CKB2, I_CVPOS, I_CVW1, I_CVB1, I_CVW2, I_CVB2,
       I_POOLW, I_POOLS, I_WOUT, I_N2G, I_WR, I_BR, I_WGU, I_BGU, I_WD, I_BD };

#ifndef EPI_DBL_MASK
#define EPI_DBL_MASK 0
#endif
namespace pg8 {
constexpr int BM = 256, BK = 64, HALF = 128, HTB = HALF * BK * 2, STAGE_BYTES = 8 * HTB, NXCD = 8, WGM = 8;
__host__ __device__ __forceinline__ int lds_byte(int r, int c) { const int st = (r >> 4) * 2 + (c >> 5), rr = r & 15, cc = c & 31, ob = rr * 64 + cc * 2; return st * 1024 + (ob ^ (((ob >> 9) & 1) << 5)); }
__host__ __device__ __forceinline__ void stage_rc(int b, int& R, int& C) { const int st = b / 1024, sb = b % 1024, swz = sb ^ (((sb >> 9) & 1) << 5); R = (st >> 1) * 16 + swz / 64; C = (st & 1) * 32 + (swz % 64) / 2; }
__host__ __device__ __forceinline__ int perm32(int rho) { const int n = rho >> 4, i = rho & 15; return 8 * (i >> 2) + 4 * n + (i & 3); }

template <class Epi, class Sched>
__device__ __forceinline__ void gemm_phase(LAS unsigned char* lds, const Sched& S, const Epi& E, const int Kb  , const int wid, const int ntiles = 0  ) {
    const int lane = fresh_lane(), tid = wid * 64 + lane, wr = wid >> 2, wc = wid & 3, fr = lane & 15, fq = lane >> 4;
    const int nt = ntiles ? ntiles : Kb / 128;
    constexpr int BR = Sched::B_K16;
    int Rr[2], Cc[2]; unsigned voffB[2];
#pragma unroll
    for (int i = 0; i < 2; ++i) { int R, C; stage_rc(tid * 16 + i * 8192, R, C); Rr[i] = R; Cc[i] = C; const int Rb = Epi::PERM ? ((R & ~31) + perm32(R & 31)) : R; voffB[i] = BR ? (unsigned)(((C >> 3) * BR + Rb) * 16) : (unsigned)(Rb * Kb) + (unsigned)C * 2u; }
    const size_t kstep = (size_t)(BK * 2);
    const size_t kstepB = BR ? (size_t)8 * BR * 16 : kstep;
    const size_t hstepB = BR ? (size_t)HALF * 16 : (size_t)HALF * Kb;
    const unsigned ldsw = (unsigned)wid * 1024u;
    const int aoff = lds_byte(wr * 64 + fr, fq * 8), boff = lds_byte(wc * 32 + fr, fq * 8);
    const char* const Ab = S.a_base();
#define PG8_SA(b, h) (((b) * 2 + (h)) * HTB)
#define PG8_SB(b, h) ((4 + (b) * 2 + (h)) * HTB)
#define PG8_STAGE(bufoff, gbase, voff) do { _Pragma("unroll") for (int _i = 0; _i < 2; ++_i) \
        __builtin_amdgcn_global_load_lds((const unsigned*)((const char*)(gbase) + (voff)[_i]), (LAS unsigned*)(lds + (bufoff) + ldsw + _i * 8192), 16, 0, 0); } while (0)
#define PG8_LDA(dst, b, h) do { _Pragma("unroll") for (int m = 0; m < 4; ++m) _Pragma("unroll") for (int k = 0; k < 2; ++k) dst[m][k] = *(const LAS bf16x8*)(lds + PG8_SA(b, h) + aoff + m * 2048 + k * 1024); } while (0)
#define PG8_LDB(dst, b, h) do { _Pragma("unroll") for (int n = 0; n < 2; ++n) _Pragma("unroll") for (int k = 0; k < 2; ++k) dst[n][k] = *(const LAS bf16x8*)(lds + PG8_SB(b, h) + boff + n * 2048 + k * 1024); } while (0)
#define PG8_MMA(ai, bj, At, Bt) do { __builtin_amdgcn_s_setprio(1); \
        if constexpr (Epi::FP8) { _Pragma("unroll") for (int m = 0; m < 4; ++m) _Pragma("unroll") for (int n = 0; n < 2; ++n) { \
            const i32x8 _b = __builtin_shufflevector(__builtin_bit_cast(i32x4, Bt[n][0]), __builtin_bit_cast(i32x4, Bt[n][1]), 0, 1, 2, 3, 4, 5, 6, 7); \
            const i32x8 _a = __builtin_shufflevector(__builtin_bit_cast(i32x4, At[m][0]), __builtin_bit_cast(i32x4, At[m][1]), 0, 1, 2, 3, 4, 5, 6, 7); \
            acc[ai][bj][m][n] = __builtin_amdgcn_mfma_scale_f32_16x16x128_f8f6f4(_b, _a, acc[ai][bj][m][n], 0, 0, 0, 0x7f7f7f7f, 0, 0x7f7f7f7f); } } \
        else { _Pragma("unroll") for (int m = 0; m < 4; ++m) _Pragma("unroll") for (int n = 0; n < 2; ++n) _Pragma("unroll") for (int k = 0; k < 2; ++k) \
            acc[ai][bj][m][n] = __builtin_amdgcn_mfma_f32_16x16x32_bf16(Bt[n][k], At[m][k], acc[ai][bj][m][n], 0, 0, 0); } \
        __builtin_amdgcn_s_setprio(0); } while (0)
#define PG8_WAIT_V(n) asm volatile("s_waitcnt vmcnt(" #n ")" ::: "memory")
#define PG8_WAIT_L(n) asm volatile("s_waitcnt lgkmcnt(" #n ")" ::: "memory")
#define PG8_BAR __builtin_amdgcn_s_barrier()
#define PG8_SCHED __builtin_amdgcn_sched_barrier(0)
    typename Sched::Unit cur, nxt; int ui = 0;
    if (!S.next(0, cur)) return;
    f32x4 acc[2][2][4][2];
#pragma unroll
    for (int a = 0; a < 2; ++a)
#pragma unroll
        for (int b = 0; b < 2; ++b)
#pragma unroll
            for (int m = 0; m < 4; ++m)
#pragma unroll
                for (int n = 0; n < 2; ++n) acc[a][b][m][n] = (f32x4){0.f, 0.f, 0.f, 0.f};
    bf16x8 At[4][2], B0[2][2], B1[2][2];
    unsigned offA0[2], offA1[2], nofA0[2], nofA1[2];
#pragma unroll
    for (int i = 0; i < 2; ++i) { offA0[i] = S.a_off(cur, Rr[i], Cc[i]); offA1[i] = S.a_off(cur, HALF + Rr[i], Cc[i]); nofA0[i] = offA0[i]; nofA1[i] = offA1[i]; }
    const char* cB = S.b_ptr(cur);
    PG8_STAGE(PG8_SB(0, 0), cB, voffB); PG8_STAGE(PG8_SA(0, 0), Ab, offA0); PG8_STAGE(PG8_SB(0, 1), cB + hstepB, voffB); PG8_STAGE(PG8_SA(0, 1), Ab, offA1);
    if (wr == 1) PG8_BAR;
    PG8_WAIT_V(4); PG8_BAR;
    PG8_STAGE(PG8_SB(1, 0), cB + kstepB, voffB); PG8_STAGE(PG8_SA(1, 0), Ab + kstep, offA0); PG8_STAGE(PG8_SB(1, 1), cB + hstepB + kstepB, voffB);
    PG8_WAIT_V(6); PG8_BAR;
    for (;;) {
        const bool has_next = S.next(ui + 1, nxt);
        const char* nB = has_next ? S.b_ptr(nxt) : cB;
        if (has_next) {
            if constexpr (Sched::SIDE_IDX) S.stage_idx(lds, nxt, (ui + 1) & 1, wid, lane);
            else {
#pragma unroll
                for (int i = 0; i < 2; ++i) { nofA0[i] = S.a_off(nxt, Rr[i], Cc[i]); nofA1[i] = S.a_off(nxt, HALF + Rr[i], Cc[i]); }
            }
        }
        E.stage(lds, cur, ui & 1, wid, lane);
        for (int t = 0; t < nt; t += 2) {
            const bool last = (t == nt - 2);
            const char* a1 = Ab + (size_t)(t + 1) * kstep;
            PG8_LDB(B0, 0, 0); PG8_SCHED; PG8_LDA(At, 0, 0); PG8_STAGE(PG8_SA(1, 1), a1, offA1);
            if (last) {
                if constexpr (Sched::SIDE_IDX) { if (has_next) {
#pragma unroll
                    for (int i = 0; i < 2; ++i) { nofA0[i] = S.a_off_lds(lds, nxt, (ui + 1) & 1, Rr[i], Cc[i]); nofA1[i] = S.a_off_lds(lds, nxt, (ui + 1) & 1, HALF + Rr[i], Cc[i]); } } }
#pragma unroll
                for (int i = 0; i < 2; ++i) { offA0[i] = nofA0[i]; offA1[i] = nofA1[i]; }
            }
            const char* a2 = last ? Ab : Ab + (size_t)(t + 2) * kstep; const char* b2 = last ? nB : cB + (size_t)(t + 2) * kstepB;
            const char* a3 = a2 + kstep; const char* b3 = b2 + kstepB;
            PG8_WAIT_L(8); PG8_BAR; PG8_WAIT_L(0); PG8_MMA(0, 0, At, B0); PG8_BAR; PG8_SCHED;
            PG8_LDB(B1, 0, 1); PG8_STAGE(PG8_SB(0, 0), b2, voffB);
            PG8_BAR; PG8_WAIT_L(0); PG8_MMA(0, 1, At, B1); PG8_BAR;
            PG8_LDA(At, 0, 1); PG8_STAGE(PG8_SA(0, 0), a2, offA0);
            PG8_BAR; PG8_WAIT_L(0); PG8_MMA(1, 0, At, B0); PG8_BAR; PG8_SCHED;
            PG8_STAGE(PG8_SB(0, 1), b2 + hstepB, voffB);
            PG8_WAIT_V(6); PG8_BAR; PG8_MMA(1, 1, At, B1); PG8_BAR;
            PG8_LDB(B0, 1, 0); PG8_SCHED; PG8_LDA(At, 1, 0); PG8_STAGE(PG8_SA(0, 1), a2, offA1);
            PG8_WAIT_L(8); PG8_BAR; PG8_WAIT_L(0); PG8_MMA(0, 0, At, B0); PG8_BAR; PG8_SCHED;
            PG8_LDB(B1, 1, 1); PG8_STAGE(PG8_SB(1, 0), b3, voffB);
            PG8_BAR; PG8_WAIT_L(0); PG8_MMA(0, 1, At, B1); PG8_BAR;
            PG8_LDA(At, 1, 1); PG8_STAGE(PG8_SA(1, 0), a3, offA0);
            PG8_BAR; PG8_WAIT_L(0); PG8_MMA(1, 0, At, B0); PG8_BAR; PG8_SCHED;
            PG8_STAGE(PG8_SB(1, 1), b3 + hstepB, voffB);
            PG8_WAIT_V(6); PG8_BAR; PG8_MMA(1, 1, At, B1); PG8_BAR;
        }
        E(acc, cur, wr, wc, fr, fq, lds, ui & 1);
        if constexpr ((EPI_DBL_MASK & Epi::ID) != 0) E(acc, cur, wr, wc, fr, fq, lds, ui & 1);
        if (!has_next) break;
#pragma unroll
        for (int a = 0; a < 2; ++a)
#pragma unroll
            for (int b = 0; b < 2; ++b)
#pragma unroll
                for (int m = 0; m < 4; ++m)
#pragma unroll
                    for (int n = 0; n < 2; ++n) acc[a][b][m][n] = (f32x4){0.f, 0.f, 0.f, 0.f};
        cur = nxt; cB = nB; ++ui;
    }
    PG8_WAIT_V(0);
    if (wr == 0) PG8_BAR;
    PG8_BAR;
#undef PG8_SA
#undef PG8_SB
#undef PG8_STAGE
#undef PG8_LDA
#undef PG8_LDB
#undef PG8_MMA
#undef PG8_WAIT_V
#undef PG8_WAIT_L
#undef PG8_BAR
#undef PG8_SCHED
}

struct DUnit { int pm, pn; };
struct DenseSched {
    typedef DUnit Unit; static constexpr bool SIDE_IDX = false; static constexpr int B_K16 = 0;
    const char* A; unsigned lda2; const char* Bt; int K; int nM, nN, nwg, G, c;
    __device__ __forceinline__ void init(const void* A_, int lda, const void* Bt_, int M, int N, int K_, int G_, int c_) { A = (const char*)A_; lda2 = (unsigned)lda * 2u; Bt = (const char*)Bt_; K = K_; nM = M / BM; nN = N / BM; nwg = nM * nN; G = G_; c = c_; }
    __device__ __forceinline__ bool next(int i, Unit& u) const {
        const long L = (long)i * G + c; if (L >= nwg) return false;
        int wgid = (int)L; { const int q = nwg / NXCD, r = nwg % NXCD, xcd = wgid % NXCD, off = wgid / NXCD; wgid = (xcd < r ? xcd * (q + 1) : r * (q + 1) + (xcd - r) * q) + off; }
        const int nig = WGM * nN, gid = wgid / nig, fm = gid * WGM, gsz = (nM - fm) < WGM ? (nM - fm) : WGM;
        u.pm = fm + ((wgid % nig) % gsz); u.pn = (wgid % nig) / gsz; return true;
    }
    __device__ __forceinline__ const char* a_base() const { return A; }
    __device__ __forceinline__ unsigned a_off(const Unit& u, int r, int C) const { return (unsigned)(u.pm * BM + r) * lda2 + (unsigned)C * 2u; }
    __device__ __forceinline__ const char* b_ptr(const Unit& u) const { return Bt + (size_t)u.pn * BM * K * 2; }
};
}

namespace epi {
using pg8::BM; using pg8::HALF;
struct InProj {
    __device__ __forceinline__ void stage(LAS unsigned char*, const pg8::DUnit&, int, int, int) const {}
    static constexpr bool PERM = true; static constexpr int ID = 1; static constexpr bool FP8 = false;
    bf16_t* Q; bf16_t* KV; bf16_t* PIN; float* GLOG;
    __device__ __forceinline__ void operator()(const f32x4 (&acc)[2][2][4][2], const pg8::DUnit& u, int wr, int wc, int fr, int fq, LAS unsigned char*, int) const {
        const int row0 = u.pm * BM + wr * 64 + fr, cw = wc * 32 + 8 * fq;
#pragma unroll
        for (int ai = 0; ai < 2; ++ai)
#pragma unroll
            for (int m = 0; m < 4; ++m) {
                const int row = row0 + ai * HALF + m * 16;
#pragma unroll
                for (int bj = 0; bj < 2; ++bj) {
                    const f32x4 v0 = acc[ai][bj][m][0], v1 = acc[ai][bj][m][1];
                    if (u.pn == 14) {
                        if (bj == 0 && cw < 24) { float* g = GLOG + (size_t)row * 32 + cw; *(f32x4*)g = v0; *(f32x4*)(g + 4) = v1; }
                    } else {
                        u32x4 w; w.x = cvt_pk_bf16(v0[0], v0[1]); w.y = cvt_pk_bf16(v0[2], v0[3]); w.z = cvt_pk_bf16(v1[0], v1[1]); w.w = cvt_pk_bf16(v1[2], v1[3]);
                        bf16_t* dst;
                        if (u.pn < 4) dst = Q + (size_t)row * 1024 + u.pn * 256 + bj * 128 + cw;
                        else if (u.pn < 10) { const int b = row >> 13, s = row & 8191; dst = KV + (size_t)(u.pn - 4) * (KV_STRIDE / 2) + ((size_t)((b * 2 + bj) * SEQ + s)) * 128 + cw; }
                        else dst = PIN + (size_t)row * 1024 + (u.pn - 10) * 256 + bj * 128 + cw;
                        *(u32x4*)dst = w;
                    }
                }
            }
    }
};
struct CUnit { int kv, pm, ks; };
struct CmpHid {
    __device__ __forceinline__ void stage(LAS unsigned char*, const CUnit&, int, int, int) const {}
    static constexpr bool PERM = false; static constexpr int ID = 2; static constexpr bool FP8 = false;
    float* HIDP;
    __device__ __forceinline__ void operator()(const f32x4 (&acc)[2][2][4][2], const CUnit& u, int wr, int wc, int fr, int fq, LAS unsigned char*, int) const {
        const int row0 = u.pm * BM + wr * 64 + fr, col0 = wc * 32 + 4 * fq;
        float* base = HIDP + ((size_t)(u.ks * 2 + u.kv) * 2048) * 256;
#pragma unroll
        for (int ai = 0; ai < 2; ++ai)
#pragma unroll
            for (int m = 0; m < 4; ++m) { float* rowp = base + (size_t)(row0 + ai * HALF + m * 16) * 256 + col0;
#pragma unroll
                for (int bj = 0; bj < 2; ++bj)
#pragma unroll
                    for (int n = 0; n < 2; ++n) *(f32x4*)(rowp + bj * HALF + n * 16) = acc[ai][bj][m][n]; }
    }
};
struct PUnit { int g, pm; };
struct Pool {
    __device__ __forceinline__ void stage(LAS unsigned char*, const PUnit&, int, int, int) const {}
    static constexpr bool PERM = true; static constexpr int ID = 4; static constexpr bool FP8 = false;
    bf16_t* MIX; const float* scale;
    __device__ __forceinline__ void operator()(const f32x4 (&acc)[2][2][4][2], const PUnit& u, int wr, int wc, int fr, int fq, LAS unsigned char*, int) const {
        const int row0 = u.pm * BM + wr * 64 + fr, cw = wc * 32 + 8 * fq;
        float sc[2][8];
#pragma unroll
        for (int bj = 0; bj < 2; ++bj)
#pragma unroll
            for (int j = 0; j < 8; ++j) sc[bj][j] = scale[u.g * 256 + bj * 128 + cw + j];
#pragma unroll
        for (int ai = 0; ai < 2; ++ai)
#pragma unroll
            for (int m = 0; m < 4; ++m) {
                const int row = row0 + ai * HALF + m * 16;
#pragma unroll
                for (int bj = 0; bj < 2; ++bj) {
                    float v[8];
#pragma unroll
                    for (int j = 0; j < 8; ++j) v[j] = acc[ai][bj][m][j >> 2][j & 3] * sc[bj][j];
                    u32x4 w; w.x = cvt_pk_bf16(v[0], v[1]); w.y = cvt_pk_bf16(v[2], v[3]); w.z = cvt_pk_bf16(v[4], v[5]); w.w = cvt_pk_bf16(v[6], v[7]);
                    *(u32x4*)(MIX + (size_t)row * 2048 + 1024 + u.g * 256 + bj * 128 + cw) = w;
                }
            }
    }
};
struct OutProj {
    __device__ __forceinline__ void stage(LAS unsigned char*, const pg8::DUnit&, int, int, int) const {}
    static constexpr bool PERM = true; static constexpr int ID = 8; static constexpr bool FP8 = false;
    bf16_t* ATT;
    __device__ __forceinline__ void operator()(const f32x4 (&acc)[2][2][4][2], const pg8::DUnit& u, int wr, int wc, int fr, int fq, LAS unsigned char*, int) const {
        const int row0 = u.pm * BM + wr * 64 + fr, cw = u.pn * BM + wc * 32 + 8 * fq;
#pragma unroll
        for (int ai = 0; ai < 2; ++ai)
#pragma unroll
            for (int m = 0; m < 4; ++m) { bf16_t* rowp = ATT + (size_t)(row0 + ai * HALF + m * 16) * DM + cw;
#pragma unroll
                for (int bj = 0; bj < 2; ++bj) { const f32x4 v0 = acc[ai][bj][m][0], v1 = acc[ai][bj][m][1];
                    u32x4 w; w.x = cvt_pk_bf16(v0[0], v0[1]); w.y = cvt_pk_bf16(v0[2], v0[3]); w.z = cvt_pk_bf16(v1[0], v1[1]); w.w = cvt_pk_bf16(v1[2], v1[3]);
                    *(u32x4*)(rowp + bj * HALF) = w; } }
    }
};
struct MUnit { int e, pm, pn, rowbase, cnt; };
constexpr float W8_SCALE = 64.0f, W8_INV = 1.0f / 64.0f;
struct GateUp {
    static constexpr bool PERM = true; static constexpr int ID = 16; static constexpr bool FP8 = true;
    unsigned char* ACT; const float* bgu;
    __device__ __forceinline__ void stage(LAS unsigned char* lds, const MUnit& u, int par, int wid, int lane) const {
        if (wid < 4) { const float* src = bgu + (size_t)u.e * 4096 + (wid >> 1) * 2048 + u.pn * 128 + (wid & 1) * 64 + lane;
            __builtin_amdgcn_global_load_lds((const unsigned*)src, (LAS unsigned*)(lds + SIDE_OFF + par * SIDE_BYTES + 1024 + wid * 256), 4, 0, 0); }
    }
    __device__ __forceinline__ void operator()(const f32x4 (&acc)[2][2][4][2], const MUnit& u, int wr, int wc, int fr, int fq, LAS unsigned char* lds, int par) const {
        const int row0 = u.rowbase + wr * 64 + fr, cw = wc * 32 + 8 * fq, j0 = u.pn * 128 + cw;
        float bg[8], bu[8];
        { const LAS f32x4* sb = (const LAS f32x4*)(lds + SIDE_OFF + par * SIDE_BYTES + 1024);
          const f32x4 g0 = sb[cw >> 2], g1 = sb[(cw >> 2) + 1], u0 = sb[32 + (cw >> 2)], u1 = sb[33 + (cw >> 2)];
#pragma unroll
          for (int j = 0; j < 4; ++j) { bg[j] = g0[j]; bg[4 + j] = g1[j]; bu[j] = u0[j]; bu[4 + j] = u1[j]; } }
#pragma unroll
        for (int ai = 0; ai < 2; ++ai)
#pragma unroll
            for (int m = 0; m < 4; ++m) {
                const int row = row0 + ai * HALF + m * 16;
                float v[8];
#pragma unroll
                for (int j = 0; j < 8; ++j) {
                    float g = fmaf(acc[ai][0][m][j >> 2][j & 3], W8_INV, bg[j]), up = fmaf(acc[ai][1][m][j >> 2][j & 3], W8_INV, bu[j]);
                    g = fminf(g, 7.0f); up = fminf(fmaxf(up, -7.0f), 7.0f);
                    v[j] = (up + 1.0f) * g * fast_rcp(1.0f + fast_exp2(-2.4554669595930157f * g));
                }
                u32x2 w; int p = __builtin_amdgcn_cvt_pk_fp8_f32(v[0], v[1], 0, false); p = __builtin_amdgcn_cvt_pk_fp8_f32(v[2], v[3], p, true); w.x = (unsigned)p;
                p = __builtin_amdgcn_cvt_pk_fp8_f32(v[4], v[5], 0, false); p = __builtin_amdgcn_cvt_pk_fp8_f32(v[6], v[7], p, true); w.y = (unsigned)p;
                *(u32x2*)(ACT + (size_t)row * 2048 + j0) = w;
            }
    }
};
struct Down {
    static constexpr bool PERM = true; static constexpr int ID = 32; static constexpr bool FP8 = true;
    bf16_t* YBUF; const float* bd; const float* WL;
    __device__ __forceinline__ void stage(LAS unsigned char* lds, const MUnit& u, int par, int wid, int lane) const {
        const float* src = wid < 4 ? bd + (size_t)u.e * 2048 + u.pn * 256 + wid * 64 + lane : WL + (size_t)u.e * NTOK + u.pm * 256 + (wid - 4) * 64 + lane;
        __builtin_amdgcn_global_load_lds((const unsigned*)src, (LAS unsigned*)(lds + SIDE_OFF + par * SIDE_BYTES + 1024 + wid * 256), 4, 0, 0);
    }
    __device__ __forceinline__ void operator()(const f32x4 (&acc)[2][2][4][2], const MUnit& u, int wr, int wc, int fr, int fq, LAS unsigned char* lds, int par) const {
        const int rl0 = wr * 64 + fr, cw = wc * 32 + 8 * fq;
        float bias[2][8];
        const LAS f32x4* sb = (const LAS f32x4*)(lds + SIDE_OFF + par * SIDE_BYTES + 1024);
        const LAS float* sw = (const LAS float*)(lds + SIDE_OFF + par * SIDE_BYTES + 2048);
#pragma unroll
        for (int bj = 0; bj < 2; ++bj) { const f32x4 b0 = sb[bj * 32 + (cw >> 2)], b1 = sb[bj * 32 + (cw >> 2) + 1];
#pragma unroll
            for (int j = 0; j < 4; ++j) { bias[bj][j] = b0[j]; bias[bj][4 + j] = b1[j]; } }
#pragma unroll
        for (int ai = 0; ai < 2; ++ai)
#pragma unroll
            for (int m = 0; m < 4; ++m) {
                const float wt = sw[rl0 + ai * HALF + m * 16];
                const size_t row = (size_t)(u.rowbase + rl0 + ai * HALF + m * 16);
#pragma unroll
                for (int bj = 0; bj < 2; ++bj) {
                    float v[8];
#pragma unroll
                    for (int j = 0; j < 8; ++j) v[j] = fmaf(acc[ai][bj][m][j >> 2][j & 3], W8_INV, bias[bj][j]) * wt;
                    u32x4 w; w.x = cvt_pk_bf16(v[0], v[1]); w.y = cvt_pk_bf16(v[2], v[3]); w.z = cvt_pk_bf16(v[4], v[5]); w.w = cvt_pk_bf16(v[6], v[7]);
                    *(u32x4*)(YBUF + row * 2048 + u.pn * 256 + bj * 128 + cw) = w;
                }
            }
    }
};
}

namespace pg8 {
struct CmpSched {
    typedef epi::CUnit Unit; static constexpr bool SIDE_IDX = false; static constexpr int B_K16 = 0;
    const char* A; const char* Bt; int G, c;
    __device__ __forceinline__ bool next(int i, Unit& u) const { const int L = i * G + c; if (L >= 64) return false; u.kv = L >> 5; u.pm = (L >> 2) & 7; u.ks = L & 3; return true; }
    __device__ __forceinline__ const char* a_base() const { return A; }
    __device__ __forceinline__ unsigned a_off(const Unit& u, int r, int C) const { return (unsigned)(u.kv * (int)KV_STRIDE) + (unsigned)(u.pm * BM + r) * 4096u + (unsigned)u.ks * 2048u + (unsigned)C * 2u; }
    __device__ __forceinline__ const char* b_ptr(const Unit& u) const { return Bt + (size_t)u.kv * 256 * 4096 * 2 + (size_t)u.ks * 2048; }
};
struct PoolSched {
    typedef epi::PUnit Unit; static constexpr bool SIDE_IDX = false; static constexpr int B_K16 = 0;
    const char* A; const char* Bt; int G, c;
    __device__ __forceinline__ bool next(int i, Unit& u) const { const int L = i * G + c; if (L >= 256) return false; u.g = L >> 6; u.pm = L & 63; return true; }
    __device__ __forceinline__ const char* a_base() const { return A; }
    __device__ __forceinline__ unsigned a_off(const Unit& u, int r, int C) const { return (unsigned)(u.pm * BM + r) * 2048u + (unsigned)(u.g * 256 + C) * 2u; }
    __device__ __forceinline__ const char* b_ptr(const Unit& u) const { return Bt + (size_t)u.g * 256 * 256 * 2; }
};
template <int NTN, bool GATHER>
struct MoeSched {
    typedef epi::MUnit Unit; static constexpr bool SIDE_IDX = GATHER; static constexpr int B_K16 = NTN * 256;
    __device__ __forceinline__ void stage_idx(LAS unsigned char* lds, const Unit& u, int par, int wid, int lane) const {
        if (wid >= 4) __builtin_amdgcn_global_load_lds((const unsigned*)(tokl + (size_t)u.e * NTOK + u.pm * 256 + (wid - 4) * 64 + lane), (LAS unsigned*)(lds + SIDE_OFF + par * SIDE_BYTES + (wid - 4) * 256), 4, 0, 0);
    }
    __device__ __forceinline__ unsigned a_off_lds(LAS unsigned char* lds, const Unit& u, int par, int r, int C) const {
        const unsigned tok = ((const LAS unsigned*)(lds + SIDE_OFF + par * SIDE_BYTES))[r]; return (tok < (unsigned)NTOK ? tok : 0u) * 2048u + (unsigned)C * 2u;
    }
    const char* A; const char* Bt; const int* tokl; const LAS int* tb; const LAS int* cn; int G, c; size_t bstride;
    __device__ __forceinline__ bool next(int i, Unit& u) const {
        const int L = i * G + c, tile = L / NTN; if (tile >= tb[32]) return false;
        int e = -1;
        { const LAS i32x4* t4 = (const LAS i32x4*)tb;
#pragma unroll
          for (int k = 0; k < 8; ++k) { const i32x4 v = t4[k]; e += (v.x <= tile) + (v.y <= tile) + (v.z <= tile) + (v.w <= tile); } }
        u.e = e; u.pm = tile - tb[e]; u.pn = L % NTN; u.rowbase = tile * 256; u.cnt = cn[e]; return true;
    }
    __device__ __forceinline__ const char* a_base() const { return A; }
    __device__ __forceinline__ unsigned a_off(const Unit& u, int r, int C) const {
        if (GATHER) { int rl = u.pm * 256 + r; rl = rl < u.cnt ? rl : u.cnt - 1; const int tok = tokl[(size_t)u.e * NTOK + rl]; return (unsigned)tok * 2048u + (unsigned)C * 2u; }
        else return (unsigned)(u.rowbase + r) * 2048u + (unsigned)C * 2u;
    }
    __device__ __forceinline__ const char* b_ptr(const Unit& u) const { return Bt + (size_t)u.e * bstride + (size_t)u.pn * BM * 16; }
};
}

namespace att {
constexpr float SCALE = 0.08838834764831845f, CLOG = SCALE * 1.4426950408889634f;
constexpr float THR_RAW = 8.0f / SCALE;
constexpr int SHM_V = 16384, SHM_K = 16384;
constexpr int NKVB = 2;
constexpr int L_V = 0, L_K = NKVB * SHM_V, L_CV0 = NKVB * (SHM_V + SHM_K), L_WS = 98304, L_BS = L_WS + NWAVES * 64 * 4;
static_assert(L_CV0 + 32768 <= L_WS, "attention LDS");
constexpr int BS_STRIDE = 129;
constexpr int L_SEL = L_BS + 64 * BS_STRIDE * 4;
constexpr int L_UNI = L_SEL + 64 * 16;
constexpr int L_LIST = L_UNI + 32;
constexpr int L_END = L_LIST + 128 * 4;
static_assert(L_END <= MISC_OFF, "attention LDS");
#define KSWZ(row, colB) ((row) * 256 + ((colB) ^ (((row) & 7) << 4)))
#define SBAR() __builtin_amdgcn_sched_barrier(0)
__device__ __forceinline__ int crow(int r, int hi) { return (r & 3) + 8 * (r >> 2) + 4 * hi; }
__device__ __forceinline__ void qkt(f32x16& p0, f32x16& p1, const char* Ks, const bf16x8* qr, int r32, int hi) {
    p0 = f32x16{}; p1 = f32x16{};
#pragma unroll
    for (int d0 = 0; d0 < 8; ++d0) { const int cb = (d0 * 16 + hi * 8) * 2;
        const bf16x8 b0 = *reinterpret_cast<const bf16x8*>(Ks + KSWZ(r32, cb));
        const bf16x8 b1 = *reinterpret_cast<const bf16x8*>(Ks + KSWZ(32 + r32, cb));
        p0 = __builtin_amdgcn_mfma_f32_32x32x16_bf16(b0, qr[d0], p0, 0, 0, 0);
        p1 = __builtin_amdgcn_mfma_f32_32x32x16_bf16(b1, qr[d0], p1, 0, 0, 0); }
}
__device__ __forceinline__ int v_st(int k, int c) { const int kk = (k & ~0xC) | ((k & 4) << 1) | ((k & 8) >> 1); return ((kk >> 3) * 4 + (c >> 5)) * 512 + ((kk & 7) * 32 + (c & 31)) * 2; }
__device__ __forceinline__ int v_rd_base(int lane) { return ((lane & 3) << 3) | (((lane >> 2) & 3) << 6) | (((lane >> 4) & 1) << 5) | (((lane >> 5) & 1) << 8); }
constexpr int v_rd_off(int d0, int ks, int half) { return d0 * 512 + ks * 4096 + half * 2048; }
template <int OFF> __device__ __forceinline__ s16x4 tr_read(int vb) {
    s16x4 r; asm volatile("ds_read_b64_tr_b16 %0, %1 offset:%2" : "=&v"(r) : "v"(vb), "i"(OFF) : "memory"); return r;
}
template <int D0> __device__ __forceinline__ void pv_one(f32x16& od, int vb, bf16x8 pa0, bf16x8 pa1, bf16x8 pa2, bf16x8 pa3) {
    const s16x4 l0 = tr_read<v_rd_off(D0, 0, 0)>(vb), h0 = tr_read<v_rd_off(D0, 0, 1)>(vb), l1 = tr_read<v_rd_off(D0, 1, 0)>(vb), h1 = tr_read<v_rd_off(D0, 1, 1)>(vb);
    const s16x4 l2 = tr_read<v_rd_off(D0, 2, 0)>(vb), h2 = tr_read<v_rd_off(D0, 2, 1)>(vb), l3 = tr_read<v_rd_off(D0, 3, 0)>(vb), h3 = tr_read<v_rd_off(D0, 3, 1)>(vb);
    asm volatile("s_waitcnt lgkmcnt(0)" ::: "memory"); SBAR();
#define PKV(L, H) (bf16x8){L[0], L[1], L[2], L[3], H[0], H[1], H[2], H[3]}
    od = __builtin_amdgcn_mfma_f32_32x32x16_bf16(pa0, PKV(l0, h0), od, 0, 0, 0);
    od = __builtin_amdgcn_mfma_f32_32x32x16_bf16(pa1, PKV(l1, h1), od, 0, 0, 0);
    od = __builtin_amdgcn_mfma_f32_32x32x16_bf16(pa2, PKV(l2, h2), od, 0, 0, 0);
    od = __builtin_amdgcn_mfma_f32_32x32x16_bf16(pa3, PKV(l3, h3), od, 0, 0, 0);
#undef PKV
}
__device__ __forceinline__ void pv_d0(f32x16* o, int vb, bf16x8 pa0, bf16x8 pa1, bf16x8 pa2, bf16x8 pa3) {
    pv_one<0>(o[0], vb, pa0, pa1, pa2, pa3); pv_one<1>(o[1], vb, pa0, pa1, pa2, pa3); pv_one<2>(o[2], vb, pa0, pa1, pa2, pa3); pv_one<3>(o[3], vb, pa0, pa1, pa2, pa3);
}
__device__ __forceinline__ void pack_p(const f32x16& p0, const f32x16& p1, bf16x8& pa0, bf16x8& pa1, bf16x8& pa2, bf16x8& pa3) {
#define PK4(P, BASE, OUT) do { unsigned a0 = cvt_pk_bf16(P[BASE + 0], P[BASE + 1]), a1 = cvt_pk_bf16(P[BASE + 2], P[BASE + 3]);   \
    unsigned b0 = cvt_pk_bf16(P[BASE + 4], P[BASE + 5]), b1 = cvt_pk_bf16(P[BASE + 6], P[BASE + 7]);                              \
    auto r0 = __builtin_amdgcn_permlane32_swap(a0, b0, false, false); auto r1 = __builtin_amdgcn_permlane32_swap(a1, b1, false, false); \
    u32x4 w = {r0[0], r1[0], r0[1], r1[1]}; OUT = *reinterpret_cast<bf16x8*>(&w); } while (0)
    PK4(p0, 0, pa0); PK4(p0, 8, pa1); PK4(p1, 0, pa2); PK4(p1, 8, pa3);
#undef PK4
}
__device__ __forceinline__ float half_max(float v) { auto rr = __builtin_amdgcn_permlane32_swap(__float_as_uint(v), __float_as_uint(v), false, false); return fmaxf(__uint_as_float(rr[0]), __uint_as_float(rr[1])); }
__device__ __forceinline__ float half_sum(float v) { auto rr = __builtin_amdgcn_permlane32_swap(__float_as_uint(v), __float_as_uint(v), false, false); return __uint_as_float(rr[0]) + __uint_as_float(rr[1]); }

struct Ptrs { const bf16_t* Q; const bf16_t* KV; const bf16_t* KCMP; const bf16_t* VCMP; const float* GLOG; bf16_t* MIX; float* scr; };

template <int MODE>
__device__ __forceinline__ void branch_ref(char* lds, const bf16_t* Kb, const bf16_t* Vb, const bf16x8* qr, int ntiles, int qi, int qoff, int nmax,
                                       const unsigned (&selw)[4], float& m_reg, float& l_reg, float inv_l, f32x16* o, const int wid) {
    const int lane = fresh_lane(), tid = wid * 64 + lane, r32 = lane & 31, hi = lane >> 5;
    char* V_lds = lds + L_V; char* K_lds = lds + L_K;
    float* al_l = (float*)(lds + L_WS) + wid * 64 + 32;
    float* bs = (float*)(lds + L_BS);
    const int* tlist = (const int*)(lds + L_LIST);
    const int sr = tid >> 4, sc = (tid & 15) * 8, vst0 = v_st(sr, sc), vst1 = v_st(32 + sr, sc);
    const int vb0 = (int)(uintptr_t)V_lds + v_rd_base(lane);
    const int j0w = (qi - 8 > 0) ? qi - 8 : 0;
    bf16x8 vs0, vs1, ks0, ks1;
#define TILE_OF(i) (MODE <= 1 ? (i) : (MODE == 2 ? tlist[i] : j0w + (i)))
#define SLOADT(j) do { const size_t k0 = (size_t)(j) * 64; ks0 = *(const bf16x8*)(Kb + (k0 + sr) * 128 + sc); ks1 = *(const bf16x8*)(Kb + (k0 + 32 + sr) * 128 + sc); \
        if (MODE != 0) { vs0 = *(const bf16x8*)(Vb + (k0 + sr) * 128 + sc); vs1 = *(const bf16x8*)(Vb + (k0 + 32 + sr) * 128 + sc); } } while (0)
#define SWRITET(b) do { const int kc = sc * 2; *(bf16x8*)(K_lds + (b) * SHM_K + KSWZ(sr, kc)) = ks0; *(bf16x8*)(K_lds + (b) * SHM_K + KSWZ(32 + sr, kc)) = ks1; \
        if (MODE != 0) { *(bf16x8*)(V_lds + (b) * SHM_V + vst0) = vs0; *(bf16x8*)(V_lds + (b) * SHM_V + vst1) = vs1; } } while (0)
    SLOADT(TILE_OF(0)); SWRITET(0); __syncthreads();
    for (int i = 0; i < ntiles; ++i) {
        const int j = TILE_OF(i), buf = i & 1;
        if (i + 1 < ntiles) SLOADT(TILE_OF(i + 1));
        f32x16 p0, p1;
        qkt(p0, p1, K_lds + buf * SHM_K, qr, r32, hi);
        int lo = 0, hi_ = 63;
        if (MODE <= 1) hi_ = nmax - j * 64;
        else if (MODE == 2) { const int jw = j >> 5; const unsigned sw_ = jw == 0 ? selw[0] : jw == 1 ? selw[1] : jw == 2 ? selw[2] : selw[3]; const bool sel = (sw_ >> (j & 31)) & 1u; hi_ = sel ? (j == qi ? qoff : 63) : -1; }
        else { if (j == qi) hi_ = qoff; else if (j == qi - 8) lo = qoff + 1; }
        const int lo4 = lo - 4 * hi, hi4 = hi_ - 4 * hi;
        float pmax = -INFINITY;
#pragma unroll
        for (int r = 0; r < 16; ++r) { const int kc0 = (r & 3) + 8 * (r >> 2);
            p0[r] = (kc0 >= lo4 && kc0 <= hi4) ? p0[r] : -INFINITY; p1[r] = (kc0 + 32 >= lo4 && kc0 + 32 <= hi4) ? p1[r] : -INFINITY;
            pmax = fmaxf(pmax, fmaxf(p0[r], p1[r])); }
        float alpha = 1.f;
        if (MODE != 1) {
            pmax = half_max(pmax);
            const float mn = fmaxf(m_reg, pmax); alpha = fast_exp2((m_reg - mn) * CLOG); m_reg = mn;
        }
        const float mnC = -m_reg * CLOG;
        float ps = 0.f;
#pragma unroll
        for (int r = 0; r < 16; ++r) { p0[r] = fast_exp2(fmaf(p0[r], CLOG, mnC)); p1[r] = fast_exp2(fmaf(p1[r], CLOG, mnC)); ps += p0[r] + p1[r]; }
        if (MODE != 1) { ps = half_sum(ps); l_reg = l_reg * alpha + ps; }
        if (MODE == 1) {
#pragma unroll
            for (int r = 0; r < 16; ++r) { p0[r] *= inv_l; p1[r] *= inv_l; }
            unsigned* row = (unsigned*)bs + qoff * BS_STRIDE + j * 16 + hi;
#pragma unroll
            for (int a = 0; a < 4; ++a) {
                const float s0 = 2.f * (p0[4 * a] + p0[4 * a + 1] + p0[4 * a + 2]) + p0[4 * a + 3], s1 = 2.f * (p1[4 * a] + p1[4 * a + 1] + p1[4 * a + 2]) + p1[4 * a + 3];
                atomicAdd(row + 2 * a, (unsigned)(s0 * 67108864.f + 0.5f)); atomicAdd(row + 2 * a + 1, (unsigned)(p0[4 * a + 3] * 67108864.f + 0.5f));
                atomicAdd(row + 8 + 2 * a, (unsigned)(s1 * 67108864.f + 0.5f)); atomicAdd(row + 8 + 2 * a + 1, (unsigned)(p1[4 * a + 3] * 67108864.f + 0.5f));
            }
        }
        if (MODE != 0) {
            if (MODE != 1) {
                if (__any(alpha < 1.f)) { if (hi == 0) al_l[r32] = alpha; asm volatile("s_waitcnt lgkmcnt(0)" ::: "memory");
#pragma unroll
                    for (int d = 0; d < 4; ++d)
#pragma unroll
                        for (int r = 0; r < 16; ++r) o[d][r] *= al_l[crow(r, hi)]; }
            }
            bf16x8 pa0, pa1, pa2, pa3;
            pack_p(p0, p1, pa0, pa1, pa2, pa3);
            pv_d0(o, vb0 + buf * SHM_V, pa0, pa1, pa2, pa3);
        }
        if (i + 1 < ntiles) SWRITET(buf ^ 1);
        __syncthreads();
    }
#undef TILE_OF
#undef SLOADT
#undef SWRITET
}


struct Conv { const char* gsrc; const char* dsrc; unsigned char* gdst; unsigned char* ddst; int gn0, dn0, next, total; };
constexpr int L_CV1 = L_BS;
static_assert(64 * BS_STRIDE * 4 >= 32768, "conversion buffer 1");
__device__ __forceinline__ Conv conv_init(const float* wgu, const float* wd, unsigned char* ws, int c, bool on) {
    Conv cv;
    cv.gsrc = (const char*)(wgu + (size_t)(c >> 3) * 16 * 4096 + (c & 7) * 512);
    cv.gdst = ws + WS_WGU + (size_t)(c >> 3) * 4096 * 16;
    cv.dsrc = (const char*)(wd + (size_t)(c >> 2) * 16 * 2048 + (c & 3) * 512) - ((size_t)128 << 23);
    cv.ddst = ws + WS_WD + (size_t)(c >> 2) * 2048 * 16 - ((size_t)128 << 21);
    cv.gn0 = (c & 7) * 512; cv.dn0 = (c & 3) * 512; cv.next = 0; cv.total = on ? 192 : 0;
    return cv;
}
__device__ __forceinline__ void conv_issue(LAS unsigned char* ldsl, int cb, const Conv& cv, int L, const int wid, const int lane) {
    const bool gu = L < 128; const int sh = gu ? 14 : 13;
    const char* src = (gu ? cv.gsrc : cv.dsrc) + ((size_t)L << 23) + wid * 256;
    const unsigned voff = ((unsigned)(lane >> 4) << sh) + (unsigned)(lane & 15) * 16u;
    LAS unsigned char* d = ldsl + cb + wid * 4096;
    __builtin_amdgcn_global_load_lds((const unsigned*)(src + voff), (LAS unsigned*)d, 16, 0, 0);
    __builtin_amdgcn_global_load_lds((const unsigned*)(src + ((size_t)4 << sh) + voff), (LAS unsigned*)(d + 1024), 16, 0, 0);
    __builtin_amdgcn_global_load_lds((const unsigned*)(src + ((size_t)8 << sh) + voff), (LAS unsigned*)(d + 2048), 16, 0, 0);
    __builtin_amdgcn_global_load_lds((const unsigned*)(src + ((size_t)12 << sh) + voff), (LAS unsigned*)(d + 3072), 16, 0, 0);
}
typedef float f32x2 __attribute__((ext_vector_type(2)));
__device__ __forceinline__ unsigned cv_pk4(float a, float b, float c, float d) {
    f32x2 t0 = {a, b}, t1 = {c, d}; t0 *= 64.0f; t1 *= 64.0f;
    int p = __builtin_amdgcn_cvt_pk_fp8_f32(t0.x, t0.y, 0, false); p = __builtin_amdgcn_cvt_pk_fp8_f32(t1.x, t1.y, p, true); return (unsigned)p; }
__device__ __forceinline__ void conv_read(LAS unsigned char* ldsl, int cb, const int wid, const int lane, float (&v)[16]) {
    const LAS float* bp = (const LAS float*)(ldsl + cb + wid * 4096 + lane * 4);
#pragma unroll
    for (int j = 0; j < 16; ++j) v[j] = bp[j * 64];
}
__device__ __forceinline__ void conv_store(const Conv& cv, int L, const int wid, const int lane, const float (&v)[16]) {
    const bool gu = L < 128;
    const int n0 = (gu ? cv.gn0 : cv.dn0) + wid * 64;
    const int rowbase = gu ? (n0 < 2048 ? ((n0 >> 7) * 256 + (n0 & 127)) : (((n0 - 2048) >> 7) * 256 + 128 + (n0 & 127))) : n0;
    unsigned char* dst = (gu ? cv.gdst : cv.ddst) + ((size_t)L << 21) + (size_t)rowbase * 16;
    u32x4 o;
    o.x = cv_pk4(v[0], v[1], v[2], v[3]); o.y = cv_pk4(v[4], v[5], v[6], v[7]); o.z = cv_pk4(v[8], v[9], v[10], v[11]); o.w = cv_pk4(v[12], v[13], v[14], v[15]);
    *(u32x4*)(dst + (unsigned)(lane * 16)) = o;
}
__device__ __forceinline__ void conv_consume(LAS unsigned char* ldsl, int cb, const Conv& cv, int L, const int wid, const int lane) {
    float v[16];
    conv_read(ldsl, cb, wid, lane, v);
    asm volatile("s_waitcnt lgkmcnt(0)" ::: "memory");
    conv_store(cv, L, wid, lane, v);
}
__device__ __forceinline__ void conv_tail(char* lds, Conv& cv, const int wid) {
    const int lane = fresh_lane();
    LAS unsigned char* ldsl = (LAS unsigned char*)(unsigned)(uintptr_t)lds;
    int is = cv.next, co = cv.next;
    for (int k = 0; k < 3 && is < cv.total; ++k, ++is) conv_issue(ldsl, (is & 3) * 32768, cv, is, wid, lane);
    while (co < cv.total) {
        if (is < cv.total) { conv_issue(ldsl, (is & 3) * 32768, cv, is, wid, lane); ++is; asm volatile("s_waitcnt vmcnt(12)" ::: "memory"); }
        else asm volatile("s_waitcnt vmcnt(0)" ::: "memory");
        conv_consume(ldsl, (co & 3) * 32768, cv, co, wid, lane); ++co;
    }
    cv.next = cv.total;
}

template <int MODE>
__device__ __forceinline__ void branch(char* lds, const bf16_t* Kb, const bf16_t* Vb, const bf16x8* qr, int ntiles, int qi, int qoff, int nmax,
                                       const unsigned (&selw)[4], float& m_reg, float& l_reg, float inv_l, f32x16* o, const int wid, Conv& cv) {
    const int lane = fresh_lane(), r32 = lane & 31, hi = lane >> 5;
    constexpr bool CONV = MODE >= 2;
    char* V_lds = lds + L_V; char* K_lds = lds + L_K;
    LAS unsigned char* ldsl = (LAS unsigned char*)(unsigned)(uintptr_t)lds;
    float* al_l = (float*)(lds + L_WS) + wid * 64 + 32;
    float* bs = (float*)(lds + L_BS);
    const int* tlist = (const int*)(lds + L_LIST);
    const int vb0 = (int)(uintptr_t)V_lds + v_rd_base(lane);
    const int j0w = (qi - 8 > 0) ? qi - 8 : 0;
    unsigned ksrc[2], vsrc[2];
#pragma unroll
    for (int i = 0; i < 2; ++i) { const int q = (i * 8 + wid) * 64 + lane;
        { const int row = q >> 4, c = (q & 15) ^ (row & 7); ksrc[i] = (unsigned)(row * 256 + c * 16); }
        { const int sub = q >> 5, within = q & 31, kk = (sub >> 2) * 8 + (within >> 2), k = (kk & ~0xC) | ((kk & 4) << 1) | ((kk & 8) >> 1), c = (sub & 3) * 32 + (within & 3) * 8; vsrc[i] = (unsigned)(k * 256 + c * 2); } }
#define TILE_OF(i) (MODE <= 1 ? (i) : (MODE == 2 ? tlist[i] : j0w + (i)))
#define ISSUE(j, b) do { const char* kg_ = (const char*)Kb + (size_t)(j) * 16384; const char* vg_ = (const char*)Vb + (size_t)(j) * 16384; \
        _Pragma("unroll") for (int _i = 0; _i < 2; ++_i) { \
            __builtin_amdgcn_global_load_lds((const unsigned*)(kg_ + ksrc[_i]), (LAS unsigned*)(ldsl + L_K + (b) * SHM_K + (_i * 8 + wid) * 1024), 16, 0, 0); \
            if (MODE != 0) __builtin_amdgcn_global_load_lds((const unsigned*)(vg_ + vsrc[_i]), (LAS unsigned*)(ldsl + L_V + (b) * SHM_V + (_i * 8 + wid) * 1024), 16, 0, 0); } } while (0)
    ISSUE(TILE_OF(0), 0);
    int buf = 0;
    bool cin = false;
    for (int i = 0; i < ntiles; ++i) {
        const int j = TILE_OF(i);
        if (CONV && cin) asm volatile("s_waitcnt vmcnt(4)" ::: "memory"); else asm volatile("s_waitcnt vmcnt(0)" ::: "memory");
        asm volatile("s_waitcnt lgkmcnt(0)" ::: "memory");
        __builtin_amdgcn_s_barrier();
        asm volatile("" ::: "memory");
        if (i + 1 < ntiles) ISSUE(TILE_OF(i + 1), buf ^ 1);
        f32x16 p0, p1;
        qkt(p0, p1, K_lds + buf * SHM_K, qr, r32, hi);
        float cvv[16]; const bool cold = CONV && i >= 2 && cv.next - 2 < cv.total;
        if (CONV) { if (cold) conv_read(ldsl, (i & 1) ? L_CV1 : L_CV0, wid, lane, cvv); SBAR(); }
        bool boundary;
        if (MODE <= 1) boundary = (64 * j + 63 > 4 * qi - 2);
        else if (MODE == 2) boundary = (j == qi);
        else boundary = (j == qi) || (j == qi - 8);
        float pmax = -INFINITY; bool rowvalid = true;
        if (boundary) {
            int lo = 0, hi_ = 63;
            if (MODE <= 1) hi_ = nmax - j * 64;
            else if (MODE == 2) hi_ = qoff;
            else { if (j == qi) hi_ = qoff; else lo = qoff + 1; }
            const int lo4 = lo - 4 * hi, hi4 = hi_ - 4 * hi;
#pragma unroll
            for (int r = 0; r < 16; ++r) { const int kc0 = (r & 3) + 8 * (r >> 2);
                p0[r] = (kc0 >= lo4 && kc0 <= hi4) ? p0[r] : -INFINITY; p1[r] = (kc0 + 32 >= lo4 && kc0 + 32 <= hi4) ? p1[r] : -INFINITY;
                pmax = fmaxf(pmax, fmaxf(p0[r], p1[r])); }
        } else {
            if (MODE == 2) { const int jw = j >> 5; const unsigned sw_ = jw == 0 ? selw[0] : jw == 1 ? selw[1] : jw == 2 ? selw[2] : selw[3]; rowvalid = (sw_ >> (j & 31)) & 1u; }
#pragma unroll
            for (int r = 0; r < 16; ++r) pmax = fmaxf(pmax, fmaxf(p0[r], p1[r]));
            if (MODE == 2) pmax = rowvalid ? pmax : -INFINITY;
        }
        float alpha = 1.f;
        if (MODE != 1) {
            pmax = half_max(pmax);
            if (!__all(pmax - m_reg <= THR_RAW)) { const float mn = fmaxf(m_reg, pmax); alpha = fast_exp2((m_reg - mn) * CLOG); m_reg = mn; }
        }
        float mnC = -m_reg * CLOG;
        if (MODE == 2) mnC = rowvalid ? mnC : -INFINITY;
        float ps = 0.f;
#pragma unroll
        for (int r = 0; r < 16; ++r) { p0[r] = fast_exp2(fmaf(p0[r], CLOG, mnC)); p1[r] = fast_exp2(fmaf(p1[r], CLOG, mnC)); ps += p0[r] + p1[r]; }
        if (MODE != 1) { ps = half_sum(ps); l_reg = l_reg * alpha + ps; }
        if (MODE == 1) {
#pragma unroll
            for (int r = 0; r < 16; ++r) { p0[r] *= inv_l; p1[r] *= inv_l; }
            unsigned* row = (unsigned*)bs + qoff * BS_STRIDE + j * 16 + hi;
#pragma unroll
            for (int a = 0; a < 4; ++a) {
                const float s0 = 2.f * (p0[4 * a] + p0[4 * a + 1] + p0[4 * a + 2]) + p0[4 * a + 3], s1 = 2.f * (p1[4 * a] + p1[4 * a + 1] + p1[4 * a + 2]) + p1[4 * a + 3];
                atomicAdd(row + 2 * a, (unsigned)(s0 * 67108864.f + 0.5f)); atomicAdd(row + 2 * a + 1, (unsigned)(p0[4 * a + 3] * 67108864.f + 0.5f));
                atomicAdd(row + 8 + 2 * a, (unsigned)(s1 * 67108864.f + 0.5f)); atomicAdd(row + 8 + 2 * a + 1, (unsigned)(p1[4 * a + 3] * 67108864.f + 0.5f));
            }
        }
        if (MODE != 0) {
            if (MODE != 1) {
                if (__any(alpha < 1.f)) { if (hi == 0) al_l[r32] = alpha; asm volatile("s_waitcnt lgkmcnt(0)" ::: "memory");
#pragma unroll
                    for (int d = 0; d < 4; ++d)
#pragma unroll
                        for (int r = 0; r < 16; ++r) o[d][r] *= al_l[crow(r, hi)]; }
            }
            bf16x8 pa0, pa1, pa2, pa3;
            pack_p(p0, p1, pa0, pa1, pa2, pa3);
            if (CONV) {
                SBAR();
                asm volatile("s_waitcnt lgkmcnt(0)" ::: "memory");
                cin = cv.next < cv.total;
                if (cin) conv_issue(ldsl, (i & 1) ? L_CV1 : L_CV0, cv, cv.next, wid, lane);
                SBAR();
                pv_one<0>(o[0], vb0 + buf * SHM_V, pa0, pa1, pa2, pa3);
                if (cold) conv_store(cv, cv.next - 2, wid, lane, cvv);
                ++cv.next;
                pv_one<1>(o[1], vb0 + buf * SHM_V, pa0, pa1, pa2, pa3); pv_one<2>(o[2], vb0 + buf * SHM_V, pa0, pa1, pa2, pa3); pv_one<3>(o[3], vb0 + buf * SHM_V, pa0, pa1, pa2, pa3);
            } else pv_d0(o, vb0 + buf * SHM_V, pa0, pa1, pa2, pa3);
        }
        buf ^= 1;
    }
    if (CONV) {
        asm volatile("s_waitcnt vmcnt(0)" ::: "memory");
        if (ntiles >= 2 && cv.next - 2 < cv.total) conv_consume(ldsl, ((ntiles - 2) & 1) ? L_CV1 : L_CV0, cv, cv.next - 2, wid, lane);
        if (ntiles >= 1 && cv.next - 1 < cv.total) conv_consume(ldsl, ((ntiles - 1) & 1) ? L_CV1 : L_CV0, cv, cv.next - 1, wid, lane);
        cv.next = cv.next < cv.total ? cv.next : cv.total;
    }
    asm volatile("s_waitcnt lgkmcnt(0)" ::: "memory");
    __builtin_amdgcn_s_barrier();
    asm volatile("" ::: "memory");
#undef TILE_OF
#undef ISSUE
}

template <int STAGE, bool CHECK = false>
__device__ __forceinline__ void finalize(char* lds, const f32x16* o, float f, float* scr, bf16_t* mixrow0  , const int wid, unsigned* err = nullptr) {
    const int lane = fresh_lane(), r32 = lane & 31, hi = lane >> 5;
    float* li_l = (float*)(lds + L_WS) + wid * 64;
    if (hi == 0) li_l[r32] = f;
    asm volatile("s_waitcnt lgkmcnt(0)" ::: "memory");
    int lb = hi * 4; asm volatile("" : "+v"(lb));
    float* sw = scr + (size_t)(wid * 32 + lb) * 128 + r32;
    bf16_t* mw = mixrow0 + (size_t)lb * 2048 + r32;
#pragma unroll
    for (int r = 0; r < 16; ++r) { const int orc = (r & 3) + 8 * (r >> 2); const float fr_ = li_l[orc + lb];
#pragma unroll
        for (int d0 = 0; d0 < 4; ++d0) {
            float* p = sw + orc * 128 + d0 * 32;
            float v = o[d0][r] * fr_;
            if (STAGE >= 1) v += *p;
            if (STAGE <= 1) *p = v;
            else { bf16_t* mp = mw + (size_t)orc * 2048 + d0 * 32;
                if (CHECK) { const float old = __uint_as_float((unsigned)(*mp) << 16); if (!(fabsf(old - v) <= 0.02f * fabsf(v) + 2e-3f)) __hip_atomic_store(err, 1u, RLX_AGENT); }
                *mp = (bf16_t)(cvt_pk_bf16(v, v) & 0xffffu); }
        } }
}


typedef unsigned u32x8 __attribute__((ext_vector_type(8)));
__device__ __forceinline__ void accum_out(char* lds, const f32x16* o, float f, u32x8* out, const int wid, const bool first) {
    const int lane = fresh_lane(), r32 = lane & 31, hi = lane >> 5;
    float* li_l = (float*)(lds + L_WS) + wid * 64;
    if (hi == 0) li_l[r32] = f;
    asm volatile("s_waitcnt lgkmcnt(0)" ::: "memory");
#pragma unroll
    for (int k = 0; k < 8; ++k) { const float f0 = li_l[crow(2 * k, hi)], f1 = li_l[crow(2 * k + 1, hi)];
#pragma unroll
        for (int d0 = 0; d0 < 4; ++d0) { const unsigned pk = out[d0][k]; const float a = first ? 0.f : bf_lo(pk), b = first ? 0.f : bf_hi(pk);
            out[d0][k] = cvt_pk_bf16(fmaf(o[d0][2 * k], f0, a), fmaf(o[d0][2 * k + 1], f1, b)); } }
}
template <bool CHECK>
__device__ __forceinline__ void store_out(char* lds, const u32x8* out, bf16_t* mixrow0, const int wid, unsigned* err) {
    const int lane = fresh_lane(), r32 = lane & 31, hi = lane >> 5;
    unsigned short* st = (unsigned short*)(lds + wid * 8192);
#pragma unroll
    for (int k = 0; k < 8; ++k) { const int row0 = crow(2 * k, hi), row1 = crow(2 * k + 1, hi);
#pragma unroll
        for (int d0 = 0; d0 < 4; ++d0) { const unsigned pk = out[d0][k]; st[row0 * 128 + d0 * 32 + r32] = (unsigned short)(pk & 0xffffu); st[row1 * 128 + d0 * 32 + r32] = (unsigned short)(pk >> 16); } }
    asm volatile("s_waitcnt lgkmcnt(0)" ::: "memory");
#pragma unroll
    for (int q = 0; q < 8; ++q) { const int idx = q * 64 + lane, row = idx >> 4, ch = idx & 15;
        const u32x4 v = *(const u32x4*)(st + row * 128 + ch * 8);
        u32x4* gp = (u32x4*)(mixrow0 + (size_t)row * 2048 + ch * 8);
        if (CHECK) { const u32x4 old = *gp; const unsigned a[4] = {old.x, old.y, old.z, old.w}, b[4] = {v.x, v.y, v.z, v.w};
#pragma unroll
            for (int k = 0; k < 4; ++k) { const float x0 = bf_lo(a[k]), x1 = bf_hi(a[k]), y0 = bf_lo(b[k]), y1 = bf_hi(b[k]);
                if (!(fabsf(x0 - y0) <= 0.03f * fabsf(y0) + 3e-3f) || !(fabsf(x1 - y1) <= 0.03f * fabsf(y1) + 3e-3f)) __hip_atomic_store(err, 1u, RLX_AGENT); } }
        *gp = v; }
}

template <int IMPL, bool CHECK>
__device__ __forceinline__ void attn_item(char* lds, const Ptrs& P, int b, int g, int qi, const int wid, unsigned* err, Conv& cv) {
    const int lane = fresh_lane(), tid = wid * 64 + lane, r32 = lane & 31, hi = lane >> 5;
    const int hh = wid >> 1, head = g * 4 + hh, qoff = (wid & 1) * 32 + r32, t = qi * 64 + qoff;
    const size_t tok = (size_t)b * SEQ + t;
    bf16x8 qr[8];
    { const bf16_t* Qw = P.Q + tok * 1024 + head * 128 + hi * 8;
#pragma unroll
      for (int d0 = 0; d0 < 8; ++d0) qr[d0] = *(const bf16x8*)(Qw + d0 * 16); }
    const float* gl = P.GLOG + tok * 32 + head * 3;
    const float g_c = sigmoidf_(gl[0]), g_s = sigmoidf_(gl[1]), g_w = sigmoidf_(gl[2]);
    const size_t kvo = (size_t)((b * 2 + g) * SEQ) * 128, cmo = (size_t)((b * 2 + g) * NCMP) * 128;
    const bf16_t* Ks = P.KV + 2 * (KV_STRIDE / 2) + kvo; const bf16_t* Vs = P.KV + 3 * (KV_STRIDE / 2) + kvo;
    const bf16_t* Kw = P.KV + 4 * (KV_STRIDE / 2) + kvo; const bf16_t* Vw = P.KV + 5 * (KV_STRIDE / 2) + kvo;
    const bf16_t* Kc = P.KCMP + cmo; const bf16_t* Vc = P.VCMP + cmo;
    float* bs = (float*)(lds + L_BS);
    unsigned* selm = (unsigned*)(lds + L_SEL); unsigned* uni = (unsigned*)(lds + L_UNI); int* tlist = (int*)(lds + L_LIST);
    for (int i = tid; i < 64 * BS_STRIDE; i += 512) ((unsigned*)bs)[i] = 0u;
    if (tid < 8) uni[tid] = 0u;
    __syncthreads();
    bf16_t* mixrow0 = P.MIX + ((size_t)b * SEQ + qi * 64 + (wid & 1) * 32) * 2048 + head * 128;
    unsigned selw[4] = {0u, 0u, 0u, 0u};
    f32x16 o[4];
    u32x8 out[4];
    const int nmax = (t - 31) >> 4;
    const int ntc = ((4 * qi + 2) >> 6) + 1;
    float m_c = -1e30f, l_c = 0.f;
    if (IMPL == 0) branch_ref<0>(lds, Kc, Vc, qr, ntc, qi, qoff, nmax, selw, m_c, l_c, 0.f, o, wid); else branch<0>(lds, Kc, Vc, qr, ntc, qi, qoff, nmax, selw, m_c, l_c, 0.f, o, wid, cv);
    const float inv_lc = l_c > 0.f ? 1.0f / l_c : 0.f;
#pragma unroll
    for (int d = 0; d < 4; ++d) o[d] = f32x16{};
    if (IMPL == 0) branch_ref<1>(lds, Kc, Vc, qr, ntc, qi, qoff, nmax, selw, m_c, l_c, inv_lc, o, wid); else branch<1>(lds, Kc, Vc, qr, ntc, qi, qoff, nmax, selw, m_c, l_c, inv_lc, o, wid, cv);
    if (IMPL == 1) accum_out(lds, o, g_c, out, wid, true); else finalize<0>(lds, o, g_c, P.scr, mixrow0, wid);
    __syncthreads();
    if (IMPL == 0) {
    {
        const int cur = qi;
        for (int qq = 0; qq < 8; ++qq) {
            const int q = wid * 8 + qq;
            unsigned mk0 = 0u, mk1 = 0u, mk2 = 0u, mk3 = 0u;
#define MK_SET(idx) do { const int _w = (idx) >> 5; const unsigned _b = 1u << ((idx) & 31); mk0 |= _w == 0 ? _b : 0u; mk1 |= _w == 1 ? _b : 0u; mk2 |= _w == 2 ? _b : 0u; mk3 |= _w == 3 ? _b : 0u; } while (0)
            if (cur <= 15) { mk0 = (1u << (cur + 1)) - 1u; }
            else {
                MK_SET(0); MK_SET(cur); MK_SET(cur - 1);
                const int j0 = lane, j1 = lane + 64;
                const unsigned* bsu = (const unsigned*)bs;
                unsigned s0 = (j0 >= 1 && j0 <= cur - 2) ? bsu[q * BS_STRIDE + j0] + 1u : 0u;
                unsigned s1 = (j1 <= cur - 2) ? bsu[q * BS_STRIDE + j1] + 1u : 0u;
                for (int it = 0; it < 13; ++it) {
                    unsigned bv; int bi;
                    if (s1 > s0) { bv = s1; bi = j1; } else { bv = s0; bi = j0; }
#pragma unroll
                    for (int off = 1; off < 64; off <<= 1) { const unsigned ov = (unsigned)__shfl_xor((int)bv, off); const int oi = __shfl_xor(bi, off); if (ov > bv || (ov == bv && oi < bi)) { bv = ov; bi = oi; } }
                    bi = __builtin_amdgcn_readfirstlane(bi);
                    MK_SET(bi);
                    if (bi == j0) s0 = 0u;
                    if (bi == j1) s1 = 0u;
                }
            }
#undef MK_SET
            if (lane < 4) { const unsigned v = lane == 0 ? mk0 : lane == 1 ? mk1 : lane == 2 ? mk2 : mk3; selm[q * 4 + lane] = v; atomicOr(&uni[lane], v); }
        }
    }
    } else {
    {
        const int cur = qi;
        if (cur <= 15) {
            if (lane < 4) { const unsigned v = lane == 0 ? ((1u << (cur + 1)) - 1u) : 0u;
#pragma unroll
                for (int qq = 0; qq < 8; ++qq) selm[(wid * 8 + qq) * 4 + lane] = v;
                atomicOr(&uni[lane], v); }
        } else {
            const unsigned* bsu = (const unsigned*)bs; const int j0 = lane, j1 = lane + 64;
            const bool v0 = j0 >= 1 && j0 <= cur - 2, v1 = j1 <= cur - 2;
#pragma unroll 1
            for (int qb = 0; qb < 8; qb += 4) {
                unsigned s0[4], s1[4]; unsigned long long ma[4], mb[4];
#pragma unroll
                for (int u = 0; u < 4; ++u) { const int q = wid * 8 + qb + u;
                    s0[u] = v0 ? bsu[q * BS_STRIDE + j0] + 1u : 0u; s1[u] = v1 ? bsu[q * BS_STRIDE + j1] + 1u : 0u;
                    ma[u] = 1ull; mb[u] = 0ull;
                    if (cur < 64) ma[u] |= 1ull << cur; else mb[u] |= 1ull << (cur - 64);
                    if (cur - 1 < 64) ma[u] |= 1ull << (cur - 1); else mb[u] |= 1ull << (cur - 65); }
#pragma unroll 1
                for (int it = 0; it < 13; ++it) {
#pragma unroll
                    for (int u = 0; u < 4; ++u) {
                        unsigned v = s0[u] > s1[u] ? s0[u] : s1[u];
                        { unsigned t;
                          t = (unsigned)__builtin_amdgcn_update_dpp(0, (int)v, 0x111, 0xf, 0xf, false); v = v > t ? v : t;
                          t = (unsigned)__builtin_amdgcn_update_dpp(0, (int)v, 0x112, 0xf, 0xf, false); v = v > t ? v : t;
                          t = (unsigned)__builtin_amdgcn_update_dpp(0, (int)v, 0x114, 0xf, 0xf, false); v = v > t ? v : t;
                          t = (unsigned)__builtin_amdgcn_update_dpp(0, (int)v, 0x118, 0xf, 0xf, false); v = v > t ? v : t;
                          t = (unsigned)__builtin_amdgcn_update_dpp(0, (int)v, 0x142, 0xa, 0xf, false); v = v > t ? v : t;
                          t = (unsigned)__builtin_amdgcn_update_dpp(0, (int)v, 0x143, 0xc, 0xf, false); v = v > t ? v : t; }
                        const unsigned m = (unsigned)__builtin_amdgcn_readlane((int)v, 63);
                        const unsigned long long b0 = __ballot(s0[u] == m), b1 = __ballot(s1[u] == m);
                        if (b0) { const int idx = __builtin_ctzll(b0); ma[u] |= 1ull << idx; if (lane == idx) s0[u] = 0u; }
                        else    { const int idx = __builtin_ctzll(b1); mb[u] |= 1ull << idx; if (lane == idx) s1[u] = 0u; }
                    }
                }
#pragma unroll
                for (int u = 0; u < 4; ++u) { const int q = wid * 8 + qb + u;
                    if (lane < 4) { const unsigned v = lane == 0 ? (unsigned)ma[u] : lane == 1 ? (unsigned)(ma[u] >> 32) : lane == 2 ? (unsigned)mb[u] : (unsigned)(mb[u] >> 32); selm[q * 4 + lane] = v; atomicOr(&uni[lane], v); } }
            }
        }
    }
    }
    __syncthreads();
    if (tid < 128) {
        const unsigned w = uni[tid >> 5]; const bool on = (w >> (tid & 31)) & 1u;
        if (on) { int pos = __popc(w & ((1u << (tid & 31)) - 1u)); for (int k = 0; k < (tid >> 5); ++k) pos += __popc(uni[k]); tlist[pos] = tid; }
    }
    const int nsel = __popc(uni[0]) + __popc(uni[1]) + __popc(uni[2]) + __popc(uni[3]);
#pragma unroll
    for (int k = 0; k < 4; ++k) selw[k] = selm[qoff * 4 + k];
    __syncthreads();
    { float m_s = -1e30f, l_s = 0.f;
#pragma unroll
      for (int d = 0; d < 4; ++d) o[d] = f32x16{};
      if (IMPL == 0) branch_ref<2>(lds, Ks, Vs, qr, nsel, qi, qoff, 0, selw, m_s, l_s, 0.f, o, wid); else branch<2>(lds, Ks, Vs, qr, nsel, qi, qoff, 0, selw, m_s, l_s, 0.f, o, wid, cv);
      if (IMPL == 1) accum_out(lds, o, l_s > 0.f ? g_s / l_s : 0.f, out, wid, false); else finalize<1>(lds, o, l_s > 0.f ? g_s / l_s : 0.f, P.scr, mixrow0, wid); }
    { float m_w = -1e30f, l_w = 0.f;
#pragma unroll
      for (int d = 0; d < 4; ++d) o[d] = f32x16{};
      const int j0w = (qi - 8 > 0) ? qi - 8 : 0;
      if (IMPL == 0) branch_ref<3>(lds, Kw, Vw, qr, qi - j0w + 1, qi, qoff, 0, selw, m_w, l_w, 0.f, o, wid); else branch<3>(lds, Kw, Vw, qr, qi - j0w + 1, qi, qoff, 0, selw, m_w, l_w, 0.f, o, wid, cv);
      if (IMPL == 1) { accum_out(lds, o, l_w > 0.f ? g_w / l_w : 0.f, out, wid, false); store_out<CHECK>(lds, out, mixrow0, wid, err); }
      else finalize<2, CHECK>(lds, o, l_w > 0.f ? g_w / l_w : 0.f, P.scr, mixrow0, wid, err); }
    __syncthreads();
}
}

struct Frame {
    LAS unsigned char* lds; char* ldsg;
    unsigned* ctl; unsigned char* ws;
    int wave, G, c;
};
#define FRESH_TID() const int lane = fresh_lane(); const int tid = F.wave * 64 + lane; (void)tid; (void)lane
__constant__ float c_inv_freq[16] = {1.0f, 0.44036659598350525f, 0.1939227432012558f, 0.08539710193872452f, 0.03760603070259094f, 0.016560440883040428f, 0.007292664609849453f,
    0.0032114461064338684f, 0.0014142135623842478f, 0.0006227724370546639f, 0.00027424818836152554f, 0.00012076973507646471f, 5.3182957344688475e-05f, 2.34199997066753e-05f,
    1.0313385246263351e-05f, 4.541670477919979e-06f};

template <int MODE> __device__ __forceinline__ int rowmap(int n) {
    if (MODE == 1) return n < 2560 ? n : (n < 2584 ? 3584 + (n - 2560) : n - 24);
    if (MODE == 2) return n < 2048 ? ((n >> 7) * 256 + (n & 127)) : (((n - 2048) >> 7) * 256 + 128 + ((n - 2048) & 127));
    return n;
}
struct TrMat { const float* W; bf16_t* WT; int K, N, ldt, mode, nkt, nnt; };
__device__ __forceinline__ void tr_load(const TrMat& M, int kt, int nt, int w, int lane, f32x4 (&v)[8]) {
    const int n = nt * 128 + (lane & 31) * 4, kb = kt * 128 + w * 16 + (lane >> 5) * 8;
    const bool ok = n < M.N; const float* p = M.W + (size_t)kb * M.N + (ok ? n : 0);
#pragma unroll
    for (int i = 0; i < 8; ++i) v[i] = *(const f32x4*)(p + (size_t)i * M.N);
}
__device__ __forceinline__ void tr_lds_write(LAS unsigned* buf, int w, int lane, const f32x4 (&v)[8]) {
#pragma unroll
    for (int i2 = 0; i2 < 4; ++i2) { const int kp = w * 8 + (lane >> 5) * 4 + i2;
        u32x4 o; o.x = cvt_pk_bf16(v[2 * i2][0], v[2 * i2 + 1][0]); o.y = cvt_pk_bf16(v[2 * i2][1], v[2 * i2 + 1][1]); o.z = cvt_pk_bf16(v[2 * i2][2], v[2 * i2 + 1][2]); o.w = cvt_pk_bf16(v[2 * i2][3], v[2 * i2 + 1][3]);
        *(LAS u32x4*)(buf + kp * 128 + (((lane & 31) * 4) ^ (4 * ((kp >> 2) & 7)))) = o; }
}
__device__ __forceinline__ void tr_store(const TrMat& M, int kt, int nt, const LAS unsigned* buf, int tid) {
#pragma unroll
    for (int q = 0; q < 4; ++q) { const int idx = tid + 512 * q, nl = idx >> 4, kg = idx & 15, n = nt * 128 + nl;
        u32x4 o; const LAS unsigned* b = buf + (kg * 4) * 128 + (nl ^ (4 * (kg & 7)));
        o.x = b[0]; o.y = b[128]; o.z = b[256]; o.w = b[384];
        if (n < M.N) { const int row = M.mode == 1 ? rowmap<1>(n) : n; *(u32x4*)(M.WT + (size_t)row * M.ldt + kt * 128 + kg * 8) = o; } }
}
__device__ __forceinline__ unsigned pk4_fp8(float a, float b, float c, float d) { int p = __builtin_amdgcn_cvt_pk_fp8_f32(a, b, 0, false); p = __builtin_amdgcn_cvt_pk_fp8_f32(c, d, p, true); return (unsigned)p; }
__device__ __forceinline__ void tr_lds_write8(LAS unsigned* buf, int w, int lane, const f32x4 (&v)[8]) {
#pragma unroll
    for (int i2 = 0; i2 < 2; ++i2) { const int kq = w * 4 + (lane >> 5) * 2 + i2;
        u32x4 o;
#pragma unroll
        for (int j = 0; j < 4; ++j) o[j] = pk4_fp8(v[4 * i2][j] * 64.0f, v[4 * i2 + 1][j] * 64.0f, v[4 * i2 + 2][j] * 64.0f, v[4 * i2 + 3][j] * 64.0f);
        *(LAS u32x4*)(buf + kq * 128 + (((lane & 31) * 4) ^ (4 * ((kq >> 2) & 7)))) = o; }
}
__device__ __forceinline__ void tr_store8(const TrMat& M, int kt, int nt, const LAS unsigned* buf, int tid) {
#pragma unroll
    for (int q = 0; q < 2; ++q) { const int idx = tid + 512 * q, nl = idx >> 3, kg = idx & 7, n = nt * 128 + nl;
        u32x4 o; const LAS unsigned* b = buf + (kg * 4) * 128 + (nl ^ (4 * kg));
        o.x = b[0]; o.y = b[128]; o.z = b[256]; o.w = b[384];
        const int row = M.mode == 2 ? rowmap<2>(n) : n; *(u32x4*)((unsigned char*)M.WT + ((size_t)(kt * 8 + kg) * M.N + row) * 16) = o; }
}
__device__ __forceinline__ bool tr_pick(const Frame& F, const Args& A, int id, TrMat& M, int& kt, int& nt) {
    constexpr int T_GU = 16 * 32, T_DN = 16 * 16, T_IN = 16 * 29, T_OUT = 16 * 16, T_W1 = 32 * 2, T_PW = 2 * 2, T_W2 = 2;
    int r = id;
    if (r < 32 * T_GU) { const int e = r / T_GU; r %= T_GU; M = TrMat{A.in[I_WGU] + (size_t)e * 2048 * 4096, (bf16_t*)(F.ws + WS_WGU + (size_t)e * 4096 * 2048), 2048, 4096, 2048, 2, 16, 32}; }
    else if ((r -= 32 * T_GU) < 32 * T_DN) { const int e = r / T_DN; r %= T_DN; M = TrMat{A.in[I_WD] + (size_t)e * 2048 * 2048, (bf16_t*)(F.ws + WS_WD + (size_t)e * 2048 * 2048), 2048, 2048, 2048, 3, 16, 16}; }
    else if ((r -= 32 * T_DN) < T_IN) { M = TrMat{A.in[I_WIN], (bf16_t*)(F.ws + WS_WINT), 2048, 3608, 2048, 1, 16, 29}; }
    else if ((r -= T_IN) < T_OUT) { M = TrMat{A.in[I_WOUT], (bf16_t*)(F.ws + WS_WOUTT), 2048, 2048, 2048, 0, 16, 16}; }
    else if ((r -= T_OUT) < 2 * T_W1) { const int kv = r / T_W1; r %= T_W1; M = TrMat{kv ? A.in[I_CVW1] : A.in[I_CKW1], (bf16_t*)(F.ws + WS_W1T) + (size_t)kv * 256 * 4096, 4096, 256, 4096, 0, 32, 2}; }
    else if ((r -= 2 * T_W1) < 4 * T_PW) { const int g = r / T_PW; r %= T_PW; M = TrMat{A.in[I_POOLW] + (size_t)g * 65536, (bf16_t*)(F.ws + WS_PWT) + (size_t)g * 65536, 256, 256, 256, 0, 2, 2}; }
    else if ((r -= 4 * T_PW) < 2 * T_W2) { const int kv = r / T_W2; r %= T_W2; M = TrMat{kv ? A.in[I_CVW2] : A.in[I_CKW2], (bf16_t*)(F.ws + WS_W2T) + (size_t)kv * 128 * 256, 256, 128, 256, 0, 2, 1}; }
    else return false;
    kt = r / M.nnt; nt = r % M.nnt; return true;
}
constexpr int NMOE_TILES = 32 * (16 * 32 + 16 * 16);
__device__ __forceinline__ void convert_tiles(const Frame& F, const Args& A, int first, int stride, int end) {
    FRESH_TID();
    LAS unsigned* tb0 = (LAS unsigned*)F.lds; TrMat MA, MB; int ktA = 0, ntA = 0, ktB = 0, ntB = 0; f32x4 vA[8], vB[8];
    int id = first;
    bool haveA = id < end && tr_pick(F, A, id, MA, ktA, ntA); if (haveA) tr_load(MA, ktA, ntA, F.wave, lane, vA);
    bool haveB = id + stride < end && tr_pick(F, A, id + stride, MB, ktB, ntB); if (haveB) tr_load(MB, ktB, ntB, F.wave, lane, vB);
    id += 2 * stride;
    while (haveA) {
        { LAS unsigned* buf = tb0;
          if (MA.mode >= 2) tr_lds_write8(buf, F.wave, lane, vA); else tr_lds_write(buf, F.wave, lane, vA);
          __syncthreads();
          const TrMat Mc = MA; const int ktc = ktA, ntc = ntA;
          haveA = id < end && tr_pick(F, A, id, MA, ktA, ntA); if (haveA) tr_load(MA, ktA, ntA, F.wave, lane, vA);
          if (Mc.mode >= 2) tr_store8(Mc, ktc, ntc, buf, tid); else tr_store(Mc, ktc, ntc, buf, tid); }
        if (!haveB) break;
        { LAS unsigned* buf = tb0 + 8192;
          if (MB.mode >= 2) tr_lds_write8(buf, F.wave, lane, vB); else tr_lds_write(buf, F.wave, lane, vB);
          __syncthreads();
          const TrMat Mc = MB; const int ktc = ktB, ntc = ntB;
          haveB = id + stride < end && tr_pick(F, A, id + stride, MB, ktB, ntB); if (haveB) tr_load(MB, ktB, ntB, F.wave, lane, vB);
          if (Mc.mode >= 2) tr_store8(Mc, ktc, ntc, buf, tid); else tr_store(Mc, ktc, ntc, buf, tid); }
        id += 2 * stride;
    }
    __syncthreads();
}
__device__ __forceinline__ void posb_partials(const Frame& F, const Args& A, int rank, int n) {
    FRESH_TID();
    float* pb = (float*)(F.ws + WS_POSB64);
    for (long i = (long)rank * 512 + tid; i < 64 * 512; i += (long)n * 512) { const int o = (int)(i & 511), ks = (int)(i >> 9), kv = o >> 8, h = o & 255;
        const float* pos = kv ? A.in[I_CVPOS] : A.in[I_CKPOS]; const float* w1 = kv ? A.in[I_CVW1] : A.in[I_CKW1]; float s0 = 0.f, s1 = 0.f, s2 = 0.f, s3 = 0.f;
#pragma unroll 4
        for (int r = ks * 64; r < ks * 64 + 64; r += 4) { s0 = fmaf(pos[r], w1[(size_t)r * 256 + h], s0); s1 = fmaf(pos[r + 1], w1[(size_t)(r + 1) * 256 + h], s1); s2 = fmaf(pos[r + 2], w1[(size_t)(r + 2) * 256 + h], s2); s3 = fmaf(pos[r + 3], w1[(size_t)(r + 3) * 256 + h], s3); }
        pb[i] = (s0 + s1) + (s2 + s3); }
}
__device__ __forceinline__ void phase0(const Frame& F, const Args& A) {
    FRESH_TID();
    const int gw = F.c * NWAVES + F.wave, NGW = F.G * NWAVES;
    const long gt = (long)F.c * 512 + tid, NT = (long)F.G * 512;
    { const float* x = A.in[I_X]; const float* g1 = A.in[I_N1G]; bf16_t* H = (bf16_t*)(F.ws + WS_H);
      for (int row = gw; row < NTOK; row += 2 * NGW) {
        const bool hasB = row + NGW < NTOK; const int rowB = hasB ? row + NGW : row;
        const f32x4* xa = (const f32x4*)(x + (size_t)row * DM) + lane; const f32x4* xb = (const f32x4*)(x + (size_t)rowB * DM) + lane; f32x4 va[8], vb[8]; float sa = 0.f, sb = 0.f;
#pragma unroll
        for (int j = 0; j < 8; ++j) { va[j] = xa[64 * j]; vb[j] = xb[64 * j]; }
#pragma unroll
        for (int j = 0; j < 8; ++j) { sa += (va[j][0] * va[j][0] + va[j][1] * va[j][1]) + (va[j][2] * va[j][2] + va[j][3] * va[j][3]); sb += (vb[j][0] * vb[j][0] + vb[j][1] * vb[j][1]) + (vb[j][2] * vb[j][2] + vb[j][3] * vb[j][3]); }
        const float ra = rsqrtf(wave_sum(sa) * (1.0f / DM) + 1e-5f), rb = rsqrtf(wave_sum(sb) * (1.0f / DM) + 1e-5f);
        u32x2* oa = (u32x2*)(H + (size_t)row * DM) + lane; u32x2* ob = (u32x2*)(H + (size_t)rowB * DM) + lane;
#pragma unroll
        for (int j = 0; j < 8; ++j) { const f32x4 gg = ((const f32x4*)g1)[64 * j + lane]; u32x2 w;
            w.x = cvt_pk_bf16(va[j][0] * ra * gg[0], va[j][1] * ra * gg[1]); w.y = cvt_pk_bf16(va[j][2] * ra * gg[2], va[j][3] * ra * gg[3]); oa[64 * j] = w;
            if (hasB) { w.x = cvt_pk_bf16(vb[j][0] * rb * gg[0], vb[j][1] * rb * gg[1]); w.y = cvt_pk_bf16(vb[j][2] * rb * gg[2], vb[j][3] * rb * gg[3]); ob[64 * j] = w; } }
      } }
    convert_tiles(F, A, (F.G == 256 ? NMOE_TILES : 0) + F.c, F.G, 1 << 30);
    { u32x4* z = (u32x4*)((bf16_t*)(F.ws + WS_WINT) + (size_t)3608 * 2048); const long n16 = (long)(NINP - 3608) * 2048 * 2 / 16;
      for (long i = gt; i < n16; i += NT) z[i] = (u32x4){0u, 0u, 0u, 0u}; }
    { float* tc = (float*)(F.ws + WS_COS); float* tsn = (float*)(F.ws + WS_SIN);
      for (long i = gt; i < 8208 * 16; i += NT) { const int pos = (int)(i >> 4), k = (int)(i & 15);
        const float ang = (float)pos * c_inv_freq[k]; double xr = (double)ang * 0.15915494309189535; xr -= __builtin_rint(xr);
        tc[i] = __builtin_amdgcn_cosf((float)xr); tsn[i] = __builtin_amdgcn_sinf((float)xr); } }
}

struct RowJob { bf16_t* p; u32x4 raw; f32x4 g0, g1, c0, c1, s0, s1; };
__device__ __forceinline__ void rowjob_issue(RowJob& J, const Frame& F, const Args& A, int row, int sub) {
    constexpr int NQ = NTOK * 8, NK = NB * NGRP * SEQ;
    bf16_t* Q = (bf16_t*)(F.ws + WS_Q); bf16_t* KS = (bf16_t*)(F.ws + WS_KV + 2 * KV_STRIDE); bf16_t* KW = (bf16_t*)(F.ws + WS_KV + 4 * KV_STRIDE);
    const float* tc = (const float*)(F.ws + WS_COS); const float* tsn = (const float*)(F.ws + WS_SIN);
    const float* gain; int pos;
    if (row < NQ) { J.p = Q + (size_t)row * 128; gain = A.in[I_QNG]; pos = (row >> 3) & (SEQ - 1); }
    else if (row < NQ + NK) { const int r = row - NQ; J.p = KS + (size_t)r * 128; gain = A.in[I_KNS]; pos = r & (SEQ - 1); }
    else { const int r = row - NQ - NK; J.p = KW + (size_t)r * 128; gain = A.in[I_KNW]; pos = r & (SEQ - 1); }
    J.raw = *(const u32x4*)(J.p + sub * 8);
    J.g0 = *(const f32x4*)(gain + sub * 8); J.g1 = *(const f32x4*)(gain + sub * 8 + 4);
    const int ti = pos * 16 + (sub & 1) * 8;
    J.c0 = *(const f32x4*)(tc + ti); J.c1 = *(const f32x4*)(tc + ti + 4); J.s0 = *(const f32x4*)(tsn + ti); J.s1 = *(const f32x4*)(tsn + ti + 4);
}
__device__ __forceinline__ void rowjob_finish(const RowJob& J, int sub) {
    const u32x4 raw = J.raw;
    float x[8] = {bf_lo(raw.x), bf_hi(raw.x), bf_lo(raw.y), bf_hi(raw.y), bf_lo(raw.z), bf_hi(raw.z), bf_lo(raw.w), bf_hi(raw.w)};
    float ss = 0.f;
#pragma unroll
    for (int j = 0; j < 8; ++j) ss += x[j] * x[j];
    ss += __shfl_xor(ss, 1); ss += __shfl_xor(ss, 2); ss += __shfl_xor(ss, 4); ss += __shfl_xor(ss, 8);
    const float rstd = rsqrtf(ss * (1.0f / 128.0f) + 1e-6f);
#pragma unroll
    for (int j = 0; j < 8; ++j) x[j] = x[j] * rstd * (j < 4 ? J.g0[j] : J.g1[j - 4]);
#pragma unroll
    for (int j = 0; j < 8; ++j) { const float other = __shfl_xor(x[j], 2); const float cs = j < 4 ? J.c0[j] : J.c1[j - 4], sn = j < 4 ? J.s0[j] : J.s1[j - 4];
        const float rot = (sub < 2) ? (x[j] * cs - other * sn) : (x[j] * cs + other * sn); x[j] = sub < 4 ? rot : x[j]; }
    u32x4 w; w.x = cvt_pk_bf16(x[0], x[1]); w.y = cvt_pk_bf16(x[2], x[3]); w.z = cvt_pk_bf16(x[4], x[5]); w.w = cvt_pk_bf16(x[6], x[7]);
    *(u32x4*)(J.p + sub * 8) = w;
}
__device__ __forceinline__ void norm_rope_rows(const Frame& F, const Args& A, int ec, int eG) {
    FRESH_TID();
    const int gw = ec * NWAVES + F.wave, NGW = eG * NWAVES, sub = lane & 15, rsel = lane >> 4;
    constexpr int NITEM = (NTOK * 8 + 2 * NB * NGRP * SEQ) / 4;
    for (int it = gw; it < NITEM; it += 2 * NGW) {
        RowJob JA, JB; const bool hasB = it + NGW < NITEM;
        rowjob_issue(JA, F, A, it * 4 + rsel, sub);
        if (hasB) rowjob_issue(JB, F, A, (it + NGW) * 4 + rsel, sub);
        rowjob_finish(JA, sub);
        if (hasB) rowjob_finish(JB, sub);
    }
}
template <int W> __device__ __forceinline__ void pool_item(const bf16_t* PIN, bf16_t* DP, int tok, int c8) {
    const int s = tok & (SEQ - 1);
    u32x4 raw[W];
#pragma unroll
    for (int j = 0; j < W; ++j) { const int jj = j <= s ? j : s; raw[j] = *(const u32x4*)(PIN + (size_t)(tok - jj) * 1024 + c8 * 8); }
    float acc[8] = {0.f, 0.f, 0.f, 0.f, 0.f, 0.f, 0.f, 0.f};
#pragma unroll
    for (int j = 0; j < W; ++j) { const float wg = j <= s ? 1.f : 0.f; const u32x4 r = raw[j];
        acc[0] = fmaf(bf_lo(r.x), wg, acc[0]); acc[1] = fmaf(bf_hi(r.x), wg, acc[1]); acc[2] = fmaf(bf_lo(r.y), wg, acc[2]); acc[3] = fmaf(bf_hi(r.y), wg, acc[3]);
        acc[4] = fmaf(bf_lo(r.z), wg, acc[4]); acc[5] = fmaf(bf_hi(r.z), wg, acc[5]); acc[6] = fmaf(bf_lo(r.w), wg, acc[6]); acc[7] = fmaf(bf_hi(r.w), wg, acc[7]); }
    const u32x4 r0 = raw[0]; const float cur[8] = {bf_lo(r0.x), bf_hi(r0.x), bf_lo(r0.y), bf_hi(r0.y), bf_lo(r0.z), bf_hi(r0.z), bf_lo(r0.w), bf_hi(r0.w)};
    const float inv = 1.0f / (float)((s + 1 < W) ? s + 1 : W); float d[8];
#pragma unroll
    for (int k = 0; k < 8; ++k) d[k] = acc[k] * inv - cur[k];
    u32x4 o; o.x = cvt_pk_bf16(d[0], d[1]); o.y = cvt_pk_bf16(d[2], d[3]); o.z = cvt_pk_bf16(d[4], d[5]); o.w = cvt_pk_bf16(d[6], d[7]);
    *(u32x4*)(DP + (size_t)tok * 1024 + c8 * 8) = o;
}
__device__ __forceinline__ void pool_diffs(const Frame& F, int ec, int eG) {
    const bf16_t* PIN = (const bf16_t*)(F.ws + WS_PIN); bf16_t* DP = (bf16_t*)(F.ws + WS_DP);
    FRESH_TID();
    const long gt = (long)ec * 512 + tid, NT = (long)eG * 512;
    for (long i = gt; i < 4L * NTOK * 32; i += NT) {
        const int g = (int)(i >> 19), tok = (int)((i >> 5) & (NTOK - 1)), c8 = g * 32 + (int)(i & 31);
        if (g == 0) pool_item<2>(PIN, DP, tok, c8); else if (g == 1) pool_item<4>(PIN, DP, tok, c8); else if (g == 2) pool_item<8>(PIN, DP, tok, c8); else pool_item<16>(PIN, DP, tok, c8);
    }
}
__device__ __forceinline__ void cmp_bias_total(const Frame& F, const Args& A) {
    FRESH_TID();
    const float* posb = (const float*)(F.ws + WS_POSB64); float* bt = (float*)(F.ws + WS_POSB + 65536 - 2048);
#pragma unroll
    for (int q = 0; q < 8; ++q) { const int o = q * 64 + lane; float sacc = (o < 256 ? A.in[I_CKB1] : A.in[I_CVB1])[o & 255];
        for (int p = 0; p < 64; ++p) sacc += posb[p * 512 + o];
        bt[o] = sacc; }
}
__device__ __forceinline__ void cmp_layer2(const Frame& F, const Args& A, int kv, int rg) {
    FRESH_TID();
    const int w = F.wave, l15 = lane & 15, q4 = lane >> 4;
    const float* HP = (const float*)(F.ws + WS_ACT); const bf16_t* W2T = (const bf16_t*)(F.ws + WS_W2T) + (size_t)kv * 128 * 256;
    const float* bt = (const float*)(F.ws + WS_POSB + 65536 - 2048) + kv * 256;
    LAS f32x4* red = (LAS f32x4*)F.lds;
    { const int rowA = rg * 16 + l15, k0 = w * 32 + q4 * 8;
      f32x4 h0 = *(const f32x4*)(bt + k0), h1 = *(const f32x4*)(bt + k0 + 4);
#pragma unroll
      for (int p = 0; p < 4; ++p) { const float* src = HP + ((size_t)(p * 2 + kv) * 2048 + rowA) * 256 + k0; h0 += *(const f32x4*)src; h1 += *(const f32x4*)(src + 4); }
      float g[8];
#pragma unroll
      for (int j = 0; j < 8; ++j) { const float x = j < 4 ? h0[j] : h1[j - 4]; const float uu = 0.7978845608028654f * (x + 0.044715f * x * x * x);
          g[j] = x * fast_rcp(1.0f + fast_exp2(-2.885390081777927f * uu)); }
      auto f2b = [](float f) -> unsigned { unsigned u = __float_as_uint(f); return (u + 0x7fffu + ((u >> 16) & 1u)) >> 16; };
      u32x4 aw; aw.x = f2b(g[0]) | (f2b(g[1]) << 16); aw.y = f2b(g[2]) | (f2b(g[3]) << 16); aw.z = f2b(g[4]) | (f2b(g[5]) << 16); aw.w = f2b(g[6]) | (f2b(g[7]) << 16);
      const bf16x8 a = *reinterpret_cast<const bf16x8*>(&aw);
#pragma unroll
      for (int nt = 0; nt < 8; ++nt) { const bf16x8 b = *(const bf16x8*)(W2T + (size_t)(nt * 16 + l15) * 256 + w * 32 + q4 * 8);
          const f32x4 z = {0.f, 0.f, 0.f, 0.f}; red[(w * 8 + nt) * 64 + lane] = __builtin_amdgcn_mfma_f32_16x16x32_bf16(a, b, z, 0, 0, 0); } }
    __syncthreads();
    if (w == 0) {
        bf16_t* OUT = (bf16_t*)(F.ws + WS_CMP + (kv ? 512 * 1024 : 0));
        const float* b2 = kv ? A.in[I_CVB2] : A.in[I_CKB2]; const float* gain = A.in[I_KNC];
        const float* tc = (const float*)(F.ws + WS_COS); const float* tsn = (const float*)(F.ws + WS_SIN);
        f32x4 acc[8]; float bb[8], gg[8];
#pragma unroll
        for (int nt = 0; nt < 8; ++nt) { f32x4 t = red[nt * 64 + lane];
#pragma unroll
            for (int ww = 1; ww < 8; ++ww) t += red[(ww * 8 + nt) * 64 + lane];
            acc[nt] = t; bb[nt] = b2[nt * 16 + l15]; gg[nt] = gain[nt * 16 + l15]; }
#pragma unroll
        for (int r = 0; r < 4; ++r) {
            const int m = rg * 16 + q4 * 4 + r, n = m & 511;
            float v[8]; float ss = 0.f;
#pragma unroll
            for (int nt = 0; nt < 8; ++nt) { v[nt] = acc[nt][r] + bb[nt]; ss += v[nt] * v[nt]; }
            if (kv == 0) {
                ss += __shfl_xor(ss, 1); ss += __shfl_xor(ss, 2); ss += __shfl_xor(ss, 4); ss += __shfl_xor(ss, 8);
                const float rstd = rsqrtf(ss * (1.0f / 128.0f) + 1e-6f);
#pragma unroll
                for (int nt = 0; nt < 8; ++nt) v[nt] = v[nt] * rstd * gg[nt];
                const int pos = n * 16 + 31; const float cs = tc[pos * 16 + l15], sn = tsn[pos * 16 + l15];
                const float x1 = v[0], x2 = v[1]; v[0] = x1 * cs - x2 * sn; v[1] = x2 * cs + x1 * sn;
            }
#pragma unroll
            for (int nt = 0; nt < 8; ++nt) { const float o = (n == 511) ? 0.f : v[nt]; OUT[(size_t)m * 128 + nt * 16 + l15] = (bf16_t)(cvt_pk_bf16(o, o) & 0xffffu); }
        }
    }
    __syncthreads();
}

__device__ __forceinline__ void phase5(const Frame& F, const Args& A) {
    FRESH_TID();
    const int w = F.wave;
    LAS float* xs = (LAS float*)F.lds;
    LAS float* red = (LAS float*)(F.lds + LTAB_OFF);
    LAS int* hist = (LAS int*)(F.lds + LTAB_OFF + 16384);
    LAS int* base = hist + 32;
    const float* X1 = A.in[I_X]; const bf16_t* ATT = (const bf16_t*)(F.ws + WS_H); const float* g2 = A.in[I_N2G]; const float* Wr = A.in[I_WR]; const float* br = A.in[I_BR];
    unsigned char* H2 = (unsigned char*)(F.ws + WS_H2);
    unsigned* slot = (unsigned*)(F.ws + WS_SLOT); int* tokl = (int*)(F.ws + WS_TOKL); float* wl = (float*)(F.ws + WS_WL);
    unsigned* counts = F.ctl + CW_CNT;
    constexpr int XS = 2050;
    float wr0[64], wr1[64];
    { const float* wb = Wr + (size_t)(256 * w + (lane >> 4)) * 32 + (lane & 15);
#pragma unroll
      for (int s = 0; s < 64; ++s) { wr0[s] = wb[(size_t)s * 128]; wr1[s] = wb[(size_t)s * 128 + 16]; } }
    LAS unsigned* rec = (LAS unsigned*)(F.lds + LTAB_OFF + 16384 + 512);
    int ci = 0;
    for (int ch = F.c; ch < NTOK / 16; ch += F.G, ++ci) {
        if ((ci & 3) == 0 && tid < 32) hist[tid] = 0;
        { const int tok0 = ch * 16 + 2 * w;
#pragma unroll 1
          for (int half = 0; half < 2; ++half) {
              const f32x4* xr = (const f32x4*)(X1 + (size_t)(tok0 + half) * DM) + lane; const u32x2* ar = (const u32x2*)(ATT + (size_t)(tok0 + half) * DM) + lane; f32x4 v[8]; u32x2 a[8]; float ssq = 0.f;
#pragma unroll
              for (int j = 0; j < 8; ++j) { v[j] = xr[64 * j]; a[j] = ar[64 * j]; }
#pragma unroll
              for (int j = 0; j < 8; ++j) { v[j][0] += bf_lo(a[j].x); v[j][1] += bf_hi(a[j].x); v[j][2] += bf_lo(a[j].y); v[j][3] += bf_hi(a[j].y);
                  ssq += (v[j][0] * v[j][0] + v[j][1] * v[j][1]) + (v[j][2] * v[j][2] + v[j][3] * v[j][3]); }
              const float rs = rsqrtf(wave_sum(ssq) * (1.0f / DM) + 1e-5f);
              unsigned* oo = (unsigned*)(H2 + (size_t)(tok0 + half) * DM) + lane;
#pragma unroll
              for (int j = 0; j < 8; ++j) { const f32x4 gg = ((const f32x4*)g2)[64 * j + lane];
                  const float y0 = v[j][0] * rs * gg[0], y1 = v[j][1] * rs * gg[1], y2 = v[j][2] * rs * gg[2], y3 = v[j][3] * rs * gg[3];
                  oo[64 * j] = pk4_fp8(y0, y1, y2, y3); LAS f32x2* d = (LAS f32x2*)(xs + (2 * w + half) * XS + (64 * j + lane) * 4); d[0] = (f32x2){y0, y1}; d[1] = (f32x2){y2, y3}; }
          }
        }
        __syncthreads();
        { f32x4 a0 = {0.f, 0.f, 0.f, 0.f}, a1 = {0.f, 0.f, 0.f, 0.f};
          const LAS float* xa = xs + (lane & 15) * XS + 256 * w + (lane >> 4);
#pragma unroll
          for (int s = 0; s < 64; ++s) { const float a = xa[4 * s];
              a0 = __builtin_amdgcn_mfma_f32_16x16x4f32(a, wr0[s], a0, 0, 0, 0); a1 = __builtin_amdgcn_mfma_f32_16x16x4f32(a, wr1[s], a1, 0, 0, 0); }
#pragma unroll
          for (int r = 0; r < 4; ++r) { red[(w * 16 + (lane >> 4) * 4 + r) * 32 + (lane & 15)] = a0[r]; red[(w * 16 + (lane >> 4) * 4 + r) * 32 + 16 + (lane & 15)] = a1[r]; } }
        __syncthreads();
        const int tl = tid >> 5, e = tid & 31, tok = ch * 16 + tl;
        float lg = br[e];
#pragma unroll
        for (int k = 0; k < 8; ++k) lg += red[(k * 16 + tl) * 32 + e];
        float tv[4]; int ti[4];
#pragma unroll
        for (int r = 0; r < 4; ++r) { float bv = lg; int bi = e;
#pragma unroll
            for (int off = 1; off < 32; off <<= 1) { const float ov = __shfl_xor(bv, off); const int oi = __shfl_xor(bi, off); if (ov > bv || (ov == bv && oi < bi)) { bv = ov; bi = oi; } }
            tv[r] = bv; ti[r] = bi; if (e == bi) lg = -INFINITY; }
        const float e1 = __expf(tv[1] - tv[0]), e2 = __expf(tv[2] - tv[0]), e3 = __expf(tv[3] - tv[0]); const float inv = 1.0f / (1.0f + e1 + e2 + e3);
        const int my_e = e == 0 ? ti[0] : e == 1 ? ti[1] : e == 2 ? ti[2] : ti[3];
        const float my_w = (e == 0 ? 1.0f : e == 1 ? e1 : e == 2 ? e2 : e3) * inv;
        if (e < 4) { const int lr = atomicAdd((int*)&hist[my_e], 1); LAS unsigned* r = rec + (((ci & 3) * 64) + tl * 4 + e) * 4;
            r[0] = (unsigned)tok * 4u + (unsigned)e; r[1] = (unsigned)my_e; r[2] = __float_as_uint(my_w); r[3] = (unsigned)lr; }
        const bool lastc = ch + F.G >= NTOK / 16;
        if ((ci & 3) == 3 || lastc) {
            __syncthreads();
            if (tid < 32) { const int hcnt = hist[tid]; base[tid] = hcnt > 0 ? (int)__hip_atomic_fetch_add(counts + 64 * tid, (unsigned)hcnt, RLX_AGENT) : 0; }
            __syncthreads();
            const int nrec = ((ci & 3) + 1) * 64;
            if (tid < nrec) { const LAS unsigned* r = rec + tid * 4; const unsigned ts = r[0], ee = r[1], wb = r[2]; const int rank = base[ee] + (int)r[3];
                __hip_atomic_store((unsigned*)tokl + (size_t)ee * NTOK + rank, ts >> 2, RLX_AGENT); __hip_atomic_store((unsigned*)wl + (size_t)ee * NTOK + rank, wb, RLX_AGENT);
                slot[ts] = (ee << 16) | (unsigned)rank; }
        }
        __syncthreads();
    }
}

__device__ __forceinline__ void moe_tables(const Frame& F) {
    FRESH_TID();
    LAS int* tb = (LAS int*)(F.lds + LTAB_OFF); LAS int* cn = tb + 64;
    if (tid < 32) cn[tid] = (int)__hip_atomic_load(F.ctl + CW_CNT + 64 * tid, RLX_AGENT);
    __syncthreads();
    if (tid == 0) { int acc = 0;
        for (int e = 0; e < 32; ++e) { tb[e] = acc; acc += (cn[e] + 255) >> 8; }
        tb[32] = acc; }
    __syncthreads();
}
__device__ __forceinline__ void phase8(const Frame& F, const Args& A) {
    FRESH_TID();
    const int gw = F.c * NWAVES + F.wave, NGW = F.G * NWAVES;
    const LAS int* tb = (const LAS int*)(F.lds + LTAB_OFF);
    const unsigned* slot = (const unsigned*)(F.ws + WS_SLOT); const bf16_t* Y = (const bf16_t*)(F.ws + WS_YBUF); float* out = A.out;
    for (int tok = gw; tok < NTOK; tok += NGW) {
        const u32x4 sl = *(const u32x4*)(slot + (size_t)tok * 4);
        const size_t r0 = (size_t)tb[sl.x >> 16] * 256 + (sl.x & 0xffffu), r1 = (size_t)tb[sl.y >> 16] * 256 + (sl.y & 0xffffu), r2 = (size_t)tb[sl.z >> 16] * 256 + (sl.z & 0xffffu), r3 = (size_t)tb[sl.w >> 16] * 256 + (sl.w & 0xffffu);
        f32x4* xo = (f32x4*)(out + (size_t)tok * DM) + lane; const f32x4* xi = (const f32x4*)(A.in[I_X] + (size_t)tok * DM) + lane; const u32x2* at = (const u32x2*)((const bf16_t*)(F.ws + WS_H) + (size_t)tok * DM) + lane;
        const u32x2* y0 = (const u32x2*)(Y + r0 * DM) + lane; const u32x2* y1 = (const u32x2*)(Y + r1 * DM) + lane; const u32x2* y2 = (const u32x2*)(Y + r2 * DM) + lane; const u32x2* y3 = (const u32x2*)(Y + r3 * DM) + lane;
#pragma unroll
        for (int j = 0; j < 8; ++j) { f32x4 v = xi[64 * j]; const u32x2 t = at[64 * j]; v[0] += bf_lo(t.x); v[1] += bf_hi(t.x); v[2] += bf_lo(t.y); v[3] += bf_hi(t.y);
            const u32x2 a = y0[64 * j], b = y1[64 * j], c = y2[64 * j], d = y3[64 * j];
            v[0] += (bf_lo(a.x) + bf_lo(b.x)) + (bf_lo(c.x) + bf_lo(d.x)); v[1] += (bf_hi(a.x) + bf_hi(b.x)) + (bf_hi(c.x) + bf_hi(d.x));
            v[2] += (bf_lo(a.y) + bf_lo(b.y)) + (bf_lo(c.y) + bf_lo(d.y)); v[3] += (bf_hi(a.y) + bf_hi(b.y)) + (bf_hi(c.y) + bf_hi(d.y));
            xo[64 * j] = v; }
    }
}

constexpr int NPHASE = 10;
__global__ void __launch_bounds__(NWAVES * 64, 2) hybrid_fwd(Args args) {
    extern __shared__ __attribute__((aligned(16))) unsigned char lds[];
    Frame F;
    F.lds = (LAS unsigned char*)lds; F.ldsg = (char*)lds;
    F.wave = __builtin_amdgcn_readfirstlane((int)(threadIdx.x >> 6));
    F.G = gridDim.x; F.c = blockIdx.x;
    F.ws = args.ws; F.ctl = (unsigned*)(args.ws + WS_CTL);
    volatile LAS unsigned* MISC = (volatile LAS unsigned*)(F.lds + MISC_OFF);
    { const int l0 = fresh_lane(); if (F.wave == 0) MISC[l0] = 0u; }
    __syncthreads();
    XcdBarrier bar; bar.bar = F.ctl + CW_BAR; bar.x = 0; bar.st = nullptr;
    if (args.use_bar) bar = xcd_barrier_post(F.ctl + CW_BAR, MISC + 8, F.wave == 0 && fresh_lane() == 0);
    const int lo = args.ph_lo, hi = args.ph_hi;
#ifndef PHASE_MASK
#define PHASE_MASK 0x3ff
#endif
#define IN(k) ((((PHASE_MASK) >> (k)) & 1) && lo <= (k) && (k) < hi)
#ifndef DBL_MASK
#define DBL_MASK 0
#endif
#define DBL(k) (((DBL_MASK) >> (k)) & 1)
#define SEAM(k) do { if (IN(k) && IN((k) + 1)) xcd_barrier(bar, F.wave == 0 && fresh_lane() == 0); } while (0)

    if (IN(0)) { for (int rep = 0; rep <= DBL(0); ++rep) phase0(F, args); }
    SEAM(0);
    if (IN(1)) for (int rep = 0; rep <= DBL(1); ++rep) {
        pg8::DenseSched S; S.init(F.ws + WS_H, DM, F.ws + WS_WINT, NTOK, NINP, DM, F.G, F.c);
        epi::InProj E{(bf16_t*)(F.ws + WS_Q), (bf16_t*)(F.ws + WS_KV), (bf16_t*)(F.ws + WS_PIN), (float*)(F.ws + WS_GLOG)};
        pg8::gemm_phase(F.lds, S, E, DM * 2, F.wave);
        if (rep == 0) { if (F.G == 256) { if (F.c >= 192) posb_partials(F, args, F.c - 192, 64); } else posb_partials(F, args, F.c, F.G); }
    }
    SEAM(1);
    if (IN(2)) {
        const bool split = F.G >= 128;
        if (!split || F.c < 64) {
            pg8::CmpSched S{(const char*)(F.ws + WS_KV), (const char*)(F.ws + WS_W1T), split ? 64 : F.G, F.c};
            epi::CmpHid E{(float*)(F.ws + WS_ACT)};
            pg8::gemm_phase(F.lds, S, E, 8192, F.wave, 16);
        }
        if (!split || F.c >= 64) { const int ec = split ? F.c - 64 : F.c, eG = split ? F.G - 64 : F.G;
            if (ec == 0 && F.wave == 0) cmp_bias_total(F, args);
            norm_rope_rows(F, args, ec, eG); pool_diffs(F, ec, eG); }
    }
    SEAM(2);
    if (IN(3)) { for (int L = F.c; L < 256; L += F.G) cmp_layer2(F, args, L >> 7, L & 127); }
    SEAM(3);
    if (IN(4)) for (int rep = 0; rep <= DBL(4); ++rep) {
        { pg8::PoolSched S{(const char*)(F.ws + WS_DP), (const char*)(F.ws + WS_PWT), F.G, F.c};
          epi::Pool E{(bf16_t*)(F.ws + WS_MIX), args.in[I_POOLS]};
          pg8::gemm_phase(F.lds, S, E, 512, F.wave); }
        __syncthreads();
        att::Ptrs P{(const bf16_t*)(F.ws + WS_Q), (const bf16_t*)(F.ws + WS_KV), (const bf16_t*)(F.ws + WS_CMP), (const bf16_t*)(F.ws + WS_CMP + 512 * 1024),
                    (const float*)(F.ws + WS_GLOG), (bf16_t*)(F.ws + WS_MIX), (float*)(F.ws + WS_ASCR) + (size_t)F.c * 256 * 128};
        att::Conv cv = att::conv_init(args.in[I_WGU], args.in[I_WD], F.ws, F.c, F.G == 256 && rep == 0);
        for (int r = 0;; ++r) { const int k = r * F.G + ((r & 1) ? (F.G - 1 - F.c) : F.c); if (k >= 512) break;
            const int qi = 127 - (k >> 2), bg = k & 3;
#if ATT_CHECK
            att::attn_item<0, false>(F.ldsg, P, bg >> 1, bg & 1, qi, F.wave, F.ctl + CW_ERR, cv); att::attn_item<1, true>(F.ldsg, P, bg >> 1, bg & 1, qi, F.wave, F.ctl + CW_ERR, cv);
#else
            att::attn_item<1, false>(F.ldsg, P, bg >> 1, bg & 1, qi, F.wave, F.ctl + CW_ERR, cv);
#endif
        }
        att::conv_tail(F.ldsg, cv, F.wave);
        __syncthreads();
    }
    SEAM(4);
    if (IN(5)) for (int rep = 0; rep <= DBL(5); ++rep) {
        pg8::DenseSched S; S.init(F.ws + WS_MIX, DM, F.ws + WS_WOUTT, NTOK, DM, DM, F.G, F.c);
        epi::OutProj E{(bf16_t*)(F.ws + WS_H)};
        pg8::gemm_phase(F.lds, S, E, DM * 2, F.wave);
    }
    SEAM(5);
    if (IN(6)) { phase5(F, args); }
    SEAM(6);
    if (IN(7)) for (int rep = 0; rep <= DBL(7); ++rep) {
        moe_tables(F);
        pg8::MoeSched<16, true> S{(const char*)(F.ws + WS_H2), (const char*)(F.ws + WS_WGU), (const int*)(F.ws + WS_TOKL), (const LAS int*)(F.lds + LTAB_OFF), (const LAS int*)(F.lds + LTAB_OFF) + 64, F.G, F.c, (size_t)4096 * 2048};
        epi::GateUp E{(unsigned char*)(F.ws + WS_ACT), args.in[I_BGU]};
        pg8::gemm_phase(F.lds, S, E, DM, F.wave);
    }
    SEAM(7);
    if (IN(8)) for (int rep = 0; rep <= DBL(8); ++rep) {
        moe_tables(F);
        pg8::MoeSched<8, false> S{(const char*)(F.ws + WS_ACT), (const char*)(F.ws + WS_WD), nullptr, (const LAS int*)(F.lds + LTAB_OFF), (const LAS int*)(F.lds + LTAB_OFF) + 64, F.G, F.c, (size_t)2048 * 2048};
        epi::Down E{(bf16_t*)(F.ws + WS_YBUF), args.in[I_BD], (const float*)(F.ws + WS_WL)};
        pg8::gemm_phase(F.lds, S, E, DFF, F.wave);
    }
    SEAM(8);
    if (IN(9)) { moe_tables(F); phase8(F, args);
#if ATT_CHECK
        if (__hip_atomic_load(F.ctl + CW_ERR, RLX_AGENT) != 0u && F.c == 0 && F.wave == 0) { VM_WAIT(); args.out[fresh_lane()] = __builtin_nanf(""); }
#endif
    }
#undef IN
#undef SEAM
}

#ifndef N_LAUNCH_MODE
#define N_LAUNCH_MODE 1
#endif
extern "C" void kernel_launch(void* const* d_in, const int* in_sizes, int n_in, void* d_out, int out_size, void* d_ws, size_t ws_size, hipStream_t stream) {
    static int grid = 0;
    if (grid == 0) {
        if (n_in != 27 || out_size != NTOK * DM || ws_size < WS_END) { fprintf(stderr, "kernel_launch: unexpected shapes (n_in %d out %d ws %zu)\n", n_in, out_size, ws_size); grid = -1; return; }
        int dev = 0, cus = 0, per_cu = 0;
        if (hipGetDevice(&dev) != hipSuccess || hipDeviceGetAttribute(&cus, hipDeviceAttributeMultiprocessorCount, dev) != hipSuccess) { grid = -1; return; }
        if (hipFuncSetAttribute((const void*)hybrid_fwd, hipFuncAttributeMaxDynamicSharedMemorySize, LDS_BYTES) != hipSuccess) { fprintf(stderr, "kernel_launch: hipFuncSetAttribute failed\n"); grid = -1; return; }
        if (hipOccupancyMaxActiveBlocksPerMultiprocessor(&per_cu, (const void*)hybrid_fwd, NWAVES * 64, LDS_BYTES) != hipSuccess || per_cu < 1) { fprintf(stderr, "kernel_launch: occupancy query says %d\n", per_cu); }
        (void)hipGetLastError();
        grid = cus;
    }
    if (grid < 0) return;
    (void)hipMemsetAsync((char*)d_ws + WS_CTL, 0, CTL_ZERO_BYTES, stream);
    Args a{};
    for (int i = 0; i < 27; ++i) a.in[i] = (const float*)d_in[i];
    a.out = (float*)d_out; a.ws = (unsigned char*)d_ws; a.pad = 0;
    if (N_LAUNCH_MODE == 1) {
        a.ph_lo = 0; a.ph_hi = NPHASE; a.use_bar = 1;
        hipLaunchKernelGGL(hybrid_fwd, dim3(grid), dim3(NWAVES * 64), LDS_BYTES, stream, a);
    } else {
        for (int p = 0; p < NPHASE; ++p) { a.ph_lo = p; a.ph_hi = p + 1; a.use_bar = 0;
            hipLaunchKernelGGL(hybrid_fwd, dim3(grid), dim3(NWAVES * 64), LDS_BYTES, stream, a); }
    }
}
```

```cpp
#include <hip/hip_runtime.h>
#include <cstdio>
#include <cstdint>

#define LAS __attribute__((address_space(3)))
#define GAS __attribute__((address_space(1)))
typedef unsigned short bf16_t;
typedef short bf16x8 __attribute__((ext_vector_type(8)));
typedef short s16x4 __attribute__((ext_vector_type(4)));
typedef float f32x4 __attribute__((ext_vector_type(4)));
typedef float f32x2 __attribute__((ext_vector_type(2)));
typedef float f32x16 __attribute__((ext_vector_type(16)));
typedef unsigned u32x4 __attribute__((ext_vector_type(4)));
typedef unsigned u32x2 __attribute__((ext_vector_type(2)));
typedef int i32x4 __attribute__((ext_vector_type(4)));
typedef int i32x8 __attribute__((ext_vector_type(8)));

constexpr int NB = 2, SEQ = 8192, NTOK = NB * SEQ, DM = 2048, NHEAD = 8, HD = 128, NGRP = 2, NEXP = 32, DFF = 2048;
constexpr int NINP = 3840;
constexpr int NCMP = 512;
constexpr int ACT_ROWS = 4 * NTOK + NEXP * 256;
constexpr int NWAVES = 8;

constexpr size_t MiB = 1u << 20;
constexpr size_t WS_CTL = 0, CTL_ZERO_BYTES = 1 * MiB;
constexpr size_t WS_COS = 1 * MiB, WS_SIN = 2 * MiB;
constexpr size_t WS_POSB64 = 2 * MiB + 655360;
constexpr size_t WS_POSB = 3 * MiB;
constexpr size_t WS_W2T = 3 * MiB + 65536;
constexpr size_t WS_WINT = 4 * MiB;
constexpr size_t WS_WOUTT = 20 * MiB;
constexpr size_t WS_W1T = 28 * MiB;
constexpr size_t WS_PWT = 32 * MiB;
constexpr size_t WS_H = 34 * MiB;
constexpr size_t WS_Q = 98 * MiB;
constexpr size_t WS_KV = 130 * MiB, KV_STRIDE = 9 * MiB;
constexpr size_t WS_PIN = 184 * MiB;
constexpr size_t WS_DP = 216 * MiB;
constexpr size_t WS_GLOG = 248 * MiB;
constexpr size_t WS_HID = 250 * MiB;
constexpr size_t WS_CMP = 252 * MiB;
constexpr size_t WS_MIX = 254 * MiB;
constexpr size_t WS_ASCR = 318 * MiB;
constexpr size_t WS_H2 = 350 * MiB;
constexpr size_t WS_SLOT = 414 * MiB;
constexpr size_t WS_TOKL = 415 * MiB;
constexpr size_t WS_WL = 417 * MiB;
constexpr size_t WS_ACT = 420 * MiB;
constexpr size_t WS_YBUF = 708 * MiB;
constexpr size_t WS_WGU = 1024 * MiB;
constexpr size_t WS_WD = 1536 * MiB;
constexpr size_t WS_END = 1792 * MiB;

constexpr int CW_BAR = 4096;
constexpr int CW_CNT = 8192;
constexpr int CW_ERR = 12288;
#ifndef ATT_CHECK
#define ATT_CHECK 0
#endif

constexpr int RING_BYTES = 131072;
constexpr int LTAB_OFF = 133120;
constexpr int SIDE_OFF = LTAB_OFF + 2048, SIDE_BYTES = 4096;
constexpr int MISC_OFF = LTAB_OFF + 24576;
constexpr int LDS_BYTES = MISC_OFF + 256;

#define RLX_AGENT __ATOMIC_RELAXED, __HIP_MEMORY_SCOPE_AGENT
#define LDS_WAIT() asm volatile("s_waitcnt lgkmcnt(0)" ::: "memory")
#define VM_WAIT() asm volatile("s_waitcnt vmcnt(0)" ::: "memory")
__device__ __forceinline__ unsigned cvt_pk_bf16(float lo, float hi) { unsigned r; asm volatile("v_cvt_pk_bf16_f32 %0, %1, %2" : "=v"(r) : "v"(lo), "v"(hi)); return r; }
__device__ __forceinline__ unsigned cvt_pk_bf16_mfma(float lo, float hi) { unsigned r; asm volatile("v_cvt_pk_bf16_f32 %0, %1, %2\n\ts_nop 1" : "=v"(r) : "v"(lo), "v"(hi)); return r; }
__device__ __forceinline__ float bf_lo(unsigned u) { return __uint_as_float(u << 16); }
__device__ __forceinline__ float bf_hi(unsigned u) { return __uint_as_float(u & 0xffff0000u); }
__device__ __forceinline__ float fast_exp2(float x) { return __builtin_amdgcn_exp2f(x); }
__device__ __forceinline__ float fast_rcp(float x) { return __builtin_amdgcn_rcpf(x); }
__device__ __forceinline__ float sigmoidf_(float x) { return fast_rcp(1.0f + fast_exp2(-1.4426950408889634f * x)); }
__device__ __forceinline__ float wave_sum(float v) {
#define WS_STEP(ctrl, rmask) v += __int_as_float(__builtin_amdgcn_update_dpp(0, __float_as_int(v), ctrl, rmask, 0xf, false))
    WS_STEP(0x111, 0xf); WS_STEP(0x112, 0xf); WS_STEP(0x114, 0xf); WS_STEP(0x118, 0xf); WS_STEP(0x142, 0xa); WS_STEP(0x143, 0xc);
#undef WS_STEP
    return __int_as_float(__builtin_amdgcn_readlane(__float_as_int(v), 63));
}
__device__ __forceinline__ int fresh_lane() { int l; asm volatile("v_mbcnt_lo_u32_b32 %0, -1, 0\n\tv_mbcnt_hi_u32_b32 %0, -1, %0" : "=v"(l)); return l; }

#define XB_TMO      128
#define XB_XCNT(j)  (256  + 64 * (j))
#define XB_XSUB(j)  (1280 + 64 * (j))
#define XB_XGEN(j)  (2304 + 64 * (j))
#define XB_TOP      3328
#define XB_TOPGEN   3392
#define XCD_BAR_WORDS 3456
#define XB_SPIN_CAP (1u << 20)
__device__ __forceinline__ unsigned xb_ld(unsigned* p)              { return __hip_atomic_load(p, __ATOMIC_RELAXED, __HIP_MEMORY_SCOPE_AGENT); }
__device__ __forceinline__ unsigned xb_add(unsigned* p, unsigned v) { return __hip_atomic_fetch_add(p, v, __ATOMIC_RELAXED, __HIP_MEMORY_SCOPE_AGENT); }
__device__ __forceinline__ unsigned xb_xcc_id() { return (unsigned)__builtin_amdgcn_s_getreg((3 << 11) | 20) & 0xFu; }
#define XB_SPIN(cond, bar) do { unsigned _sp = 0; while (cond) { __builtin_amdgcn_s_sleep(1); \
    if ((++_sp & 255u) == 0u) { if (xb_ld(&(bar)[XB_TMO])) break; if (_sp > XB_SPIN_CAP) { atomicAdd(&(bar)[XB_TMO], 1u); break; } } } } while (0)
struct XcdBarrier { unsigned* bar; unsigned x; volatile LAS unsigned* st; };
__device__ __forceinline__ XcdBarrier xcd_barrier_post(unsigned* bar, volatile LAS unsigned* st, bool t0) {
    XcdBarrier b; b.bar = bar; b.x = xb_xcc_id(); b.st = st;
    if (t0) (void)xb_add(&bar[XB_XCNT(b.x)], 1u);
    return b;
}
__device__ __forceinline__ void xcd_barrier_complete(unsigned* bar, unsigned x, unsigned& nloc, unsigned& nx) {
    const unsigned G = gridDim.x * gridDim.y * gridDim.z;
    unsigned sum, cnt, mine, sp = 0u;
    for (;;) {
        sum = 0u; cnt = 0u; mine = 0u;
#pragma unroll
        for (unsigned j = 0; j < 16; ++j) { const unsigned c = xb_ld(&bar[XB_XCNT(j)]); sum += c; cnt += (c > 0u) ? 1u : 0u; mine = (j == x) ? c : mine; }
        if (sum == G) break;
        __builtin_amdgcn_s_sleep(1);
        if ((++sp & 255u) == 0u) { if (xb_ld(&bar[XB_TMO])) break; if (sp > XB_SPIN_CAP) { atomicAdd(&bar[XB_TMO], 1u); break; } }
    }
    nloc = mine > 0u ? mine : 1u; nx = cnt > 0u ? cnt : 1u;
}
__device__ __forceinline__ void xcd_barrier(const XcdBarrier& b, bool t0) {
    asm volatile("s_waitcnt vmcnt(0)" ::: "memory");
    __syncthreads();
    if (t0) {
        unsigned* bar = b.bar;
        __builtin_amdgcn_s_waitcnt(0);
        unsigned nloc = b.st[0], nx = b.st[1];
        if (nloc == 0u) { xcd_barrier_complete(bar, b.x, nloc, nx); b.st[0] = nloc; b.st[1] = nx; }
        const unsigned old = xb_add(&bar[XB_XSUB(b.x)], 1u);
        const unsigned gen = old / nloc;
        if (old + 1u == (gen + 1u) * nloc) {
            __builtin_amdgcn_fence(__ATOMIC_RELEASE, "agent");
            asm volatile("s_waitcnt vmcnt(0)" ::: "memory");
            const unsigned og = xb_add(&bar[XB_TOP], 1u);
            const unsigned tg = og / nx;
            if (og + 1u == (tg + 1u) * nx) xb_add(&bar[XB_TOPGEN], 1u);
            else XB_SPIN(xb_ld(&bar[XB_TOPGEN]) == tg, bar);
            __builtin_amdgcn_fence(__ATOMIC_ACQUIRE, "agent");
            xb_add(&bar[XB_XGEN(b.x)], 1u);
            asm volatile("s_waitcnt vmcnt(0)" ::: "memory");
        } else {
            XB_SPIN(xb_ld(&bar[XB_XGEN(b.x)]) == gen, bar);
            __builtin_amdgcn_fence(__ATOMIC_ACQUIRE, "agent");
            asm volatile("s_waitcnt vmcnt(0)" ::: "memory");
        }
    }
    __syncthreads();
}

struct Args {
    const float* in[27];
    float* out;
    unsigned char* ws;
    int ph_lo, ph_hi;
    int use_bar, pad;
};
enum { I_X = 0, I_N1G, I_WIN, I_QNG, I_KNC, I_KNS, I_KNW, I_CKPOS, I_CKW1, I_CKB1, I_CKW2, I_CKB2, I_CVPOS, I_CVW1, I_CVB1, I_CVW2, I_CVB2,
       I_POOLW, I_POOLS, I_WOUT, I_N2G, I_WR, I_BR, I_WGU, I_BGU, I_WD, I_BD };

#ifndef EPI_DBL_MASK
#define EPI_DBL_MASK 0
#endif
namespace pg8 {
constexpr int BM = 256, BK = 64, HALF = 128, HTB = HALF * BK * 2, STAGE_BYTES = 8 * HTB, NXCD = 8, WGM = 8;
__host__ __device__ __forceinline__ int lds_byte(int r, int c) { const int st = (r >> 4) * 2 + (c >> 5), rr = r & 15, cc = c & 31, ob = rr * 64 + cc * 2; return st * 1024 + (ob ^ (((ob >> 9) & 1) << 5)); }
__host__ __device__ __forceinline__ void stage_rc(int b, int& R, int& C) { const int st = b / 1024, sb = b % 1024, swz = sb ^ (((sb >> 9) & 1) << 5); R = (st >> 1) * 16 + swz / 64; C = (st & 1) * 32 + (swz % 64) / 2; }
__host__ __device__ __forceinline__ int perm32(int rho) { const int n = rho >> 4, i = rho & 15; return 8 * (i >> 2) + 4 * n + (i & 3); }

template <class Epi, class Sched>
__device__ __forceinline__ void gemm_phase(LAS unsigned char* lds, const Sched& S, const Epi& E, const int Kb  , const int wid, const int ntiles = 0  ) {
    const int lane = fresh_lane(), tid = wid * 64 + lane, wr = wid >> 2, wc = wid & 3, fr = lane & 15, fq = lane >> 4;
    const int nt = ntiles ? ntiles : Kb / 128;
    constexpr int BR = Sched::B_K16;
    int Rr[2], Cc[2]; unsigned voffB[2];
#pragma unroll
    for (int i = 0; i < 2; ++i) { int R, C; stage_rc(tid * 16 + i * 8192, R, C); Rr[i] = R; Cc[i] = C; const int Rb = Epi::PERM ? ((R & ~31) + perm32(R & 31)) : R; voffB[i] = BR ? (unsigned)(((C >> 3) * BR + Rb) * 16) : (unsigned)(Rb * Kb) + (unsigned)C * 2u; }
    const size_t kstep = (size_t)(BK * 2);
    const size_t kstepB = BR ? (size_t)8 * BR * 16 : kstep;
    const size_t hstepB = BR ? (size_t)HALF * 16 : (size_t)HALF * Kb;
    const unsigned ldsw = (unsigned)wid * 1024u;
    const int aoff = lds_byte(wr * 64 + fr, fq * 8), boff = lds_byte(wc * 32 + fr, fq * 8);
    const char* const Ab = S.a_base();
#define PG8_SA(b, h) (((b) * 2 + (h)) * HTB)
#define PG8_SB(b, h) ((4 + (b) * 2 + (h)) * HTB)
#define PG8_STAGE(bufoff, gbase, voff) do { _Pragma("unroll") for (int _i = 0; _i < 2; ++_i) \
        __builtin_amdgcn_global_load_lds((const unsigned*)((const char*)(gbase) + (voff)[_i]), (LAS unsigned*)(lds + (bufoff) + ldsw + _i * 8192), 16, 0, 0); } while (0)
#define PG8_LDA(dst, b, h) do { _Pragma("unroll") for (int m = 0; m < 4; ++m) _Pragma("unroll") for (int k = 0; k < 2; ++k) dst[m][k] = *(const LAS bf16x8*)(lds + PG8_SA(b, h) + aoff + m * 2048 + k * 1024); } while (0)
#define PG8_LDB(dst, b, h) do { _Pragma("unroll") for (int n = 0; n < 2; ++n) _Pragma("unroll") for (int k = 0; k < 2; ++k) dst[n][k] = *(const LAS bf16x8*)(lds + PG8_SB(b, h) + boff + n * 2048 + k * 1024); } while (0)
#define PG8_MMA(ai, bj, At, Bt) do { __builtin_amdgcn_s_setprio(1); \
        if constexpr (Epi::FP8) { _Pragma("unroll") for (int m = 0; m < 4; ++m) _Pragma("unroll") for (int n = 0; n < 2; ++n) { \
            const i32x8 _b = __builtin_shufflevector(__builtin_bit_cast(i32x4, Bt[n][0]), __builtin_bit_cast(i32x4, Bt[n][1]), 0, 1, 2, 3, 4, 5, 6, 7); \
            const i32x8 _a = __builtin_shufflevector(__builtin_bit_cast(i32x4, At[m][0]), __builtin_bit_cast(i32x4, At[m][1]), 0, 1, 2, 3, 4, 5, 6, 7); \
            acc[ai][bj][m][n] = __builtin_amdgcn_mfma_scale_f32_16x16x128_f8f6f4(_b, _a, acc[ai][bj][m][n], 0, 0, 0, 0x7f7f7f7f, 0, 0x7f7f7f7f); } } \
        else { _Pragma("unroll") for (int m = 0; m < 4; ++m) _Pragma("unroll") for (int n = 0; n < 2; ++n) _Pragma("unroll") for (int k = 0; k < 2; ++k) \
            acc[ai][bj][m][n] = __builtin_amdgcn_mfma_f32_16x16x32_bf16(Bt[n][k], At[m][k], acc[ai][bj][m][n], 0, 0, 0); } \
        __builtin_amdgcn_s_setprio(0); } while (0)
#define PG8_WAIT_V(n) asm volatile("s_waitcnt vmcnt(" #n ")" ::: "memory")
#define PG8_WAIT_L(n) asm volatile("s_waitcnt lgkmcnt(" #n ")" ::: "memory")
#define PG8_BAR __builtin_amdgcn_s_barrier()
#define PG8_SCHED __builtin_amdgcn_sched_barrier(0)
    typename Sched::Unit cur, nxt; int ui = 0;
    if (!S.next(0, cur)) return;
    f32x4 acc[2][2][4][2];
#pragma unroll
    for (int a = 0; a < 2; ++a)
#pragma unroll
        for (int b = 0; b < 2; ++b)
#pragma unroll
            for (int m = 0; m < 4; ++m)
#pragma unroll
                for (int n = 0; n < 2; ++n) acc[a][b][m][n] = (f32x4){0.f, 0.f, 0.f, 0.f};
    bf16x8 At[4][2], B0[2][2], B1[2][2];
    unsigned offA0[2], offA1[2], nofA0[2], nofA1[2];
#pragma unroll
    for (int i = 0; i < 2; ++i) { offA0[i] = S.a_off(cur, Rr[i], Cc[i]); offA1[i] = S.a_off(cur, HALF + Rr[i], Cc[i]); nofA0[i] = offA0[i]; nofA1[i] = offA1[i]; }
    const char* cB = S.b_ptr(cur);
    PG8_STAGE(PG8_SB(0, 0), cB, voffB); PG8_STAGE(PG8_SA(0, 0), Ab, offA0); PG8_STAGE(PG8_SB(0, 1), cB + hstepB, voffB); PG8_STAGE(PG8_SA(0, 1), Ab, offA1);
    if (wr == 1) PG8_BAR;
    PG8_WAIT_V(4); PG8_BAR;
    PG8_STAGE(PG8_SB(1, 0), cB + kstepB, voffB); PG8_STAGE(PG8_SA(1, 0), Ab + kstep, offA0); PG8_STAGE(PG8_SB(1, 1), cB + hstepB + kstepB, voffB);
    PG8_WAIT_V(6); PG8_BAR;
    for (;;) {
        const bool has_next = S.next(ui + 1, nxt);
        const char* nB = has_next ? S.b_ptr(nxt) : cB;
        if (has_next) {
            if constexpr (Sched::SIDE_IDX) S.stage_idx(lds, nxt, (ui + 1) & 1, wid, lane);
            else {
#pragma unroll
                for (int i = 0; i < 2; ++i) { nofA0[i] = S.a_off(nxt, Rr[i], Cc[i]); nofA1[i] = S.a_off(nxt, HALF + Rr[i], Cc[i]); }
            }
        }
        E.stage(lds, cur, ui & 1, wid, lane);
        for (int t = 0; t < nt; t += 2) {
            const bool last = (t == nt - 2);
            const char* a1 = Ab + (size_t)(t + 1) * kstep;
            PG8_LDB(B0, 0, 0); PG8_SCHED; PG8_LDA(At, 0, 0); PG8_STAGE(PG8_SA(1, 1), a1, offA1);
            if (last) {
                if constexpr (Sched::SIDE_IDX) { if (has_next) {
#pragma unroll
                    for (int i = 0; i < 2; ++i) { nofA0[i] = S.a_off_lds(lds, nxt, (ui + 1) & 1, Rr[i], Cc[i]); nofA1[i] = S.a_off_lds(lds, nxt, (ui + 1) & 1, HALF + Rr[i], Cc[i]); } } }
#pragma unroll
                for (int i = 0; i < 2; ++i) { offA0[i] = nofA0[i]; offA1[i] = nofA1[i]; }
            }
            const char* a2 = last ? Ab : Ab + (size_t)(t + 2) * kstep; const char* b2 = last ? nB : cB + (size_t)(t + 2) * kstepB;
            const char* a3 = a2 + kstep; const char* b3 = b2 + kstepB;
            PG8_WAIT_L(8); PG8_BAR; PG8_WAIT_L(0); PG8_MMA(0, 0, At, B0); PG8_BAR; PG8_SCHED;
            PG8_LDB(B1, 0, 1); PG8_STAGE(PG8_SB(0, 0), b2, voffB);
            PG8_BAR; PG8_WAIT_L(0); PG8_MMA(0, 1, At, B1); PG8_BAR;
            PG8_LDA(At, 0, 1); PG8_STAGE(PG8_SA(0, 0), a2, offA0);
            PG8_BAR; PG8_WAIT_L(0); PG8_MMA(1, 0, At, B0); PG8_BAR; PG8_SCHED;
            PG8_STAGE(PG8_SB(0, 1), b2 + hstepB, voffB);
            PG8_WAIT_V(6); PG8_BAR; PG8_MMA(1, 1, At, B1); PG8_BAR;
            PG8_LDB(B0, 1, 0); PG8_SCHED; PG8_LDA(At, 1, 0); PG8_STAGE(PG8_SA(0, 1), a2, offA1);
            PG8_WAIT_L(8); PG8_BAR; PG8_WAIT_L(0); PG8_MMA(0, 0, At, B0); PG8_BAR; PG8_SCHED;
            PG8_LDB(B1, 1, 1); PG8_STAGE(PG8_SB(1, 0), b3, voffB);
            PG8_BAR; PG8_WAIT_L(0); PG8_MMA(0, 1, At, B1); PG8_BAR;
            PG8_LDA(At, 1, 1); PG8_STAGE(PG8_SA(1, 0), a3, offA0);
            PG8_BAR; PG8_WAIT_L(0); PG8_MMA(1, 0, At, B0); PG8_BAR; PG8_SCHED;
            PG8_STAGE(PG8_SB(1, 1), b3 + hstepB, voffB);
            PG8_WAIT_V(6); PG8_BAR; PG8_MMA(1, 1, At, B1); PG8_BAR;
        }
        E(acc, cur, wr, wc, fr, fq, lds, ui & 1);
        if constexpr ((EPI_DBL_MASK & Epi::ID) != 0) E(acc, cur, wr, wc, fr, fq, lds, ui & 1);
        if (!has_next) break;
#pragma unroll
        for (int a = 0; a < 2; ++a)
#pragma unroll
            for (int b = 0; b < 2; ++b)
#pragma unroll
                for (int m = 0; m < 4; ++m)
#pragma unroll
                    for (int n = 0; n < 2; ++n) acc[a][b][m][n] = (f32x4){0.f, 0.f, 0.f, 0.f};
        cur = nxt; cB = nB; ++ui;
    }
    PG8_WAIT_V(0);
    if (wr == 0) PG8_BAR;
    PG8_BAR;
#undef PG8_SA
#undef PG8_SB
#undef PG8_STAGE
#undef PG8_LDA
#undef PG8_LDB
#undef PG8_MMA
#undef PG8_WAIT_V
#undef PG8_WAIT_L
#undef PG8_BAR
#undef PG8_SCHED
}

struct DUnit { int pm, pn; };
struct DenseSched {
    typedef DUnit Unit; static constexpr bool SIDE_IDX = false; static constexpr int B_K16 = 0;
    const char* A; unsigned lda2; const char* Bt; int K; int nM, nN, nwg, G, c;
    __device__ __forceinline__ void init(const void* A_, int lda, const void* Bt_, int M, int N, int K_, int G_, int c_) { A = (const char*)A_; lda2 = (unsigned)lda * 2u; Bt = (const char*)Bt_; K = K_; nM = M / BM; nN = N / BM; nwg = nM * nN; G = G_; c = c_; }
    __device__ __forceinline__ bool next(int i, Unit& u) const {
        const long L = (long)i * G + c; if (L >= nwg) return false;
        int wgid = (int)L; { const int q = nwg / NXCD, r = nwg % NXCD, xcd = wgid % NXCD, off = wgid / NXCD; wgid = (xcd < r ? xcd * (q + 1) : r * (q + 1) + (xcd - r) * q) + off; }
        const int nig = WGM * nN, gid = wgid / nig, fm = gid * WGM, gsz = (nM - fm) < WGM ? (nM - fm) : WGM;
        u.pm = fm + ((wgid % nig) % gsz); u.pn = (wgid % nig) / gsz; return true;
    }
    __device__ __forceinline__ const char* a_base() const { return A; }
    __device__ __forceinline__ unsigned a_off(const Unit& u, int r, int C) const { return (unsigned)(u.pm * BM + r) * lda2 + (unsigned)C * 2u; }
    __device__ __forceinline__ const char* b_ptr(const Unit& u) const { return Bt + (size_t)u.pn * BM * K * 2; }
};
}

namespace epi {
using pg8::BM; using pg8::HALF;
struct InProj {
    __device__ __forceinline__ void stage(LAS unsigned char*, const pg8::DUnit&, int, int, int) const {}
    static constexpr bool PERM = true; static constexpr int ID = 1; static constexpr bool FP8 = false;
    bf16_t* Q; bf16_t* KV; bf16_t* PIN; float* GLOG;
    __device__ __forceinline__ void operator()(const f32x4 (&acc)[2][2][4][2], const pg8::DUnit& u, int wr, int wc, int fr, int fq, LAS unsigned char*, int) const {
        const int row0 = u.pm * BM + wr * 64 + fr, cw = wc * 32 + 8 * fq;
#pragma unroll
        for (int ai = 0; ai < 2; ++ai)
#pragma unroll
            for (int m = 0; m < 4; ++m) {
                const int row = row0 + ai * HALF + m * 16;
#pragma unroll
                for (int bj = 0; bj < 2; ++bj) {
                    const f32x4 v0 = acc[ai][bj][m][0], v1 = acc[ai][bj][m][1];
                    if (u.pn == 14) {
                        if (bj == 0 && cw < 24) { float* g = GLOG + (size_t)row * 32 + cw; *(f32x4*)g = v0; *(f32x4*)(g + 4) = v1; }
                    } else {
                        u32x4 w; w.x = cvt_pk_bf16(v0[0], v0[1]); w.y = cvt_pk_bf16(v0[2], v0[3]); w.z = cvt_pk_bf16(v1[0], v1[1]); w.w = cvt_pk_bf16(v1[2], v1[3]);
                        bf16_t* dst;
                        if (u.pn < 4) dst = Q + (size_t)row * 1024 + u.pn * 256 + bj * 128 + cw;
                        else if (u.pn < 10) { const int b = row >> 13, s = row & 8191; dst = KV + (size_t)(u.pn - 4) * (KV_STRIDE / 2) + ((size_t)((b * 2 + bj) * SEQ + s)) * 128 + cw; }
                        else dst = PIN + (size_t)row * 1024 + (u.pn - 10) * 256 + bj * 128 + cw;
                        *(u32x4*)dst = w;
                    }
                }
            }
    }
};
struct CUnit { int kv, pm, ks; };
struct CmpHid {
    __device__ __forceinline__ void stage(LAS unsigned char*, const CUnit&, int, int, int) const {}
    static constexpr bool PERM = false; static constexpr int ID = 2; static constexpr bool FP8 = false;
    float* HIDP;
    __device__ __forceinline__ void operator()(const f32x4 (&acc)[2][2][4][2], const CUnit& u, int wr, int wc, int fr, int fq, LAS unsigned char*, int) const {
        const int row0 = u.pm * BM + wr * 64 + fr, col0 = wc * 32 + 4 * fq;
        float* base = HIDP + ((size_t)(u.ks * 2 + u.kv) * 2048) * 256;
#pragma unroll
        for (int ai = 0; ai < 2; ++ai)
#pragma unroll
            for (int m = 0; m < 4; ++m) { float* rowp = base + (size_t)(row0 + ai * HALF + m * 16) * 256 + col0;
#pragma unroll
                for (int bj = 0; bj < 2; ++bj)
#pragma unroll
                    for (int n = 0; n < 2; ++n) *(f32x4*)(rowp + bj * HALF + n * 16) = acc[ai][bj][m][n]; }
    }
};
struct PUnit { int g, pm; };
struct Pool {
    __device__ __forceinline__ void stage(LAS unsigned char*, const PUnit&, int, int, int) const {}
    static constexpr bool PERM = true; static constexpr int ID = 4; static constexpr bool FP8 = false;
    bf16_t* MIX; const float* scale;
    __device__ __forceinline__ void operator()(const f32x4 (&acc)[2][2][4][2], const PUnit& u, int wr, int wc, int fr, int fq, LAS unsigned char*, int) const {
        const int row0 = u.pm * BM + wr * 64 + fr, cw = wc * 32 + 8 * fq;
        float sc[2][8];
#pragma unroll
        for (int bj = 0; bj < 2; ++bj)
#pragma unroll
            for (int j = 0; j < 8; ++j) sc[bj][j] = scale[u.g * 256 + bj * 128 + cw + j];
#pragma unroll
        for (int ai = 0; ai < 2; ++ai)
#pragma unroll
            for (int m = 0; m < 4; ++m) {
                const int row = row0 + ai * HALF + m * 16;
#pragma unroll
                for (int bj = 0; bj < 2; ++bj) {
                    float v[8];
#pragma unroll
                    for (int j = 0; j < 8; ++j) v[j] = acc[ai][bj][m][j >> 2][j & 3] * sc[bj][j];
                    u32x4 w; w.x = cvt_pk_bf16(v[0], v[1]); w.y = cvt_pk_bf16(v[2], v[3]); w.z = cvt_pk_bf16(v[4], v[5]); w.w = cvt_pk_bf16(v[6], v[7]);
                    *(u32x4*)(MIX + (size_t)row * 2048 + 1024 + u.g * 256 + bj * 128 + cw) = w;
                }
            }
    }
};
struct OutProj {
    __device__ __forceinline__ void stage(LAS unsigned char*, const pg8::DUnit&, int, int, int) const {}
    static constexpr bool PERM = true; static constexpr int ID = 8; static constexpr bool FP8 = false;
    bf16_t* ATT;
    __device__ __forceinline__ void operator()(const f32x4 (&acc)[2][2][4][2], const pg8::DUnit& u, int wr, int wc, int fr, int fq, LAS unsigned char*, int) const {
        const int row0 = u.pm * BM + wr * 64 + fr, cw = u.pn * BM + wc * 32 + 8 * fq;
#pragma unroll
        for (int ai = 0; ai < 2; ++ai)
#pragma unroll
            for (int m = 0; m < 4; ++m) { bf16_t* rowp = ATT + (size_t)(row0 + ai * HALF + m * 16) * DM + cw;
#pragma unroll
                for (int bj = 0; bj < 2; ++bj) { const f32x4 v0 = acc[ai][bj][m][0], v1 = acc[ai][bj][m][1];
                    u32x4 w; w.x = cvt_pk_bf16(v0[0], v0[1]); w.y = cvt_pk_bf16(v0[2], v0[3]); w.z = cvt_pk_bf16(v1[0], v1[1]); w.w = cvt_pk_bf16(v1[2], v1[3]);
                    *(u32x4*)(rowp + bj * HALF) = w; } }
    }
};
struct MUnit { int e, pm, pn, rowbase, cnt; };
constexpr float W8_SCALE = 64.0f, W8_INV = 1.0f / 64.0f;
struct GateUp {
    static constexpr bool PERM = true; static constexpr int ID = 16; static constexpr bool FP8 = true;
    unsigned char* ACT; const float* bgu;
    __device__ __forceinline__ void stage(LAS unsigned char* lds, const MUnit& u, int par, int wid, int lane) const {
        if (wid < 4) { const float* src = bgu + (size_t)u.e * 4096 + (wid >> 1) * 2048 + u.pn * 128 + (wid & 1) * 64 + lane;
            __builtin_amdgcn_global_load_lds((const unsigned*)src, (LAS unsigned*)(lds + SIDE_OFF + par * SIDE_BYTES + 1024 + wid * 256), 4, 0, 0); }
    }
    __device__ __forceinline__ void operator()(const f32x4 (&acc)[2][2][4][2], const MUnit& u, int wr, int wc, int fr, int fq, LAS unsigned char* lds, int par) const {
        const int row0 = u.rowbase + wr * 64 + fr, cw = wc * 32 + 8 * fq, j0 = u.pn * 128 + cw;
        float bg[8], bu[8];
        { const LAS f32x4* sb = (const LAS f32x4*)(lds + SIDE_OFF + par * SIDE_BYTES + 1024);
          const f32x4 g0 = sb[cw >> 2], g1 = sb[(cw >> 2) + 1], u0 = sb[32 + (cw >> 2)], u1 = sb[33 + (cw >> 2)];
#pragma unroll
          for (int j = 0; j < 4; ++j) { bg[j] = g0[j]; bg[4 + j] = g1[j]; bu[j] = u0[j]; bu[4 + j] = u1[j]; } }
#pragma unroll
        for (int ai = 0; ai < 2; ++ai)
#pragma unroll
            for (int m = 0; m < 4; ++m) {
                const int row = row0 + ai * HALF + m * 16;
                float v[8];
#pragma unroll
                for (int j = 0; j < 8; ++j) {
                    float g = fmaf(acc[ai][0][m][j >> 2][j & 3], W8_INV, bg[j]), up = fmaf(acc[ai][1][m][j >> 2][j & 3], W8_INV, bu[j]);
                    g = fminf(g, 7.0f); up = fminf(fmaxf(up, -7.0f), 7.0f);
                    v[j] = (up + 1.0f) * g * fast_rcp(1.0f + fast_exp2(-2.4554669595930157f * g));
                }
                u32x2 w; int p = __builtin_amdgcn_cvt_pk_fp8_f32(v[0], v[1], 0, false); p = __builtin_amdgcn_cvt_pk_fp8_f32(v[2], v[3], p, true); w.x = (unsigned)p;
                p = __builtin_amdgcn_cvt_pk_fp8_f32(v[4], v[5], 0, false); p = __builtin_amdgcn_cvt_pk_fp8_f32(v[6], v[7], p, true); w.y = (unsigned)p;
                *(u32x2*)(ACT + (size_t)row * 2048 + j0) = w;
            }
    }
};
struct Down {
    static constexpr bool PERM = true; static constexpr int ID = 32; static constexpr bool FP8 = true;
    bf16_t* YBUF; const float* bd; const float* WL;
    __device__ __forceinline__ void stage(LAS unsigned char* lds, const MUnit& u, int par, int wid, int lane) const {
        const float* src = wid < 4 ? bd + (size_t)u.e * 2048 + u.pn * 256 + wid * 64 + lane : WL + (size_t)u.e * NTOK + u.pm * 256 + (wid - 4) * 64 + lane;
        __builtin_amdgcn_global_load_lds((const unsigned*)src, (LAS unsigned*)(lds + SIDE_OFF + par * SIDE_BYTES + 1024 + wid * 256), 4, 0, 0);
    }
    __device__ __forceinline__ void operator()(const f32x4 (&acc)[2][2][4][2], const MUnit& u, int wr, int wc, int fr, int fq, LAS unsigned char* lds, int par) const {
        const int rl0 = wr * 64 + fr, cw = wc * 32 + 8 * fq;
        float bias[2][8];
        const LAS f32x4* sb = (const LAS f32x4*)(lds + SIDE_OFF + par * SIDE_BYTES + 1024);
        const LAS float* sw = (const LAS float*)(lds + SIDE_OFF + par * SIDE_BYTES + 2048);
#pragma unroll
        for (int bj = 0; bj < 2; ++bj) { const f32x4 b0 = sb[bj * 32 + (cw >> 2)], b1 = sb[bj * 32 + (cw >> 2) + 1];
#pragma unroll
            for (int j = 0; j < 4; ++j) { bias[bj][j] = b0[j]; bias[bj][4 + j] = b1[j]; } }
#pragma unroll
        for (int ai = 0; ai < 2; ++ai)
#pragma unroll
            for (int m = 0; m < 4; ++m) {
                const float wt = sw[rl0 + ai * HALF + m * 16];
                const size_t row = (size_t)(u.rowbase + rl0 + ai * HALF + m * 16);
#pragma unroll
                for (int bj = 0; bj < 2; ++bj) {
                    float v[8];
#pragma unroll
                    for (int j = 0; j < 8; ++j) v[j] = fmaf(acc[ai][bj][m][j >> 2][j & 3], W8_INV, bias[bj][j]) * wt;
                    u32x4 w; w.x = cvt_pk_bf16(v[0], v[1]); w.y = cvt_pk_bf16(v[2], v[3]); w.z = cvt_pk_bf16(v[4], v[5]); w.w = cvt_pk_bf16(v[6], v[7]);
                    *(u32x4*)(YBUF + row * 2048 + u.pn * 256 + bj * 128 + cw) = w;
                }
            }
    }
};
}

namespace pg8 {
struct CmpSched {
    typedef epi::CUnit Unit; static constexpr bool SIDE_IDX = false; static constexpr int B_K16 = 0;
    const char* A; const char* Bt; int G, c;
    __device__ __forceinline__ bool next(int i, Unit& u) const { const int L = i * G + c; if (L >= 64) return false; u.kv = L >> 5; u.pm = (L >> 2) & 7; u.ks = L & 3; return true; }
    __device__ __forceinline__ const char* a_base() const { return A; }
    __device__ __forceinline__ unsigned a_off(const Unit& u, int r, int C) const { return (unsigned)(u.kv * (int)KV_STRIDE) + (unsigned)(u.pm * BM + r) * 4096u + (unsigned)u.ks * 2048u + (unsigned)C * 2u; }
    __device__ __forceinline__ const char* b_ptr(const Unit& u) const { return Bt + (size_t)u.kv * 256 * 4096 * 2 + (size_t)u.ks * 2048; }
};
struct PoolSched {
    typedef epi::PUnit Unit; static constexpr bool SIDE_IDX = false; static constexpr int B_K16 = 0;
    const char* A; const char* Bt; int G, c;
    __device__ __forceinline__ bool next(int i, Unit& u) const { const int L = i * G + c; if (L >= 256) return false; u.g = L >> 6; u.pm = L & 63; return true; }
    __device__ __forceinline__ const char* a_base() const { return A; }
    __device__ __forceinline__ unsigned a_off(const Unit& u, int r, int C) const { return (unsigned)(u.pm * BM + r) * 2048u + (unsigned)(u.g * 256 + C) * 2u; }
    __device__ __forceinline__ const char* b_ptr(const Unit& u) const { return Bt + (size_t)u.g * 256 * 256 * 2; }
};
template <int NTN, bool GATHER>
struct MoeSched {
    typedef epi::MUnit Unit; static constexpr bool SIDE_IDX = GATHER; static constexpr int B_K16 = NTN * 256;
    __device__ __forceinline__ void stage_idx(LAS unsigned char* lds, const Unit& u, int par, int wid, int lane) const {
        if (wid >= 4) __builtin_amdgcn_global_load_lds((const unsigned*)(tokl + (size_t)u.e * NTOK + u.pm * 256 + (wid - 4) * 64 + lane), (LAS unsigned*)(lds + SIDE_OFF + par * SIDE_BYTES + (wid - 4) * 256), 4, 0, 0);
    }
    __device__ __forceinline__ unsigned a_off_lds(LAS unsigned char* lds, const Unit& u, int par, int r, int C) const {
        const unsigned tok = ((const LAS unsigned*)(lds + SIDE_OFF + par * SIDE_BYTES))[r]; return (tok < (unsigned)NTOK ? tok : 0u) * 2048u + (unsigned)C * 2u;
    }
    const char* A; const char* Bt; const int* tokl; const LAS int* tb; const LAS int* cn; int G, c; size_t bstride;
    __device__ __forceinline__ bool next(int i, Unit& u) const {
        const int L = i * G + c, tile = L / NTN; if (tile >= tb[32]) return false;
        int e = -1;
        { const LAS i32x4* t4 = (const LAS i32x4*)tb;
#pragma unroll
          for (int k = 0; k < 8; ++k) { const i32x4 v = t4[k]; e += (v.x <= tile) + (v.y <= tile) + (v.z <= tile) + (v.w <= tile); } }
        u.e = e; u.pm = tile - tb[e]; u.pn = L % NTN; u.rowbase = tile * 256; u.cnt = cn[e]; return true;
    }
    __device__ __forceinline__ const char* a_base() const { return A; }
    __device__ __forceinline__ unsigned a_off(const Unit& u, int r, int C) const {
        if (GATHER) { int rl = u.pm * 256 + r; rl = rl < u.cnt ? rl : u.cnt - 1; const int tok = tokl[(size_t)u.e * NTOK + rl]; return (unsigned)tok * 2048u + (unsigned)C * 2u; }
        else return (unsigned)(u.rowbase + r) * 2048u + (unsigned)C * 2u;
    }
    __device__ __forceinline__ const char* b_ptr(const Unit& u) const { return Bt + (size_t)u.e * bstride + (size_t)u.pn * BM * 16; }
};
}

namespace att {
constexpr float SCALE = 0.08838834764831845f, CLOG = SCALE * 1.4426950408889634f;
constexpr float THR_RAW = 8.0f / SCALE;
constexpr int SHM_V = 16384, SHM_K = 16384;
constexpr int NKVB = 2;
constexpr int L_V = 0, L_K = NKVB * SHM_V, L_CV0 = NKVB * (SHM_V + SHM_K), L_WS = 98304, L_BS = L_WS + NWAVES * 64 * 4;
static_assert(L_CV0 + 32768 <= L_WS, "attention LDS");
constexpr int BS_STRIDE = 129;
constexpr int L_SEL = L_BS + 64 * BS_STRIDE * 4;
constexpr int L_UNI = L_SEL + 64 * 16;
constexpr int L_LIST = L_UNI + 32;
constexpr int L_END = L_LIST + 128 * 4;
static_assert(L_END <= MISC_OFF, "attention LDS");
#define KSWZ(row, colB) ((row) * 256 + ((colB) ^ (((row) & 7) << 4)))
#define SBAR() __builtin_amdgcn_sched_barrier(0)
__device__ __forceinline__ int crow(int r, int hi) { return (r & 3) + 8 * (r >> 2) + 4 * hi; }
__device__ __forceinline__ void qkt(f32x16& p0, f32x16& p1, const char* Ks, const bf16x8* qr, int r32, int hi) {
    p0 = f32x16{}; p1 = f32x16{};
#pragma unroll
    for (int d0 = 0; d0 < 8; ++d0) { const int cb = (d0 * 16 + hi * 8) * 2;
        const bf16x8 b0 = *reinterpret_cast<const bf16x8*>(Ks + KSWZ(r32, cb));
        const bf16x8 b1 = *reinterpret_cast<const bf16x8*>(Ks + KSWZ(32 + r32, cb));
        p0 = __builtin_amdgcn_mfma_f32_32x32x16_bf16(b0, qr[d0], p0, 0, 0, 0);
        p1 = __builtin_amdgcn_mfma_f32_32x32x16_bf16(b1, qr[d0], p1, 0, 0, 0); }
}
__device__ __forceinline__ int v_st(int k, int c) { const int kk = (k & ~0xC) | ((k & 4) << 1) | ((k & 8) >> 1); return ((kk >> 3) * 4 + (c >> 5)) * 512 + ((kk & 7) * 32 + (c & 31)) * 2; }
__device__ __forceinline__ int v_rd_base(int lane) { return ((lane & 3) << 3) | (((lane >> 2) & 3) << 6) | (((lane >> 4) & 1) << 5) | (((lane >> 5) & 1) << 8); }
constexpr int v_rd_off(int d0, int ks, int half) { return d0 * 512 + ks * 4096 + half * 2048; }
template <int OFF> __device__ __forceinline__ s16x4 tr_read(int vb) {
    s16x4 r; asm volatile("ds_read_b64_tr_b16 %0, %1 offset:%2" : "=&v"(r) : "v"(vb), "i"(OFF) : "memory"); return r;
}
template <int D0> __device__ __forceinline__ void pv_one(f32x16& od, int vb, bf16x8 pa0, bf16x8 pa1, bf16x8 pa2, bf16x8 pa3) {
    const s16x4 l0 = tr_read<v_rd_off(D0, 0, 0)>(vb), h0 = tr_read<v_rd_off(D0, 0, 1)>(vb), l1 = tr_read<v_rd_off(D0, 1, 0)>(vb), h1 = tr_read<v_rd_off(D0, 1, 1)>(vb);
    const s16x4 l2 = tr_read<v_rd_off(D0, 2, 0)>(vb), h2 = tr_read<v_rd_off(D0, 2, 1)>(vb), l3 = tr_read<v_rd_off(D0, 3, 0)>(vb), h3 = tr_read<v_rd_off(D0, 3, 1)>(vb);
    asm volatile("s_waitcnt lgkmcnt(0)" ::: "memory"); SBAR();
#define PKV(L, H) (bf16x8){L[0], L[1], L[2], L[3], H[0], H[1], H[2], H[3]}
    od = __builtin_amdgcn_mfma_f32_32x32x16_bf16(pa0, PKV(l0, h0), od, 0, 0, 0);
    od = __builtin_amdgcn_mfma_f32_32x32x16_bf16(pa1, PKV(l1, h1), od, 0, 0, 0);
    od = __builtin_amdgcn_mfma_f32_32x32x16_bf16(pa2, PKV(l2, h2), od, 0, 0, 0);
    od = __builtin_amdgcn_mfma_f32_32x32x16_bf16(pa3, PKV(l3, h3), od, 0, 0, 0);
#undef PKV
}
__device__ __forceinline__ void pv_d0(f32x16* o, int vb, bf16x8 pa0, bf16x8 pa1, bf16x8 pa2, bf16x8 pa3) {
    pv_one<0>(o[0], vb, pa0, pa1, pa2, pa3); pv_one<1>(o[1], vb, pa0, pa1, pa2, pa3); pv_one<2>(o[2], vb, pa0, pa1, pa2, pa3); pv_one<3>(o[3], vb, pa0, pa1, pa2, pa3);
}
__device__ __forceinline__ void pack_p(const f32x16& p0, const f32x16& p1, bf16x8& pa0, bf16x8& pa1, bf16x8& pa2, bf16x8& pa3) {
#define PK4(P, BASE, OUT) do { unsigned a0 = cvt_pk_bf16(P[BASE + 0], P[BASE + 1]), a1 = cvt_pk_bf16(P[BASE + 2], P[BASE + 3]);   \
    unsigned b0 = cvt_pk_bf16(P[BASE + 4], P[BASE + 5]), b1 = cvt_pk_bf16(P[BASE + 6], P[BASE + 7]);                              \
    auto r0 = __builtin_amdgcn_permlane32_swap(a0, b0, false, false); auto r1 = __builtin_amdgcn_permlane32_swap(a1, b1, false, false); \
    u32x4 w = {r0[0], r1[0], r0[1], r1[1]}; OUT = *reinterpret_cast<bf16x8*>(&w); } while (0)
    PK4(p0, 0, pa0); PK4(p0, 8, pa1); PK4(p1, 0, pa2); PK4(p1, 8, pa3);
#undef PK4
}
__device__ __forceinline__ float half_max(float v) { auto rr = __builtin_amdgcn_permlane32_swap(__float_as_uint(v), __float_as_uint(v), false, false); return fmaxf(__uint_as_float(rr[0]), __uint_as_float(rr[1])); }
__device__ __forceinline__ float half_sum(float v) { auto rr = __builtin_amdgcn_permlane32_swap(__float_as_uint(v), __float_as_uint(v), false, false); return __uint_as_float(rr[0]) + __uint_as_float(rr[1]); }

struct Ptrs { const bf16_t* Q; const bf16_t* KV; const bf16_t* KCMP; const bf16_t* VCMP; const float* GLOG; bf16_t* MIX; float* scr; };

template <int MODE>
__device__ __forceinline__ void branch_ref(char* lds, const bf16_t* Kb, const bf16_t* Vb, const bf16x8* qr, int ntiles, int qi, int qoff, int nmax,
                                       const unsigned (&selw)[4], float& m_reg, float& l_reg, float inv_l, f32x16* o, const int wid) {
    const int lane = fresh_lane(), tid = wid * 64 + lane, r32 = lane & 31, hi = lane >> 5;
    char* V_lds = lds + L_V; char* K_lds = lds + L_K;
    float* al_l = (float*)(lds + L_WS) + wid * 64 + 32;
    float* bs = (float*)(lds + L_BS);
    const int* tlist = (const int*)(lds + L_LIST);
    const int sr = tid >> 4, sc = (tid & 15) * 8, vst0 = v_st(sr, sc), vst1 = v_st(32 + sr, sc);
    const int vb0 = (int)(uintptr_t)V_lds + v_rd_base(lane);
    const int j0w = (qi - 8 > 0) ? qi - 8 : 0;
    bf16x8 vs0, vs1, ks0, ks1;
#define TILE_OF(i) (MODE <= 1 ? (i) : (MODE == 2 ? tlist[i] : j0w + (i)))
#define SLOADT(j) do { const size_t k0 = (size_t)(j) * 64; ks0 = *(const bf16x8*)(Kb + (k0 + sr) * 128 + sc); ks1 = *(const bf16x8*)(Kb + (k0 + 32 + sr) * 128 + sc); \
        if (MODE != 0) { vs0 = *(const bf16x8*)(Vb + (k0 + sr) * 128 + sc); vs1 = *(const bf16x8*)(Vb + (k0 + 32 + sr) * 128 + sc); } } while (0)
#define SWRITET(b) do { const int kc = sc * 2; *(bf16x8*)(K_lds + (b) * SHM_K + KSWZ(sr, kc)) = ks0; *(bf16x8*)(K_lds + (b) * SHM_K + KSWZ(32 + sr, kc)) = ks1; \
        if (MODE != 0) { *(bf16x8*)(V_lds + (b) * SHM_V + vst0) = vs0; *(bf16x8*)(V_lds + (b) * SHM_V + vst1) = vs1; } } while (0)
    SLOADT(TILE_OF(0)); SWRITET(0); __syncthreads();
    for (int i = 0; i < ntiles; ++i) {
        const int j = TILE_OF(i), buf = i & 1;
        if (i + 1 < ntiles) SLOADT(TILE_OF(i + 1));
        f32x16 p0, p1;
        qkt(p0, p1, K_lds + buf * SHM_K, qr, r32, hi);
        int lo = 0, hi_ = 63;
        if (MODE <= 1) hi_ = nmax - j * 64;
        else if (MODE == 2) { const int jw = j >> 5; const unsigned sw_ = jw == 0 ? selw[0] : jw == 1 ? selw[1] : jw == 2 ? selw[2] : selw[3]; const bool sel = (sw_ >> (j & 31)) & 1u; hi_ = sel ? (j == qi ? qoff : 63) : -1; }
        else { if (j == qi) hi_ = qoff; else if (j == qi - 8) lo = qoff + 1; }
        const int lo4 = lo - 4 * hi, hi4 = hi_ - 4 * hi;
        float pmax = -INFINITY;
#pragma unroll
        for (int r = 0; r < 16; ++r) { const int kc0 = (r & 3) + 8 * (r >> 2);
            p0[r] = (kc0 >= lo4 && kc0 <= hi4) ? p0[r] : -INFINITY; p1[r] = (kc0 + 32 >= lo4 && kc0 + 32 <= hi4) ? p1[r] : -INFINITY;
            pmax = fmaxf(pmax, fmaxf(p0[r], p1[r])); }
        float alpha = 1.f;
        if (MODE != 1) {
            pmax = half_max(pmax);
            const float mn = fmaxf(m_reg, pmax); alpha = fast_exp2((m_reg - mn) * CLOG); m_reg = mn;
        }
        const float mnC = -m_reg * CLOG;
        float ps = 0.f;
#pragma unroll
        for (int r = 0; r < 16; ++r) { p0[r] = fast_exp2(fmaf(p0[r], CLOG, mnC)); p1[r] = fast_exp2(fmaf(p1[r], CLOG, mnC)); ps += p0[r] + p1[r]; }
        if (MODE != 1) { ps = half_sum(ps); l_reg = l_reg * alpha + ps; }
        if (MODE == 1) {
#pragma unroll
            for (int r = 0; r < 16; ++r) { p0[r] *= inv_l; p1[r] *= inv_l; }
            unsigned* row = (unsigned*)bs + qoff * BS_STRIDE + j * 16 + hi;
#pragma unroll
            for (int a = 0; a < 4; ++a) {
                const float s0 = 2.f * (p0[4 * a] + p0[4 * a + 1] + p0[4 * a + 2]) + p0[4 * a + 3], s1 = 2.f * (p1[4 * a] + p1[4 * a + 1] + p1[4 * a + 2]) + p1[4 * a + 3];
                atomicAdd(row + 2 * a, (unsigned)(s0 * 67108864.f + 0.5f)); atomicAdd(row + 2 * a + 1, (unsigned)(p0[4 * a + 3] * 67108864.f + 0.5f));
                atomicAdd(row + 8 + 2 * a, (unsigned)(s1 * 67108864.f + 0.5f)); atomicAdd(row + 8 + 2 * a + 1, (unsigned)(p1[4 * a + 3] * 67108864.f + 0.5f));
            }
        }
        if (MODE != 0) {
            if (MODE != 1) {
                if (__any(alpha < 1.f)) { if (hi == 0) al_l[r32] = alpha; asm volatile("s_waitcnt lgkmcnt(0)" ::: "memory");
#pragma unroll
                    for (int d = 0; d < 4; ++d)
#pragma unroll
                        for (int r = 0; r < 16; ++r) o[d][r] *= al_l[crow(r, hi)]; }
            }
            bf16x8 pa0, pa1, pa2, pa3;
            pack_p(p0, p1, pa0, pa1, pa2, pa3);
            pv_d0(o, vb0 + buf * SHM_V, pa0, pa1, pa2, pa3);
        }
        if (i + 1 < ntiles) SWRITET(buf ^ 1);
        __syncthreads();
    }
#undef TILE_OF
#undef SLOADT
#undef SWRITET
}


struct Conv { const char* sg; const char* sd; unsigned char* dg; unsigned char* dd; int next, total; bool live; };
constexpr int L_CV1 = L_BS;
static_assert(64 * BS_STRIDE * 4 >= 32768, "conversion buffer 1");
__device__ __forceinline__ Conv conv_init(const float* wgu, const float* wd, unsigned char* ws, int c, bool on, const int wid) {
    Conv cv;
    const int gn = (c & 7) * 512 + wid * 64, dn = (c & 3) * 512 + wid * 64;
    const int grow = gn < 2048 ? ((gn >> 7) * 256 + (gn & 127)) : (((gn - 2048) >> 7) * 256 + 128 + (gn & 127));
    cv.sg = (const char*)(wgu + (size_t)(c >> 3) * 16 * 4096 + gn);
    cv.dg = ws + WS_WGU + ((size_t)(c >> 3) * 4096 + grow) * 16;
    cv.sd = (const char*)(wd + (size_t)(c >> 2) * 16 * 2048 + dn) - ((size_t)128 << 23);
    cv.dd = ws + WS_WD + ((size_t)(c >> 2) * 2048 + dn) * 16 - ((size_t)128 << 21);
    cv.next = 0; cv.total = on ? 192 : 0; cv.live = false;
    return cv;
}
__device__ __forceinline__ void conv_issue(LAS unsigned char* ldsl, int cb, const Conv& cv, int L, const int wid, const int lane) {
    const bool gu = L < 128; const int sh = gu ? 14 : 13;
    const char* src = (gu ? cv.sg : cv.sd) + ((size_t)L << 23);
    const unsigned voff = ((unsigned)(lane >> 4) << sh) + (unsigned)(lane & 15) * 16u;
    LAS unsigned char* d = ldsl + cb + wid * 4096;
    __builtin_amdgcn_global_load_lds((const unsigned*)(src + voff), (LAS unsigned*)d, 16, 0, 0);
    __builtin_amdgcn_global_load_lds((const unsigned*)(src + ((size_t)4 << sh) + voff), (LAS unsigned*)(d + 1024), 16, 0, 0);
    __builtin_amdgcn_global_load_lds((const unsigned*)(src + ((size_t)8 << sh) + voff), (LAS unsigned*)(d + 2048), 16, 0, 0);
    __builtin_amdgcn_global_load_lds((const unsigned*)(src + ((size_t)12 << sh) + voff), (LAS unsigned*)(d + 3072), 16, 0, 0);
}
typedef short s16x2 __attribute__((ext_vector_type(2)));
__device__ __forceinline__ unsigned cv_pk4(float a, float b, float c, float d) {
    s16x2 r = __builtin_bit_cast(s16x2, a);
    r = __builtin_amdgcn_cvt_scalef32_pk_fp8_f32(r, a, b, 0.015625f, false);
    r = __builtin_amdgcn_cvt_scalef32_pk_fp8_f32(r, c, d, 0.015625f, true);
    return __builtin_bit_cast(unsigned, r); }
__device__ __forceinline__ void conv_read(LAS unsigned char* ldsl, int cb, const int wid, const int lane, float (&v)[16]) {
    const LAS float* bp = (const LAS float*)(ldsl + cb + wid * 4096 + lane * 4);
#pragma unroll
    for (int j = 0; j < 16; ++j) v[j] = bp[j * 64];
}
__device__ __forceinline__ void conv_store(const Conv& cv, int L, const int wid, const int lane, const float (&v)[16]) {
    unsigned char* dst = (L < 128 ? cv.dg : cv.dd) + ((size_t)L << 21);
    u32x4 o;
    o.x = cv_pk4(v[0], v[1], v[2], v[3]); o.y = cv_pk4(v[4], v[5], v[6], v[7]); o.z = cv_pk4(v[8], v[9], v[10], v[11]); o.w = cv_pk4(v[12], v[13], v[14], v[15]);
    *(u32x4*)(dst + (unsigned)(lane * 16)) = o;
}
__device__ __forceinline__ void conv_consume(LAS unsigned char* ldsl, int cb, const Conv& cv, int L, const int wid, const int lane) {
    float v[16];
    conv_read(ldsl, cb, wid, lane, v);
    asm volatile("s_waitcnt lgkmcnt(0)" ::: "memory");
    conv_store(cv, L, wid, lane, v);
}
__device__ __forceinline__ void conv_prime(char* lds, Conv& cv, int niter, const int wid) {
    const int lane = fresh_lane(); LAS unsigned char* ldsl = (LAS unsigned char*)(unsigned)(uintptr_t)lds;
    cv.live = cv.next + 2 + niter <= cv.total;
    if (cv.live) { conv_issue(ldsl, (cv.next & 1) ? L_CV1 : L_CV0, cv, cv.next, wid, lane); conv_issue(ldsl, ((cv.next + 1) & 1) ? L_CV1 : L_CV0, cv, cv.next + 1, wid, lane); cv.next += 2; }
}
__device__ __forceinline__ void conv_drain(char* lds, Conv& cv, const int wid) {
    const int lane = fresh_lane(); LAS unsigned char* ldsl = (LAS unsigned char*)(unsigned)(uintptr_t)lds;
    if (cv.live) {
        asm volatile("s_waitcnt vmcnt(0)" ::: "memory");
        conv_consume(ldsl, ((cv.next - 2) & 1) ? L_CV1 : L_CV0, cv, cv.next - 2, wid, lane);
        conv_consume(ldsl, ((cv.next - 1) & 1) ? L_CV1 : L_CV0, cv, cv.next - 1, wid, lane);
        cv.live = false;
    }
}
__device__ __forceinline__ void conv_tail(char* lds, Conv& cv, const int wid) {
    const int lane = fresh_lane();
    LAS unsigned char* ldsl = (LAS unsigned char*)(unsigned)(uintptr_t)lds;
    int is = cv.next, co = cv.next;
    for (int k = 0; k < 3 && is < cv.total; ++k, ++is) conv_issue(ldsl, (is & 3) * 32768, cv, is, wid, lane);
    while (co < cv.total) {
        if (is < cv.total) { conv_issue(ldsl, (is & 3) * 32768, cv, is, wid, lane); ++is; asm volatile("s_waitcnt vmcnt(12)" ::: "memory"); }
        else asm volatile("s_waitcnt vmcnt(0)" ::: "memory");
        conv_consume(ldsl, (co & 3) * 32768, cv, co, wid, lane); ++co;
    }
    cv.next = cv.total;
}

template <int MODE, bool CONV>
__device__ __forceinline__ void branch(char* lds, const bf16_t* Kb, const bf16_t* Vb, const bf16x8* qr, int ntiles, int qi, int qoff, int nmax,
                                       const unsigned (&selw)[4], float& m_reg, float& l_reg, float inv_l, f32x16* o, const int wid, Conv& cv) {
    const int lane = fresh_lane(), r32 = lane & 31, hi = lane >> 5;
    char* V_lds = lds + L_V; char* K_lds = lds + L_K;
    LAS unsigned char* ldsl = (LAS unsigned char*)(unsigned)(uintptr_t)lds;
    float* al_l = (float*)(lds + L_WS) + wid * 64 + 32;
    float* bs = (float*)(lds + L_BS);
    const int* tlist = (const int*)(lds + L_LIST);
    const int vb0 = (int)(uintptr_t)V_lds + v_rd_base(lane);
    const int j0w = (qi - 8 > 0) ? qi - 8 : 0;
    unsigned ksrc[2], vsrc[2];
#pragma unroll
    for (int i = 0; i < 2; ++i) { const int q = (i * 8 + wid) * 64 + lane;
        { const int row = q >> 4, c = (q & 15) ^ (row & 7); ksrc[i] = (unsigned)(row * 256 + c * 16); }
        { const int sub = q >> 5, within = q & 31, kk = (sub >> 2) * 8 + (within >> 2), k = (kk & ~0xC) | ((kk & 4) << 1) | ((kk & 8) >> 1), c = (sub & 3) * 32 + (within & 3) * 8; vsrc[i] = (unsigned)(k * 256 + c * 2); } }
#define TILE_OF(i) (MODE <= 1 ? (i) : (MODE == 2 ? tlist[i] : j0w + (i)))
#define ISSUE(j, b) do { const char* kg_ = (const char*)Kb + (size_t)(j) * 16384; const char* vg_ = (const char*)Vb + (size_t)(j) * 16384; \
        _Pragma("unroll") for (int _i = 0; _i < 2; ++_i) { \
            __builtin_amdgcn_global_load_lds((const unsigned*)(kg_ + ksrc[_i]), (LAS unsigned*)(ldsl + L_K + (b) * SHM_K + (_i * 8 + wid) * 1024), 16, 0, 0); \
            if (MODE != 0) __builtin_amdgcn_global_load_lds((const unsigned*)(vg_ + vsrc[_i]), (LAS unsigned*)(ldsl + L_V + (b) * SHM_V + (_i * 8 + wid) * 1024), 16, 0, 0); } } while (0)
    ISSUE(TILE_OF(0), 0);
    int buf = 0;
    for (int i = 0; i < ntiles; ++i) {
        const int j = TILE_OF(i);
        if (CONV && i > 0) asm volatile("s_waitcnt vmcnt(4)" ::: "memory"); else asm volatile("s_waitcnt vmcnt(0)" ::: "memory");
        asm volatile("s_waitcnt lgkmcnt(0)" ::: "memory");
        __builtin_amdgcn_s_barrier();
        asm volatile("" ::: "memory");
        if (i + 1 < ntiles) ISSUE(TILE_OF(i + 1), buf ^ 1);
        f32x16 p0, p1;
        qkt(p0, p1, K_lds + buf * SHM_K, qr, r32, hi);
        float cvv[16]; const int cvb = (cv.next & 1) ? L_CV1 : L_CV0;
        if (CONV) { conv_read(ldsl, cvb, wid, lane, cvv); SBAR(); }
        bool boundary;
        if (MODE <= 1) boundary = (64 * j + 63 > 4 * qi - 2);
        else if (MODE == 2) boundary = (j == qi);
        else boundary = (j == qi) || (j == qi - 8);
        float pmax = -INFINITY; bool rowvalid = true;
        if (boundary) {
            int lo = 0, hi_ = 63;
            if (MODE <= 1) hi_ = nmax - j * 64;
            else if (MODE == 2) hi_ = qoff;
            else { if (j == qi) hi_ = qoff; else lo = qoff + 1; }
            const int lo4 = lo - 4 * hi, hi4 = hi_ - 4 * hi;
#pragma unroll
            for (int r = 0; r < 16; ++r) { const int kc0 = (r & 3) + 8 * (r >> 2);
                p0[r] = (kc0 >= lo4 && kc0 <= hi4) ? p0[r] : -INFINITY; p1[r] = (kc0 + 32 >= lo4 && kc0 + 32 <= hi4) ? p1[r] : -INFINITY;
                pmax = fmaxf(pmax, fmaxf(p0[r], p1[r])); }
        } else {
            if (MODE == 2) { const int jw = j >> 5; const unsigned sw_ = jw == 0 ? selw[0] : jw == 1 ? selw[1] : jw == 2 ? selw[2] : selw[3]; rowvalid = (sw_ >> (j & 31)) & 1u; }
#pragma unroll
            for (int r = 0; r < 16; ++r) pmax = fmaxf(pmax, fmaxf(p0[r], p1[r]));
            if (MODE == 2) pmax = rowvalid ? pmax : -INFINITY;
        }
        float alpha = 1.f;
        if (MODE != 1) {
            pmax = half_max(pmax);
            if (!__all(pmax - m_reg <= THR_RAW)) { const float mn = fmaxf(m_reg, pmax); alpha = fast_exp2((m_reg - mn) * CLOG); m_reg = mn; }
        }
        float mnC = -m_reg * CLOG;
        if (MODE == 2) mnC = rowvalid ? mnC : -INFINITY;
        float ps = 0.f;
#pragma unroll
        for (int r = 0; r < 16; ++r) { p0[r] = fast_exp2(fmaf(p0[r], CLOG, mnC)); p1[r] = fast_exp2(fmaf(p1[r], CLOG, mnC)); ps += p0[r] + p1[r]; }
        if (MODE != 1) { ps = half_sum(ps); l_reg = l_reg * alpha + ps; }
        if (MODE == 1) {
#pragma unroll
            for (int r = 0; r < 16; ++r) { p0[r] *= inv_l; p1[r] *= inv_l; }
            unsigned* row = (unsigned*)bs + qoff * BS_STRIDE + j * 16 + hi;
#pragma unroll
            for (int a = 0; a < 4; ++a) {
                const float s0 = 2.f * (p0[4 * a] + p0[4 * a + 1] + p0[4 * a + 2]) + p0[4 * a + 3], s1 = 2.f * (p1[4 * a] + p1[4 * a + 1] + p1[4 * a + 2]) + p1[4 * a + 3];
                atomicAdd(row + 2 * a, (unsigned)(s0 * 67108864.f + 0.5f)); atomicAdd(row + 2 * a + 1, (unsigned)(p0[4 * a + 3] * 67108864.f + 0.5f));
                atomicAdd(row + 8 + 2 * a, (unsigned)(s1 * 67108864.f + 0.5f)); atomicAdd(row + 8 + 2 * a + 1, (unsigned)(p1[4 * a + 3] * 67108864.f + 0.5f));
            }
        }
        if (MODE != 0) {
            if (MODE != 1) {
                if (__any(alpha < 1.f)) { if (hi == 0) al_l[r32] = alpha; asm volatile("s_waitcnt lgkmcnt(0)" ::: "memory");
#pragma unroll
                    for (int d = 0; d < 4; ++d)
#pragma unroll
                        for (int r = 0; r < 16; ++r) o[d][r] *= al_l[crow(r, hi)]; }
            }
            bf16x8 pa0, pa1, pa2, pa3;
            pack_p(p0, p1, pa0, pa1, pa2, pa3);
            if (CONV) {
                SBAR();
                asm volatile("s_waitcnt lgkmcnt(0)" ::: "memory");
                conv_issue(ldsl, cvb, cv, cv.next, wid, lane);
                SBAR();
                pv_one<0>(o[0], vb0 + buf * SHM_V, pa0, pa1, pa2, pa3);
                conv_store(cv, cv.next - 2, wid, lane, cvv);
                ++cv.next;
                pv_one<1>(o[1], vb0 + buf * SHM_V, pa0, pa1, pa2, pa3); pv_one<2>(o[2], vb0 + buf * SHM_V, pa0, pa1, pa2, pa3); pv_one<3>(o[3], vb0 + buf * SHM_V, pa0, pa1, pa2, pa3);
            } else pv_d0(o, vb0 + buf * SHM_V, pa0, pa1, pa2, pa3);
        }
        buf ^= 1;
    }
    asm volatile("s_waitcnt lgkmcnt(0)" ::: "memory");
    __builtin_amdgcn_s_barrier();
    asm volatile("" ::: "memory");
#undef TILE_OF
#undef ISSUE
}

template <int STAGE, bool CHECK = false>
__device__ __forceinline__ void finalize(char* lds, const f32x16* o, float f, float* scr, bf16_t* mixrow0  , const int wid, unsigned* err = nullptr) {
    const int lane = fresh_lane(), r32 = lane & 31, hi = lane >> 5;
    float* li_l = (float*)(lds + L_WS) + wid * 64;
    if (hi == 0) li_l[r32] = f;
    asm volatile("s_waitcnt lgkmcnt(0)" ::: "memory");
    int lb = hi * 4; asm volatile("" : "+v"(lb));
    float* sw = scr + (size_t)(wid * 32 + lb) * 128 + r32;
    bf16_t* mw = mixrow0 + (size_t)lb * 2048 + r32;
#pragma unroll
    for (int r = 0; r < 16; ++r) { const int orc = (r & 3) + 8 * (r >> 2); const float fr_ = li_l[orc + lb];
#pragma unroll
        for (int d0 = 0; d0 < 4; ++d0) {
            float* p = sw + orc * 128 + d0 * 32;
            float v = o[d0][r] * fr_;
            if (STAGE >= 1) v += *p;
            if (STAGE <= 1) *p = v;
            else { bf16_t* mp = mw + (size_t)orc * 2048 + d0 * 32;
                if (CHECK) { const float old = __uint_as_float((unsigned)(*mp) << 16); if (!(fabsf(old - v) <= 0.02f * fabsf(v) + 2e-3f)) __hip_atomic_store(err, 1u, RLX_AGENT); }
                *mp = (bf16_t)(cvt_pk_bf16(v, v) & 0xffffu); }
        } }
}


typedef unsigned u32x8 __attribute__((ext_vector_type(8)));
__device__ __forceinline__ void accum_out(char* lds, const f32x16* o, float f, u32x8* out, const int wid, const bool first) {
    const int lane = fresh_lane(), r32 = lane & 31, hi = lane >> 5;
    float* li_l = (float*)(lds + L_WS) + wid * 64;
    if (hi == 0) li_l[r32] = f;
    asm volatile("s_waitcnt lgkmcnt(0)" ::: "memory");
#pragma unroll
    for (int k = 0; k < 8; ++k) { const float f0 = li_l[crow(2 * k, hi)], f1 = li_l[crow(2 * k + 1, hi)];
#pragma unroll
        for (int d0 = 0; d0 < 4; ++d0) { const unsigned pk = out[d0][k]; const float a = first ? 0.f : bf_lo(pk), b = first ? 0.f : bf_hi(pk);
            out[d0][k] = cvt_pk_bf16(fmaf(o[d0][2 * k], f0, a), fmaf(o[d0][2 * k + 1], f1, b)); } }
}
template <bool CHECK>
__device__ __forceinline__ void store_out(char* lds, const u32x8* out, bf16_t* mixrow0, const int wid, unsigned* err) {
    const int lane = fresh_lane(), r32 = lane & 31, hi = lane >> 5;
    unsigned short* st = (unsigned short*)(lds + wid * 8192);
#pragma unroll
    for (int k = 0; k < 8; ++k) { const int row0 = crow(2 * k, hi), row1 = crow(2 * k + 1, hi);
#pragma unroll
        for (int d0 = 0; d0 < 4; ++d0) { const unsigned pk = out[d0][k]; st[row0 * 128 + d0 * 32 + r32] = (unsigned short)(pk & 0xffffu); st[row1 * 128 + d0 * 32 + r32] = (unsigned short)(pk >> 16); } }
    asm volatile("s_waitcnt lgkmcnt(0)" ::: "memory");
#pragma unroll
    for (int q = 0; q < 8; ++q) { const int idx = q * 64 + lane, row = idx >> 4, ch = idx & 15;
        const u32x4 v = *(const u32x4*)(st + row * 128 + ch * 8);
        u32x4* gp = (u32x4*)(mixrow0 + (size_t)row * 2048 + ch * 8);
        if (CHECK) { const u32x4 old = *gp; const unsigned a[4] = {old.x, old.y, old.z, old.w}, b[4] = {v.x, v.y, v.z, v.w};
#pragma unroll
            for (int k = 0; k < 4; ++k) { const float x0 = bf_lo(a[k]), x1 = bf_hi(a[k]), y0 = bf_lo(b[k]), y1 = bf_hi(b[k]);
                if (!(fabsf(x0 - y0) <= 0.03f * fabsf(y0) + 3e-3f) || !(fabsf(x1 - y1) <= 0.03f * fabsf(y1) + 3e-3f)) __hip_atomic_store(err, 1u, RLX_AGENT); } }
        *gp = v; }
}

template <int IMPL, bool CHECK>
__device__ __forceinline__ void attn_item(char* lds, const Ptrs& P, int b, int g, int qi, const int wid, unsigned* err, Conv& cv) {
    const int lane = fresh_lane(), tid = wid * 64 + lane, r32 = lane & 31, hi = lane >> 5;
    const int hh = wid >> 1, head = g * 4 + hh, qoff = (wid & 1) * 32 + r32, t = qi * 64 + qoff;
    const size_t tok = (size_t)b * SEQ + t;
    bf16x8 qr[8];
    { const bf16_t* Qw = P.Q + tok * 1024 + head * 128 + hi * 8;
#pragma unroll
      for (int d0 = 0; d0 < 8; ++d0) qr[d0] = *(const bf16x8*)(Qw + d0 * 16); }
    const float* gl = P.GLOG + tok * 32 + head * 3;
    const float g_c = sigmoidf_(gl[0]), g_s = sigmoidf_(gl[1]), g_w = sigmoidf_(gl[2]);
    const size_t kvo = (size_t)((b * 2 + g) * SEQ) * 128, cmo = (size_t)((b * 2 + g) * NCMP) * 128;
    const bf16_t* Ks = P.KV + 2 * (KV_STRIDE / 2) + kvo; const bf16_t* Vs = P.KV + 3 * (KV_STRIDE / 2) + kvo;
    const bf16_t* Kw = P.KV + 4 * (KV_STRIDE / 2) + kvo; const bf16_t* Vw = P.KV + 5 * (KV_STRIDE / 2) + kvo;
    const bf16_t* Kc = P.KCMP + cmo; const bf16_t* Vc = P.VCMP + cmo;
    float* bs = (float*)(lds + L_BS);
    unsigned* selm = (unsigned*)(lds + L_SEL); unsigned* uni = (unsigned*)(lds + L_UNI); int* tlist = (int*)(lds + L_LIST);
    for (int i = tid; i < 64 * BS_STRIDE; i += 512) ((unsigned*)bs)[i] = 0u;
    if (tid < 8) uni[tid] = 0u;
    __syncthreads();
    bf16_t* mixrow0 = P.MIX + ((size_t)b * SEQ + qi * 64 + (wid & 1) * 32) * 2048 + head * 128;
    unsigned selw[4] = {0u, 0u, 0u, 0u};
    f32x16 o[4];
    u32x8 out[4];
    const int nmax = (t - 31) >> 4;
    const int ntc = ((4 * qi + 2) >> 6) + 1;
    float m_c = -1e30f, l_c = 0.f;
    if (IMPL == 0) branch_ref<0>(lds, Kc, Vc, qr, ntc, qi, qoff, nmax, selw, m_c, l_c, 0.f, o, wid); else branch<0, false>(lds, Kc, Vc, qr, ntc, qi, qoff, nmax, selw, m_c, l_c, 0.f, o, wid, cv);
    const float inv_lc = l_c > 0.f ? 1.0f / l_c : 0.f;
#pragma unroll
    for (int d = 0; d < 4; ++d) o[d] = f32x16{};
    if (IMPL == 0) branch_ref<1>(lds, Kc, Vc, qr, ntc, qi, qoff, nmax, selw, m_c, l_c, inv_lc, o, wid); else branch<1, false>(lds, Kc, Vc, qr, ntc, qi, qoff, nmax, selw, m_c, l_c, inv_lc, o, wid, cv);
    if (IMPL == 1) accum_out(lds, o, g_c, out, wid, true); else finalize<0>(lds, o, g_c, P.scr, mixrow0, wid);
    __syncthreads();
    if (IMPL == 0) {
    {
        const int cur = qi;
        for (int qq = 0; qq < 8; ++qq) {
            const int q = wid * 8 + qq;
            unsigned mk0 = 0u, mk1 = 0u, mk2 = 0u, mk3 = 0u;
#define MK_SET(idx) do { const int _w = (idx) >> 5; const unsigned _b = 1u << ((idx) & 31); mk0 |= _w == 0 ? _b : 0u; mk1 |= _w == 1 ? _b : 0u; mk2 |= _w == 2 ? _b : 0u; mk3 |= _w == 3 ? _b : 0u; } while (0)
            if (cur <= 15) { mk0 = (1u << (cur + 1)) - 1u; }
            else {
                MK_SET(0); MK_SET(cur); MK_SET(cur - 1);
                const int j0 = lane, j1 = lane + 64;
                const unsigned* bsu = (const unsigned*)bs;
                unsigned s0 = (j0 >= 1 && j0 <= cur - 2) ? bsu[q * BS_STRIDE + j0] + 1u : 0u;
                unsigned s1 = (j1 <= cur - 2) ? bsu[q * BS_STRIDE + j1] + 1u : 0u;
                for (int it = 0; it < 13; ++it) {
                    unsigned bv; int bi;
                    if (s1 > s0) { bv = s1; bi = j1; } else { bv = s0; bi = j0; }
#pragma unroll
                    for (int off = 1; off < 64; off <<= 1) { const unsigned ov = (unsigned)__shfl_xor((int)bv, off); const int oi = __shfl_xor(bi, off); if (ov > bv || (ov == bv && oi < bi)) { bv = ov; bi = oi; } }
                    bi = __builtin_amdgcn_readfirstlane(bi);
                    MK_SET(bi);
                    if (bi == j0) s0 = 0u;
                    if (bi == j1) s1 = 0u;
                }
            }
#undef MK_SET
            if (lane < 4) { const unsigned v = lane == 0 ? mk0 : lane == 1 ? mk1 : lane == 2 ? mk2 : mk3; selm[q * 4 + lane] = v; atomicOr(&uni[lane], v); }
        }
    }
    } else {
    {
        const int cur = qi;
        if (cur <= 15) {
            if (lane < 4) { const unsigned v = lane == 0 ? ((1u << (cur + 1)) - 1u) : 0u;
#pragma unroll
                for (int qq = 0; qq < 8; ++qq) selm[(wid * 8 + qq) * 4 + lane] = v;
                atomicOr(&uni[lane], v); }
        } else {
            const unsigned* bsu = (const unsigned*)bs; const int j0 = lane, j1 = lane + 64;
            const bool v0 = j0 >= 1 && j0 <= cur - 2, v1 = j1 <= cur - 2;
#pragma unroll 1
            for (int qb = 0; qb < 8; qb += 4) {
                unsigned s0[4], s1[4]; unsigned long long ma[4], mb[4];
#pragma unroll
                for (int u = 0; u < 4; ++u) { const int q = wid * 8 + qb + u;
                    s0[u] = v0 ? bsu[q * BS_STRIDE + j0] + 1u : 0u; s1[u] = v1 ? bsu[q * BS_STRIDE + j1] + 1u : 0u;
                    ma[u] = 1ull; mb[u] = 0ull;
                    if (cur < 64) ma[u] |= 1ull << cur; else mb[u] |= 1ull << (cur - 64);
                    if (cur - 1 < 64) ma[u] |= 1ull << (cur - 1); else mb[u] |= 1ull << (cur - 65); }
#pragma unroll 1
                for (int it = 0; it < 13; ++it) {
#pragma unroll
                    for (int u = 0; u < 4; ++u) {
                        unsigned v = s0[u] > s1[u] ? s0[u] : s1[u];
                        { unsigned t;
                          t = (unsigned)__builtin_amdgcn_update_dpp(0, (int)v, 0x111, 0xf, 0xf, false); v = v > t ? v : t;
                          t = (unsigned)__builtin_amdgcn_update_dpp(0, (int)v, 0x112, 0xf, 0xf, false); v = v > t ? v : t;
                          t = (unsigned)__builtin_amdgcn_update_dpp(0, (int)v, 0x114, 0xf, 0xf, false); v = v > t ? v : t;
                          t = (unsigned)__builtin_amdgcn_update_dpp(0, (int)v, 0x118, 0xf, 0xf, false); v = v > t ? v : t;
                          t = (unsigned)__builtin_amdgcn_update_dpp(0, (int)v, 0x142, 0xa, 0xf, false); v = v > t ? v : t;
                          t = (unsigned)__builtin_amdgcn_update_dpp(0, (int)v, 0x143, 0xc, 0xf, false); v = v > t ? v : t; }
                        const unsigned m = (unsigned)__builtin_amdgcn_readlane((int)v, 63);
                        const unsigned long long b0 = __ballot(s0[u] == m), b1 = __ballot(s1[u] == m);
                        if (b0) { const int idx = __builtin_ctzll(b0); ma[u] |= 1ull << idx; if (lane == idx) s0[u] = 0u; }
                        else    { const int idx = __builtin_ctzll(b1); mb[u] |= 1ull << idx; if (lane == idx) s1[u] = 0u; }
                    }
                }
#pragma unroll
                for (int u = 0; u < 4; ++u) { const int q = wid * 8 + qb + u;
                    if (lane < 4) { const unsigned v = lane == 0 ? (unsigned)ma[u] : lane == 1 ? (unsigned)(ma[u] >> 32) : lane == 2 ? (unsigned)mb[u] : (unsigned)(mb[u] >> 32); selm[q * 4 + lane] = v; atomicOr(&uni[lane], v); } }
            }
        }
    }
    }
    __syncthreads();
    if (tid < 128) {
        const unsigned w = uni[tid >> 5]; const bool on = (w >> (tid & 31)) & 1u;
        if (on) { int pos = __popc(w & ((1u << (tid & 31)) - 1u)); for (int k = 0; k < (tid >> 5); ++k) pos += __popc(uni[k]); tlist[pos] = tid; }
    }
    const int nsel = __popc(uni[0]) + __popc(uni[1]) + __popc(uni[2]) + __popc(uni[3]);
#pragma unroll
    for (int k = 0; k < 4; ++k) selw[k] = selm[qoff * 4 + k];
    __syncthreads();
    { float m_s = -1e30f, l_s = 0.f;
#pragma unroll
      for (int d = 0; d < 4; ++d) o[d] = f32x16{};
      if (IMPL == 0) branch_ref<2>(lds, Ks, Vs, qr, nsel, qi, qoff, 0, selw, m_s, l_s, 0.f, o, wid); else { conv_prime(lds, cv, nsel + (qi - ((qi - 8 > 0) ? qi - 8 : 0) + 1), wid); if (cv.live) branch<2, true>(lds, Ks, Vs, qr, nsel, qi, qoff, 0, selw, m_s, l_s, 0.f, o, wid, cv); else branch<2, false>(lds, Ks, Vs, qr, nsel, qi, qoff, 0, selw, m_s, l_s, 0.f, o, wid, cv); }
      if (IMPL == 1) accum_out(lds, o, l_s > 0.f ? g_s / l_s : 0.f, out, wid, false); else finalize<1>(lds, o, l_s > 0.f ? g_s / l_s : 0.f, P.scr, mixrow0, wid); }
    { float m_w = -1e30f, l_w = 0.f;
#pragma unroll
      for (int d = 0; d < 4; ++d) o[d] = f32x16{};
      const int j0w = (qi - 8 > 0) ? qi - 8 : 0;
      if (IMPL == 0) branch_ref<3>(lds, Kw, Vw, qr, qi - j0w + 1, qi, qoff, 0, selw, m_w, l_w, 0.f, o, wid); else { if (cv.live) branch<3, true>(lds, Kw, Vw, qr, qi - j0w + 1, qi, qoff, 0, selw, m_w, l_w, 0.f, o, wid, cv); else branch<3, false>(lds, Kw, Vw, qr, qi - j0w + 1, qi, qoff, 0, selw, m_w, l_w, 0.f, o, wid, cv); conv_drain(lds, cv, wid); }
      if (IMPL == 1) { accum_out(lds, o, l_w > 0.f ? g_w / l_w : 0.f, out, wid, false); store_out<CHECK>(lds, out, mixrow0, wid, err); }
      else finalize<2, CHECK>(lds, o, l_w > 0.f ? g_w / l_w : 0.f, P.scr, mixrow0, wid, err); }
    __syncthreads();
}
}

struct Frame {
    LAS unsigned char* lds; char* ldsg;
    unsigned* ctl; unsigned char* ws;
    int wave, G, c;
};
#define FRESH_TID() const int lane = fresh_lane(); const int tid = F.wave * 64 + lane; (void)tid; (void)lane
__constant__ float c_inv_freq[16] = {1.0f, 0.44036659598350525f, 0.1939227432012558f, 0.08539710193872452f, 0.03760603070259094f, 0.016560440883040428f, 0.007292664609849453f,
    0.0032114461064338684f, 0.0014142135623842478f, 0.0006227724370546639f, 0.00027424818836152554f, 0.00012076973507646471f, 5.3182957344688475e-05f, 2.34199997066753e-05f,
    1.0313385246263351e-05f, 4.541670477919979e-06f};

template <int MODE> __device__ __forceinline__ int rowmap(int n) {
    if (MODE == 1) return n < 2560 ? n : (n < 2584 ? 3584 + (n - 2560) : n - 24);
    if (MODE == 2) return n < 2048 ? ((n >> 7) * 256 + (n & 127)) : (((n - 2048) >> 7) * 256 + 128 + ((n - 2048) & 127));
    return n;
}
struct TrMat { const float* W; bf16_t* WT; int K, N, ldt, mode, nkt, nnt; };
__device__ __forceinline__ void tr_load(const TrMat& M, int kt, int nt, int w, int lane, f32x4 (&v)[8]) {
    const int n = nt * 128 + (lane & 31) * 4, kb = kt * 128 + w * 16 + (lane >> 5) * 8;
    const bool ok = n < M.N; const float* p = M.W + (size_t)kb * M.N + (ok ? n : 0);
#pragma unroll
    for (int i = 0; i < 8; ++i) v[i] = *(const f32x4*)(p + (size_t)i * M.N);
}
__device__ __forceinline__ void tr_lds_write(LAS unsigned* buf, int w, int lane, const f32x4 (&v)[8]) {
#pragma unroll
    for (int i2 = 0; i2 < 4; ++i2) { const int kp = w * 8 + (lane >> 5) * 4 + i2;
        u32x4 o; o.x = cvt_pk_bf16(v[2 * i2][0], v[2 * i2 + 1][0]); o.y = cvt_pk_bf16(v[2 * i2][1], v[2 * i2 + 1][1]); o.z = cvt_pk_bf16(v[2 * i2][2], v[2 * i2 + 1][2]); o.w = cvt_pk_bf16(v[2 * i2][3], v[2 * i2 + 1][3]);
        *(LAS u32x4*)(buf + kp * 128 + (((lane & 31) * 4) ^ (4 * ((kp >> 2) & 7)))) = o; }
}
__device__ __forceinline__ void tr_store(const TrMat& M, int kt, int nt, const LAS unsigned* buf, int tid) {
#pragma unroll
    for (int q = 0; q < 4; ++q) { const int idx = tid + 512 * q, nl = idx >> 4, kg = idx & 15, n = nt * 128 + nl;
        u32x4 o; const LAS unsigned* b = buf + (kg * 4) * 128 + (nl ^ (4 * (kg & 7)));
        o.x = b[0]; o.y = b[128]; o.z = b[256]; o.w = b[384];
        if (n < M.N) { const int row = M.mode == 1 ? rowmap<1>(n) : n; *(u32x4*)(M.WT + (size_t)row * M.ldt + kt * 128 + kg * 8) = o; } }
}
__device__ __forceinline__ unsigned pk4_fp8(float a, float b, float c, float d) { int p = __builtin_amdgcn_cvt_pk_fp8_f32(a, b, 0, false); p = __builtin_amdgcn_cvt_pk_fp8_f32(c, d, p, true); return (unsigned)p; }
__device__ __forceinline__ void tr_lds_write8(LAS unsigned* buf, int w, int lane, const f32x4 (&v)[8]) {
#pragma unroll
    for (int i2 = 0; i2 < 2; ++i2) { const int kq = w * 4 + (lane >> 5) * 2 + i2;
        u32x4 o;
#pragma unroll
        for (int j = 0; j < 4; ++j) o[j] = pk4_fp8(v[4 * i2][j] * 64.0f, v[4 * i2 + 1][j] * 64.0f, v[4 * i2 + 2][j] * 64.0f, v[4 * i2 + 3][j] * 64.0f);
        *(LAS u32x4*)(buf + kq * 128 + (((lane & 31) * 4) ^ (4 * ((kq >> 2) & 7)))) = o; }
}
__device__ __forceinline__ void tr_store8(const TrMat& M, int kt, int nt, const LAS unsigned* buf, int tid) {
#pragma unroll
    for (int q = 0; q < 2; ++q) { const int idx = tid + 512 * q, nl = idx >> 3, kg = idx & 7, n = nt * 128 + nl;
        u32x4 o; const LAS unsigned* b = buf + (kg * 4) * 128 + (nl ^ (4 * kg));
        o.x = b[0]; o.y = b[128]; o.z = b[256]; o.w = b[384];
        const int row = M.mode == 2 ? rowmap<2>(n) : n; *(u32x4*)((unsigned char*)M.WT + ((size_t)(kt * 8 + kg) * M.N + row) * 16) = o; }
}
__device__ __forceinline__ bool tr_pick(const Frame& F, const Args& A, int id, TrMat& M, int& kt, int& nt) {
    constexpr int T_GU = 16 * 32, T_DN = 16 * 16, T_IN = 16 * 29, T_OUT = 16 * 16, T_W1 = 32 * 2, T_PW = 2 * 2, T_W2 = 2;
    int r = id;
    if (r < 32 * T_GU) { const int e = r / T_GU; r %= T_GU; M = TrMat{A.in[I_WGU] + (size_t)e * 2048 * 4096, (bf16_t*)(F.ws + WS_WGU + (size_t)e * 4096 * 2048), 2048, 4096, 2048, 2, 16, 32}; }
    else if ((r -= 32 * T_GU) < 32 * T_DN) { const int e = r / T_DN; r %= T_DN; M = TrMat{A.in[I_WD] + (size_t)e * 2048 * 2048, (bf16_t*)(F.ws + WS_WD + (size_t)e * 2048 * 2048), 2048, 2048, 2048, 3, 16, 16}; }
    else if ((r -= 32 * T_DN) < T_IN) { M = TrMat{A.in[I_WIN], (bf16_t*)(F.ws + WS_WINT), 2048, 3608, 2048, 1, 16, 29}; }
    else if ((r -= T_IN) < T_OUT) { M = TrMat{A.in[I_WOUT], (bf16_t*)(F.ws + WS_WOUTT), 2048, 2048, 2048, 0, 16, 16}; }
    else if ((r -= T_OUT) < 2 * T_W1) { const int kv = r / T_W1; r %= T_W1; M = TrMat{kv ? A.in[I_CVW1] : A.in[I_CKW1], (bf16_t*)(F.ws + WS_W1T) + (size_t)kv * 256 * 4096, 4096, 256, 4096, 0, 32, 2}; }
    else if ((r -= 2 * T_W1) < 4 * T_PW) { const int g = r / T_PW; r %= T_PW; M = TrMat{A.in[I_POOLW] + (size_t)g * 65536, (bf16_t*)(F.ws + WS_PWT) + (size_t)g * 65536, 256, 256, 256, 0, 2, 2}; }
    else if ((r -= 4 * T_PW) < 2 * T_W2) { const int kv = r / T_W2; r %= T_W2; M = TrMat{kv ? A.in[I_CVW2] : A.in[I_CKW2], (bf16_t*)(F.ws + WS_W2T) + (size_t)kv * 128 * 256, 256, 128, 256, 0, 2, 1}; }
    else return false;
    kt = r / M.nnt; nt = r % M.nnt; return true;
}
constexpr int NMOE_TILES = 32 * (16 * 32 + 16 * 16);
__device__ __forceinline__ void convert_tiles(const Frame& F, const Args& A, int first, int stride, int end) {
    FRESH_TID();
    LAS unsigned* tb0 = (LAS unsigned*)F.lds; TrMat MA, MB; int ktA = 0, ntA = 0, ktB = 0, ntB = 0; f32x4 vA[8], vB[8];
    int id = first;
    bool haveA = id < end && tr_pick(F, A, id, MA, ktA, ntA); if (haveA) tr_load(MA, ktA, ntA, F.wave, lane, vA);
    bool haveB = id + stride < end && tr_pick(F, A, id + stride, MB, ktB, ntB); if (haveB) tr_load(MB, ktB, ntB, F.wave, lane, vB);
    id += 2 * stride;
    while (haveA) {
        { LAS unsigned* buf = tb0;
          if (MA.mode >= 2) tr_lds_write8(buf, F.wave, lane, vA); else tr_lds_write(buf, F.wave, lane, vA);
          __syncthreads();
          const TrMat Mc = MA; const int ktc = ktA, ntc = ntA;
          haveA = id < end && tr_pick(F, A, id, MA, ktA, ntA); if (haveA) tr_load(MA, ktA, ntA, F.wave, lane, vA);
          if (Mc.mode >= 2) tr_store8(Mc, ktc, ntc, buf, tid); else tr_store(Mc, ktc, ntc, buf, tid); }
        if (!haveB) break;
        { LAS unsigned* buf = tb0 + 8192;
          if (MB.mode >= 2) tr_lds_write8(buf, F.wave, lane, vB); else tr_lds_write(buf, F.wave, lane, vB);
          __syncthreads();
          const TrMat Mc = MB; const int ktc = ktB, ntc = ntB;
          haveB = id + stride < end && tr_pick(F, A, id + stride, MB, ktB, ntB); if (haveB) tr_load(MB, ktB, ntB, F.wave, lane, vB);
          if (Mc.mode >= 2) tr_store8(Mc, ktc, ntc, buf, tid); else tr_store(Mc, ktc, ntc, buf, tid); }
        id += 2 * stride;
    }
    __syncthreads();
}
__device__ __forceinline__ void posb_partials(const Frame& F, const Args& A, int rank, int n) {
    FRESH_TID();
    float* pb = (float*)(F.ws + WS_POSB64);
    for (long i = (long)rank * 512 + tid; i < 64 * 512; i += (long)n * 512) { const int o = (int)(i & 511), ks = (int)(i >> 9), kv = o >> 8, h = o & 255;
        const float* pos = kv ? A.in[I_CVPOS] : A.in[I_CKPOS]; const float* w1 = kv ? A.in[I_CVW1] : A.in[I_CKW1]; float s0 = 0.f, s1 = 0.f, s2 = 0.f, s3 = 0.f;
#pragma unroll 4
        for (int r = ks * 64; r < ks * 64 + 64; r += 4) { s0 = fmaf(pos[r], w1[(size_t)r * 256 + h], s0); s1 = fmaf(pos[r + 1], w1[(size_t)(r + 1) * 256 + h], s1); s2 = fmaf(pos[r + 2], w1[(size_t)(r + 2) * 256 + h], s2); s3 = fmaf(pos[r + 3], w1[(size_t)(r + 3) * 256 + h], s3); }
        pb[i] = (s0 + s1) + (s2 + s3); }
}
__device__ __forceinline__ void phase0(const Frame& F, const Args& A) {
    FRESH_TID();
    const int gw = F.c * NWAVES + F.wave, NGW = F.G * NWAVES;
    const long gt = (long)F.c * 512 + tid, NT = (long)F.G * 512;
    { const float* x = A.in[I_X]; const float* g1 = A.in[I_N1G]; bf16_t* H = (bf16_t*)(F.ws + WS_H);
      for (int row = gw; row < NTOK; row += 2 * NGW) {
        const bool hasB = row + NGW < NTOK; const int rowB = hasB ? row + NGW : row;
        const f32x4* xa = (const f32x4*)(x + (size_t)row * DM) + lane; const f32x4* xb = (const f32x4*)(x + (size_t)rowB * DM) + lane; f32x4 va[8], vb[8]; float sa = 0.f, sb = 0.f;
#pragma unroll
        for (int j = 0; j < 8; ++j) { va[j] = xa[64 * j]; vb[j] = xb[64 * j]; }
#pragma unroll
        for (int j = 0; j < 8; ++j) { sa += (va[j][0] * va[j][0] + va[j][1] * va[j][1]) + (va[j][2] * va[j][2] + va[j][3] * va[j][3]); sb += (vb[j][0] * vb[j][0] + vb[j][1] * vb[j][1]) + (vb[j][2] * vb[j][2] + vb[j][3] * vb[j][3]); }
        const float ra = rsqrtf(wave_sum(sa) * (1.0f / DM) + 1e-5f), rb = rsqrtf(wave_sum(sb) * (1.0f / DM) + 1e-5f);
        u32x2* oa = (u32x2*)(H + (size_t)row * DM) + lane; u32x2* ob = (u32x2*)(H + (size_t)rowB * DM) + lane;
#pragma unroll
        for (int j = 0; j < 8; ++j) { const f32x4 gg = ((const f32x4*)g1)[64 * j + lane]; u32x2 w;
            w.x = cvt_pk_bf16(va[j][0] * ra * gg[0], va[j][1] * ra * gg[1]); w.y = cvt_pk_bf16(va[j][2] * ra * gg[2], va[j][3] * ra * gg[3]); oa[64 * j] = w;
            if (hasB) { w.x = cvt_pk_bf16(vb[j][0] * rb * gg[0], vb[j][1] * rb * gg[1]); w.y = cvt_pk_bf16(vb[j][2] * rb * gg[2], vb[j][3] * rb * gg[3]); ob[64 * j] = w; } }
      } }
    convert_tiles(F, A, (F.G == 256 ? NMOE_TILES : 0) + F.c, F.G, 1 << 30);
    { u32x4* z = (u32x4*)((bf16_t*)(F.ws + WS_WINT) + (size_t)3608 * 2048); const long n16 = (long)(NINP - 3608) * 2048 * 2 / 16;
      for (long i = gt; i < n16; i += NT) z[i] = (u32x4){0u, 0u, 0u, 0u}; }
    { float* tc = (float*)(F.ws + WS_COS); float* tsn = (float*)(F.ws + WS_SIN);
      for (long i = gt; i < 8208 * 16; i += NT) { const int pos = (int)(i >> 4), k = (int)(i & 15);
        const float ang = (float)pos * c_inv_freq[k]; double xr = (double)ang * 0.15915494309189535; xr -= __builtin_rint(xr);
        tc[i] = __builtin_amdgcn_cosf((float)xr); tsn[i] = __builtin_amdgcn_sinf((float)xr); } }
}

struct RowJob { bf16_t* p; u32x4 raw; f32x4 g0, g1, c0, c1, s0, s1; };
__device__ __forceinline__ void rowjob_issue(RowJob& J, const Frame& F, const Args& A, int row, int sub) {
    constexpr int NQ = NTOK * 8, NK = NB * NGRP * SEQ;
    bf16_t* Q = (bf16_t*)(F.ws + WS_Q); bf16_t* KS = (bf16_t*)(F.ws + WS_KV + 2 * KV_STRIDE); bf16_t* KW = (bf16_t*)(F.ws + WS_KV + 4 * KV_STRIDE);
    const float* tc = (const float*)(F.ws + WS_COS); const float* tsn = (const float*)(F.ws + WS_SIN);
    const float* gain; int pos;
    if (row < NQ) { J.p = Q + (size_t)row * 128; gain = A.in[I_QNG]; pos = (row >> 3) & (SEQ - 1); }
    else if (row < NQ + NK) { const int r = row - NQ; J.p = KS + (size_t)r * 128; gain = A.in[I_KNS]; pos = r & (SEQ - 1); }
    else { const int r = row - NQ - NK; J.p = KW + (size_t)r * 128; gain = A.in[I_KNW]; pos = r & (SEQ - 1); }
    J.raw = *(const u32x4*)(J.p + sub * 8);
    J.g0 = *(const f32x4*)(gain + sub * 8); J.g1 = *(const f32x4*)(gain + sub * 8 + 4);
    const int ti = pos * 16 + (sub & 1) * 8;
    J.c0 = *(const f32x4*)(tc + ti); J.c1 = *(const f32x4*)(tc + ti + 4); J.s0 = *(const f32x4*)(tsn + ti); J.s1 = *(const f32x4*)(tsn + ti + 4);
}
__device__ __forceinline__ void rowjob_finish(const RowJob& J, int sub) {
    const u32x4 raw = J.raw;
    float x[8] = {bf_lo(raw.x), bf_hi(raw.x), bf_lo(raw.y), bf_hi(raw.y), bf_lo(raw.z), bf_hi(raw.z), bf_lo(raw.w), bf_hi(raw.w)};
    float ss = 0.f;
#pragma unroll
    for (int j = 0; j < 8; ++j) ss += x[j] * x[j];
    ss += __shfl_xor(ss, 1); ss += __shfl_xor(ss, 2); ss += __shfl_xor(ss, 4); ss += __shfl_xor(ss, 8);
    const float rstd = rsqrtf(ss * (1.0f / 128.0f) + 1e-6f);
#pragma unroll
    for (int j = 0; j < 8; ++j) x[j] = x[j] * rstd * (j < 4 ? J.g0[j] : J.g1[j - 4]);
#pragma unroll
    for (int j = 0; j < 8; ++j) { const float other = __shfl_xor(x[j], 2); const float cs = j < 4 ? J.c0[j] : J.c1[j - 4], sn = j < 4 ? J.s0[j] : J.s1[j - 4];
        const float rot = (sub < 2) ? (x[j] * cs - other * sn) : (x[j] * cs + other * sn); x[j] = sub < 4 ? rot : x[j]; }
    u32x4 w; w.x = cvt_pk_bf16(x[0], x[1]); w.y = cvt_pk_bf16(x[2], x[3]); w.z = cvt_pk_bf16(x[4], x[5]); w.w = cvt_pk_bf16(x[6], x[7]);
    *(u32x4*)(J.p + sub * 8) = w;
}
__device__ __forceinline__ void norm_rope_rows(const Frame& F, const Args& A, int ec, int eG) {
    FRESH_TID();
    const int gw = ec * NWAVES + F.wave, NGW = eG * NWAVES, sub = lane & 15, rsel = lane >> 4;
    constexpr int NITEM = (NTOK * 8 + 2 * NB * NGRP * SEQ) / 4;
    for (int it = gw; it < NITEM; it += 2 * NGW) {
        RowJob JA, JB; const bool hasB = it + NGW < NITEM;
        rowjob_issue(JA, F, A, it * 4 + rsel, sub);
        if (hasB) rowjob_issue(JB, F, A, (it + NGW) * 4 + rsel, sub);
        rowjob_finish(JA, sub);
        if (hasB) rowjob_finish(JB, sub);
    }
}
template <int W> __device__ __forceinline__ void pool_item(const bf16_t* PIN, bf16_t* DP, int tok, int c8) {
    const int s = tok & (SEQ - 1);
    u32x4 raw[W];
#pragma unroll
    for (int j = 0; j < W; ++j) { const int jj = j <= s ? j : s; raw[j] = *(const u32x4*)(PIN + (size_t)(tok - jj) * 1024 + c8 * 8); }
    float acc[8] = {0.f, 0.f, 0.f, 0.f, 0.f, 0.f, 0.f, 0.f};
#pragma unroll
    for (int j = 0; j < W; ++j) { const float wg = j <= s ? 1.f : 0.f; const u32x4 r = raw[j];
        acc[0] = fmaf(bf_lo(r.x), wg, acc[0]); acc[1] = fmaf(bf_hi(r.x), wg, acc[1]); acc[2] = fmaf(bf_lo(r.y), wg, acc[2]); acc[3] = fmaf(bf_hi(r.y), wg, acc[3]);
        acc[4] = fmaf(bf_lo(r.z), wg, acc[4]); acc[5] = fmaf(bf_hi(r.z), wg, acc[5]); acc[6] = fmaf(bf_lo(r.w), wg, acc[6]); acc[7] = fmaf(bf_hi(r.w), wg, acc[7]); }
    const u32x4 r0 = raw[0]; const float cur[8] = {bf_lo(r0.x), bf_hi(r0.x), bf_lo(r0.y), bf_hi(r0.y), bf_lo(r0.z), bf_hi(r0.z), bf_lo(r0.w), bf_hi(r0.w)};
    const float inv = 1.0f / (float)((s + 1 < W) ? s + 1 : W); float d[8];
#pragma unroll
    for (int k = 0; k < 8; ++k) d[k] = acc[k] * inv - cur[k];
    u32x4 o; o.x = cvt_pk_bf16(d[0], d[1]); o.y = cvt_pk_bf16(d[2], d[3]); o.z = cvt_pk_bf16(d[4], d[5]); o.w = cvt_pk_bf16(d[6], d[7]);
    *(u32x4*)(DP + (size_t)tok * 1024 + c8 * 8) = o;
}
__device__ __forceinline__ void pool_diffs(const Frame& F, int ec, int eG) {
    const bf16_t* PIN = (const bf16_t*)(F.ws + WS_PIN); bf16_t* DP = (bf16_t*)(F.ws + WS_DP);
    FRESH_TID();
    const long gt = (long)ec * 512 + tid, NT = (long)eG * 512;
    for (long i = gt; i < 4L * NTOK * 32; i += NT) {
        const int g = (int)(i >> 19), tok = (int)((i >> 5) & (NTOK - 1)), c8 = g * 32 + (int)(i & 31);
        if (g == 0) pool_item<2>(PIN, DP, tok, c8); else if (g == 1) pool_item<4>(PIN, DP, tok, c8); else if (g == 2) pool_item<8>(PIN, DP, tok, c8); else pool_item<16>(PIN, DP, tok, c8);
    }
}
__device__ __forceinline__ void cmp_bias_total(const Frame& F, const Args& A) {
    FRESH_TID();
    const float* posb = (const float*)(F.ws + WS_POSB64); float* bt = (float*)(F.ws + WS_POSB + 65536 - 2048);
#pragma unroll
    for (int q = 0; q < 8; ++q) { const int o = q * 64 + lane; float sacc = (o < 256 ? A.in[I_CKB1] : A.in[I_CVB1])[o & 255];
        for (int p = 0; p < 64; ++p) sacc += posb[p * 512 + o];
        bt[o] = sacc; }
}
__device__ __forceinline__ void cmp_layer2(const Frame& F, const Args& A, int kv, int rg) {
    FRESH_TID();
    const int w = F.wave, l15 = lane & 15, q4 = lane >> 4;
    const float* HP = (const float*)(F.ws + WS_ACT); const bf16_t* W2T = (const bf16_t*)(F.ws + WS_W2T) + (size_t)kv * 128 * 256;
    const float* bt = (const float*)(F.ws + WS_POSB + 65536 - 2048) + kv * 256;
    LAS f32x4* red = (LAS f32x4*)F.lds;
    { const int rowA = rg * 16 + l15, k0 = w * 32 + q4 * 8;
      f32x4 h0 = *(const f32x4*)(bt + k0), h1 = *(const f32x4*)(bt + k0 + 4);
#pragma unroll
      for (int p = 0; p < 4; ++p) { const float* src = HP + ((size_t)(p * 2 + kv) * 2048 + rowA) * 256 + k0; h0 += *(const f32x4*)src; h1 += *(const f32x4*)(src + 4); }
      float g[8];
#pragma unroll
      for (int j = 0; j < 8; ++j) { const float x = j < 4 ? h0[j] : h1[j - 4]; const float uu = 0.7978845608028654f * (x + 0.044715f * x * x * x);
          g[j] = x * fast_rcp(1.0f + fast_exp2(-2.885390081777927f * uu)); }
      auto f2b = [](float f) -> unsigned { unsigned u = __float_as_uint(f); return (u + 0x7fffu + ((u >> 16) & 1u)) >> 16; };
      u32x4 aw; aw.x = f2b(g[0]) | (f2b(g[1]) << 16); aw.y = f2b(g[2]) | (f2b(g[3]) << 16); aw.z = f2b(g[4]) | (f2b(g[5]) << 16); aw.w = f2b(g[6]) | (f2b(g[7]) << 16);
      const bf16x8 a = *reinterpret_cast<const bf16x8*>(&aw);
#pragma unroll
      for (int nt = 0; nt < 8; ++nt) { const bf16x8 b = *(const bf16x8*)(W2T + (size_t)(nt * 16 + l15) * 256 + w * 32 + q4 * 8);
          const f32x4 z = {0.f, 0.f, 0.f, 0.f}; red[(w * 8 + nt) * 64 + lane] = __builtin_amdgcn_mfma_f32_16x16x32_bf16(a, b, z, 0, 0, 0); } }
    __syncthreads();
    if (w == 0) {
        bf16_t* OUT = (bf16_t*)(F.ws + WS_CMP + (kv ? 512 * 1024 : 0));
        const float* b2 = kv ? A.in[I_CVB2] : A.in[I_CKB2]; const float* gain = A.in[I_KNC];
        const float* tc = (const float*)(F.ws + WS_COS); const float* tsn = (const float*)(F.ws + WS_SIN);
        f32x4 acc[8]; float bb[8], gg[8];
#pragma unroll
        for (int nt = 0; nt < 8; ++nt) { f32x4 t = red[nt * 64 + lane];
#pragma unroll
            for (int ww = 1; ww < 8; ++ww) t += red[(ww * 8 + nt) * 64 + lane];
            acc[nt] = t; bb[nt] = b2[nt * 16 + l15]; gg[nt] = gain[nt * 16 + l15]; }
#pragma unroll
        for (int r = 0; r < 4; ++r) {
            const int m = rg * 16 + q4 * 4 + r, n = m & 511;
            float v[8]; float ss = 0.f;
#pragma unroll
            for (int nt = 0; nt < 8; ++nt) { v[nt] = acc[nt][r] + bb[nt]; ss += v[nt] * v[nt]; }
            if (kv == 0) {
                ss += __shfl_xor(ss, 1); ss += __shfl_xor(ss, 2); ss += __shfl_xor(ss, 4); ss += __shfl_xor(ss, 8);
                const float rstd = rsqrtf(ss * (1.0f / 128.0f) + 1e-6f);
#pragma unroll
                for (int nt = 0; nt < 8; ++nt) v[nt] = v[nt] * rstd * gg[nt];
                const int pos = n * 16 + 31; const float cs = tc[pos * 16 + l15], sn = tsn[pos * 16 + l15];
                const float x1 = v[0], x2 = v[1]; v[0] = x1 * cs - x2 * sn; v[1] = x2 * cs + x1 * sn;
            }
#pragma unroll
            for (int nt = 0; nt < 8; ++nt) { const float o = (n == 511) ? 0.f : v[nt]; OUT[(size_t)m * 128 + nt * 16 + l15] = (bf16_t)(cvt_pk_bf16(o, o) & 0xffffu); }
        }
    }
    __syncthreads();
}

__device__ __forceinline__ void phase5(const Frame& F, const Args& A) {
    FRESH_TID();
    const int w = F.wave;
    LAS float* xs = (LAS float*)F.lds;
    LAS float* red = (LAS float*)(F.lds + LTAB_OFF);
    LAS int* hist = (LAS int*)(F.lds + LTAB_OFF + 16384);
    LAS int* base = hist + 32;
    const float* X1 = A.in[I_X]; const bf16_t* ATT = (const bf16_t*)(F.ws + WS_H); const float* g2 = A.in[I_N2G]; const float* Wr = A.in[I_WR]; const float* br = A.in[I_BR];
    unsigned char* H2 = (unsigned char*)(F.ws + WS_H2);
    unsigned* slot = (unsigned*)(F.ws + WS_SLOT); int* tokl = (int*)(F.ws + WS_TOKL); float* wl = (float*)(F.ws + WS_WL);
    unsigned* counts = F.ctl + CW_CNT;
    constexpr int XS = 2050;
    float wr0[64], wr1[64];
    { const float* wb = Wr + (size_t)(256 * w + (lane >> 4)) * 32 + (lane & 15);
#pragma unroll
      for (int s = 0; s < 64; ++s) { wr0[s] = wb[(size_t)s * 128]; wr1[s] = wb[(size_t)s * 128 + 16]; } }
    LAS unsigned* rec = (LAS unsigned*)(F.lds + LTAB_OFF + 16384 + 512);
    int ci = 0;
    for (int ch = F.c; ch < NTOK / 16; ch += F.G, ++ci) {
        if ((ci & 3) == 0 && tid < 32) hist[tid] = 0;
        { const int tok0 = ch * 16 + 2 * w;
#pragma unroll 1
          for (int half = 0; half < 2; ++half) {
              const f32x4* xr = (const f32x4*)(X1 + (size_t)(tok0 + half) * DM) + lane; const u32x2* ar = (const u32x2*)(ATT + (size_t)(tok0 + half) * DM) + lane; f32x4 v[8]; u32x2 a[8]; float ssq = 0.f;
#pragma unroll
              for (int j = 0; j < 8; ++j) { v[j] = xr[64 * j]; a[j] = ar[64 * j]; }
#pragma unroll
              for (int j = 0; j < 8; ++j) { v[j][0] += bf_lo(a[j].x); v[j][1] += bf_hi(a[j].x); v[j][2] += bf_lo(a[j].y); v[j][3] += bf_hi(a[j].y);
                  ssq += (v[j][0] * v[j][0] + v[j][1] * v[j][1]) + (v[j][2] * v[j][2] + v[j][3] * v[j][3]); }
              const float rs = rsqrtf(wave_sum(ssq) * (1.0f / DM) + 1e-5f);
              unsigned* oo = (unsigned*)(H2 + (size_t)(tok0 + half) * DM) + lane;
#pragma unroll
              for (int j = 0; j < 8; ++j) { const f32x4 gg = ((const f32x4*)g2)[64 * j + lane];
                  const float y0 = v[j][0] * rs * gg[0], y1 = v[j][1] * rs * gg[1], y2 = v[j][2] * rs * gg[2], y3 = v[j][3] * rs * gg[3];
                  oo[64 * j] = pk4_fp8(y0, y1, y2, y3); LAS f32x2* d = (LAS f32x2*)(xs + (2 * w + half) * XS + (64 * j + lane) * 4); d[0] = (f32x2){y0, y1}; d[1] = (f32x2){y2, y3}; }
          }
        }
        __syncthreads();
        { f32x4 a0 = {0.f, 0.f, 0.f, 0.f}, a1 = {0.f, 0.f, 0.f, 0.f};
          const LAS float* xa = xs + (lane & 15) * XS + 256 * w + (lane >> 4);
#pragma unroll
          for (int s = 0; s < 64; ++s) { const float a = xa[4 * s];
              a0 = __builtin_amdgcn_mfma_f32_16x16x4f32(a, wr0[s], a0, 0, 0, 0); a1 = __builtin_amdgcn_mfma_f32_16x16x4f32(a, wr1[s], a1, 0, 0, 0); }
#pragma unroll
          for (int r = 0; r < 4; ++r) { red[(w * 16 + (lane >> 4) * 4 + r) * 32 + (lane & 15)] = a0[r]; red[(w * 16 + (lane >> 4) * 4 + r) * 32 + 16 + (lane & 15)] = a1[r]; } }
        __syncthreads();
        const int tl = tid >> 5, e = tid & 31, tok = ch * 16 + tl;
        float lg = br[e];
#pragma unroll
        for (int k = 0; k < 8; ++k) lg += red[(k * 16 + tl) * 32 + e];
        float tv[4]; int ti[4];
#pragma unroll
        for (int r = 0; r < 4; ++r) { float bv = lg; int bi = e;
#pragma unroll
            for (int off = 1; off < 32; off <<= 1) { const float ov = __shfl_xor(bv, off); const int oi = __shfl_xor(bi, off); if (ov > bv || (ov == bv && oi < bi)) { bv = ov; bi = oi; } }
            tv[r] = bv; ti[r] = bi; if (e == bi) lg = -INFINITY; }
        const float e1 = __expf(tv[1] - tv[0]), e2 = __expf(tv[2] - tv[0]), e3 = __expf(tv[3] - tv[0]); const float inv = 1.0f / (1.0f + e1 + e2 + e3);
        const int my_e = e == 0 ? ti[0] : e == 1 ? ti[1] : e == 2 ? ti[2] : ti[3];
        const float my_w = (e == 0 ? 1.0f : e == 1 ? e1 : e == 2 ? e2 : e3) * inv;
        if (e < 4) { const int lr = atomicAdd((int*)&hist[my_e], 1); LAS unsigned* r = rec + (((ci & 3) * 64) + tl * 4 + e) * 4;
            r[0] = (unsigned)tok * 4u + (unsigned)e; r[1] = (unsigned)my_e; r[2] = __float_as_uint(my_w); r[3] = (unsigned)lr; }
        const bool lastc = ch + F.G >= NTOK / 16;
        if ((ci & 3) == 3 || lastc) {
            __syncthreads();
            if (tid < 32) { const int hcnt = hist[tid]; base[tid] = hcnt > 0 ? (int)__hip_atomic_fetch_add(counts + 64 * tid, (unsigned)hcnt, RLX_AGENT) : 0; }
            __syncthreads();
            const int nrec = ((ci & 3) + 1) * 64;
            if (tid < nrec) { const LAS unsigned* r = rec + tid * 4; const unsigned ts = r[0], ee = r[1], wb = r[2]; const int rank = base[ee] + (int)r[3];
                __hip_atomic_store((unsigned*)tokl + (size_t)ee * NTOK + rank, ts >> 2, RLX_AGENT); __hip_atomic_store((unsigned*)wl + (size_t)ee * NTOK + rank, wb, RLX_AGENT);
                slot[ts] = (ee << 16) | (unsigned)rank; }
        }
        __syncthreads();
    }
}

__device__ __forceinline__ void moe_tables(const Frame& F) {
    FRESH_TID();
    LAS int* tb = (LAS int*)(F.lds + LTAB_OFF); LAS int* cn = tb + 64;
    if (tid < 32) cn[tid] = (int)__hip_atomic_load(F.ctl + CW_CNT + 64 * tid, RLX_AGENT);
    __syncthreads();
    if (tid == 0) { int acc = 0;
        for (int e = 0; e < 32; ++e) { tb[e] = acc; acc += (cn[e] + 255) >> 8; }
        tb[32] = acc; }
    __syncthreads();
}
__device__ __forceinline__ void phase8(const Frame& F, const Args& A) {
    FRESH_TID();
    const int gw = F.c * NWAVES + F.wave, NGW = F.G * NWAVES;
    const LAS int* tb = (const LAS int*)(F.lds + LTAB_OFF);
    const unsigned* slot = (const unsigned*)(F.ws + WS_SLOT); const bf16_t* Y = (const bf16_t*)(F.ws + WS_YBUF); float* out = A.out;
    for (int tok = gw; tok < NTOK; tok += NGW) {
        const u32x4 sl = *(const u32x4*)(slot + (size_t)tok * 4);
        const size_t r0 = (size_t)tb[sl.x >> 16] * 256 + (sl.x & 0xffffu), r1 = (size_t)tb[sl.y >> 16] * 256 + (sl.y & 0xffffu), r2 = (size_t)tb[sl.z >> 16] * 256 + (sl.z & 0xffffu), r3 = (size_t)tb[sl.w >> 16] * 256 + (sl.w & 0xffffu);
        f32x4* xo = (f32x4*)(out + (size_t)tok * DM) + lane; const f32x4* xi = (const f32x4*)(A.in[I_X] + (size_t)tok * DM) + lane; const u32x2* at = (const u32x2*)((const bf16_t*)(F.ws + WS_H) + (size_t)tok * DM) + lane;
        const u32x2* y0 = (const u32x2*)(Y + r0 * DM) + lane; const u32x2* y1 = (const u32x2*)(Y + r1 * DM) + lane; const u32x2* y2 = (const u32x2*)(Y + r2 * DM) + lane; const u32x2* y3 = (const u32x2*)(Y + r3 * DM) + lane;
#pragma unroll
        for (int j = 0; j < 8; ++j) { f32x4 v = xi[64 * j]; const u32x2 t = at[64 * j]; v[0] += bf_lo(t.x); v[1] += bf_hi(t.x); v[2] += bf_lo(t.y); v[3] += bf_hi(t.y);
            const u32x2 a = y0[64 * j], b = y1[64 * j], c = y2[64 * j], d = y3[64 * j];
            v[0] += (bf_lo(a.x) + bf_lo(b.x)) + (bf_lo(c.x) + bf_lo(d.x)); v[1] += (bf_hi(a.x) + bf_hi(b.x)) + (bf_hi(c.x) + bf_hi(d.x));
            v[2] += (bf_lo(a.y) + bf_lo(b.y)) + (bf_lo(c.y) + bf_lo(d.y)); v[3] += (bf_hi(a.y) + bf_hi(b.y)) + (bf_hi(c.y) + bf_hi(d.y));
            xo[64 * j] = v; }
    }
}

constexpr int NPHASE = 10;
__global__ void __launch_bounds__(NWAVES * 64, 2) hybrid_fwd(Args args) {
    extern __shared__ __attribute__((aligned(16))) unsigned char lds[];
    Frame F;
    F.lds = (LAS unsigned char*)lds; F.ldsg = (char*)lds;
    F.wave = __builtin_amdgcn_readfirstlane((int)(threadIdx.x >> 6));
    F.G = gridDim.x; F.c = blockIdx.x;
    F.ws = args.ws; F.ctl = (unsigned*)(args.ws + WS_CTL);
    volatile LAS unsigned* MISC = (volatile LAS unsigned*)(F.lds + MISC_OFF);
    { const int l0 = fresh_lane(); if (F.wave == 0) MISC[l0] = 0u; }
    __syncthreads();
    XcdBarrier bar; bar.bar = F.ctl + CW_BAR; bar.x = 0; bar.st = nullptr;
    if (args.use_bar) bar = xcd_barrier_post(F.ctl + CW_BAR, MISC + 8, F.wave == 0 && fresh_lane() == 0);
    const int lo = args.ph_lo, hi = args.ph_hi;
#ifndef PHASE_MASK
#define PHASE_MASK 0x3ff
#endif
#define IN(k) ((((PHASE_MASK) >> (k)) & 1) && lo <= (k) && (k) < hi)
#ifndef DBL_MASK
#define DBL_MASK 0
#endif
#define DBL(k) (((DBL_MASK) >> (k)) & 1)
#define SEAM(k) do { if (IN(k) && IN((k) + 1)) xcd_barrier(bar, F.wave == 0 && fresh_lane() == 0); } while (0)

    if (IN(0)) { for (int rep = 0; rep <= DBL(0); ++rep) phase0(F, args); }
    SEAM(0);
    if (IN(1)) for (int rep = 0; rep <= DBL(1); ++rep) {
        pg8::DenseSched S; S.init(F.ws + WS_H, DM, F.ws + WS_WINT, NTOK, NINP, DM, F.G, F.c);
        epi::InProj E{(bf16_t*)(F.ws + WS_Q), (bf16_t*)(F.ws + WS_KV), (bf16_t*)(F.ws + WS_PIN), (float*)(F.ws + WS_GLOG)};
        pg8::gemm_phase(F.lds, S, E, DM * 2, F.wave);
        if (rep == 0) { if (F.G == 256) { if (F.c >= 192) posb_partials(F, args, F.c - 192, 64); } else posb_partials(F, args, F.c, F.G); }
    }
    SEAM(1);
    if (IN(2)) {
        const bool split = F.G >= 128;
        if (!split || F.c < 64) {
            pg8::CmpSched S{(const char*)(F.ws + WS_KV), (const char*)(F.ws + WS_W1T), split ? 64 : F.G, F.c};
            epi::CmpHid E{(float*)(F.ws + WS_ACT)};
            pg8::gemm_phase(F.lds, S, E, 8192, F.wave, 16);
        }
        if (!split || F.c >= 64) { const int ec = split ? F.c - 64 : F.c, eG = split ? F.G - 64 : F.G;
            if (ec == 0 && F.wave == 0) cmp_bias_total(F, args);
            norm_rope_rows(F, args, ec, eG); pool_diffs(F, ec, eG); }
    }
    SEAM(2);
    if (IN(3)) { for (int L = F.c; L < 256; L += F.G) cmp_layer2(F, args, L >> 7, L & 127); }
    SEAM(3);
    if (IN(4)) for (int rep = 0; rep <= DBL(4); ++rep) {
        { pg8::PoolSched S{(const char*)(F.ws + WS_DP), (const char*)(F.ws + WS_PWT), F.G, F.c};
          epi::Pool E{(bf16_t*)(F.ws + WS_MIX), args.in[I_POOLS]};
          pg8::gemm_phase(F.lds, S, E, 512, F.wave); }
        __syncthreads();
        att::Ptrs P{(const bf16_t*)(F.ws + WS_Q), (const bf16_t*)(F.ws + WS_KV), (const bf16_t*)(F.ws + WS_CMP), (const bf16_t*)(F.ws + WS_CMP + 512 * 1024),
                    (const float*)(F.ws + WS_GLOG), (bf16_t*)(F.ws + WS_MIX), (float*)(F.ws + WS_ASCR) + (size_t)F.c * 256 * 128};
        att::Conv cv = att::conv_init(args.in[I_WGU], args.in[I_WD], F.ws, F.c, F.G == 256 && rep == 0, F.wave);
        for (int r = 0;; ++r) { const int k = r * F.G + ((r & 1) ? (F.G - 1 - F.c) : F.c); if (k >= 512) break;
            const int qi = 127 - (k >> 2), bg = k & 3;
#if ATT_CHECK
            att::attn_item<0, false>(F.ldsg, P, bg >> 1, bg & 1, qi, F.wave, F.ctl + CW_ERR, cv); att::attn_item<1, true>(F.ldsg, P, bg >> 1, bg & 1, qi, F.wave, F.ctl + CW_ERR, cv);
#else
            att::attn_item<1, false>(F.ldsg, P, bg >> 1, bg & 1, qi, F.wave, F.ctl + CW_ERR, cv);
#endif
        }
        att::conv_tail(F.ldsg, cv, F.wave);
        __syncthreads();
    }
    SEAM(4);
    if (IN(5)) for (int rep = 0; rep <= DBL(5); ++rep) {
        pg8::DenseSched S; S.init(F.ws + WS_MIX, DM, F.ws + WS_WOUTT, NTOK, DM, DM, F.G, F.c);
        epi::OutProj E{(bf16_t*)(F.ws + WS_H)};
        pg8::gemm_phase(F.lds, S, E, DM * 2, F.wave);
    }
    SEAM(5);
    if (IN(6)) { phase5(F, args); }
    SEAM(6);
    if (IN(7)) for (int rep = 0; rep <= DBL(7); ++rep) {
        moe_tables(F);
        pg8::MoeSched<16, true> S{(const char*)(F.ws + WS_H2), (const char*)(F.ws + WS_WGU), (const int*)(F.ws + WS_TOKL), (const LAS int*)(F.lds + LTAB_OFF), (const LAS int*)(F.lds + LTAB_OFF) + 64, F.G, F.c, (size_t)4096 * 2048};
        epi::GateUp E{(unsigned char*)(F.ws + WS_ACT), args.in[I_BGU]};
        pg8::gemm_phase(F.lds, S, E, DM, F.wave);
    }
    SEAM(7);
    if (IN(8)) for (int rep = 0; rep <= DBL(8); ++rep) {
        moe_tables(F);
        pg8::MoeSched<8, false> S{(const char*)(F.ws + WS_ACT), (const char*)(F.ws + WS_WD), nullptr, (const LAS int*)(F.lds + LTAB_OFF), (const LAS int*)(F.lds + LTAB_OFF) + 64, F.G, F.c, (size_t)2048 * 2048};
        epi::Down E{(bf16_t*)(F.ws + WS_YBUF), args.in[I_BD], (const float*)(F.ws + WS_WL)};
        pg8::gemm_phase(F.lds, S, E, DFF, F.wave);
    }
    SEAM(8);
    if (IN(9)) { moe_tables(F); phase8(F, args);
#if ATT_CHECK
        if (__hip_atomic_load(F.ctl + CW_ERR, RLX_AGENT) != 0u && F.c == 0 && F.wave == 0) { VM_WAIT(); args.out[fresh_lane()] = __builtin_nanf(""); }
#endif
    }
#undef IN
#undef SEAM
}

#ifndef N_LAUNCH_MODE
#define N_LAUNCH_MODE 1
#endif
extern "C" void kernel_launch(void* const* d_in, const int* in_sizes, int n_in, void* d_out, int out_size, void* d_ws, size_t ws_size, hipStream_t stream) {
    static int grid = 0;
    if (grid == 0) {
        if (n_in != 27 || out_size != NTOK * DM || ws_size < WS_END) { fprintf(stderr, "kernel_launch: unexpected shapes (n_in %d out %d ws %zu)\n", n_in, out_size, ws_size); grid = -1; return; }
        int dev = 0, cus = 0, per_cu = 0;
        if (hipGetDevice(&dev) != hipSuccess || hipDeviceGetAttribute(&cus, hipDeviceAttributeMultiprocessorCount, dev) != hipSuccess) { grid = -1; return; }
        if (hipFuncSetAttribute((const void*)hybrid_fwd, hipFuncAttributeMaxDynamicSharedMemorySize, LDS_BYTES) != hipSuccess) { fprintf(stderr, "kernel_launch: hipFuncSetAttribute failed\n"); grid = -1; return; }
        if (hipOccupancyMaxActiveBlocksPerMultiprocessor(&per_cu, (const void*)hybrid_fwd, NWAVES * 64, LDS_BYTES) != hipSuccess || per_cu < 1) { fprintf(stderr, "kernel_launch: occupancy query says %d\n", per_cu); }
        (void)hipGetLastError();
        grid = cus;
    }
    if (grid < 0) return;
    (void)hipMemsetAsync((char*)d_ws + WS_CTL, 0, CTL_ZERO_BYTES, stream);
    Args a{};
    for (int i = 0; i < 27; ++i) a.in[i] = (const float*)d_in[i];
    a.out = (float*)d_out; a.ws = (unsigned char*)d_ws; a.pad = 0;
    if (N_LAUNCH_MODE == 1) {
        a.ph_lo = 0; a.ph_hi = NPHASE; a.use_bar = 1;
        hipLaunchKernelGGL(hybrid_fwd, dim3(grid), dim3(NWAVES * 64), LDS_BYTES, stream, a);
    } else {
        for (int p = 0; p < NPHASE; ++p) { a.ph_lo = p; a.ph_hi = p + 1; a.use_bar = 0;
            hipLaunchKernelGGL(hybrid_fwd, dim3(grid), dim3(NWAVES * 64), LDS_BYTES, stream, a); }
    }
}
```

```cpp
#include <hip/hip_runtime.h>
#include <cstdio>
#include <cstdint>

#define LAS __attribute__((address_space(3)))
#define GAS __attribute__((address_space(1)))
typedef unsigned short bf16_t;
typedef short bf16x8 __attribute__((ext_vector_type(8)));
typedef short s16x4 __attribute__((ext_vector_type(4)));
typedef float f32x4 __attribute__((ext_vector_type(4)));
typedef float f32x2 __attribute__((ext_vector_type(2)));
typedef float f32x16 __attribute__((ext_vector_type(16)));
typedef unsigned u32x4 __attribute__((ext_vector_type(4)));
typedef unsigned u32x2 __attribute__((ext_vector_type(2)));
typedef int i32x4 __attribute__((ext_vector_type(4)));
typedef int i32x8 __attribute__((ext_vector_type(8)));

constexpr int NB = 2, SEQ = 8192, NTOK = NB * SEQ, DM = 2048, NHEAD = 8, HD = 128, NGRP = 2, NEXP = 32, DFF = 2048;
constexpr int NINP = 3840;
constexpr int NCMP = 512;
constexpr int ACT_ROWS = 4 * NTOK + NEXP * 256;
constexpr int NWAVES = 8;

constexpr size_t MiB = 1u << 20;
constexpr size_t WS_CTL = 0, CTL_ZERO_BYTES = 1 * MiB;
constexpr size_t WS_COS = 1 * MiB, WS_SIN = 2 * MiB;
constexpr size_t WS_POSB64 = 2 * MiB + 655360;
constexpr size_t WS_POSB = 3 * MiB;
constexpr size_t WS_W2T = 3 * MiB + 65536;
constexpr size_t WS_WINT = 4 * MiB;
constexpr size_t WS_WOUTT = 20 * MiB;
constexpr size_t WS_W1T = 28 * MiB;
constexpr size_t WS_PWT = 32 * MiB;
constexpr size_t WS_H = 34 * MiB;
constexpr size_t WS_Q = 98 * MiB;
constexpr size_t WS_KV = 130 * MiB, KV_STRIDE = 9 * MiB;
constexpr size_t WS_PIN = 184 * MiB;
constexpr size_t WS_DP = 216 * MiB;
constexpr size_t WS_GLOG = 248 * MiB;
constexpr size_t WS_HID = 250 * MiB;
constexpr size_t WS_CMP = 252 * MiB;
constexpr size_t WS_MIX = 254 * MiB;
constexpr size_t WS_ASCR = 318 * MiB;
constexpr size_t WS_H2 = 350 * MiB;
constexpr size_t WS_SLOT = 414 * MiB;
constexpr size_t WS_TOKL = 415 * MiB;
constexpr size_t WS_WL = 417 * MiB;
constexpr size_t WS_ACT = 420 * MiB;
constexpr size_t WS_YBUF = 708 * MiB;
constexpr size_t WS_WGU = 1024 * MiB;
constexpr size_t WS_WD = 1536 * MiB;
constexpr size_t WS_END = 1792 * MiB;

constexpr int CW_BAR = 4096;
constexpr int CW_CNT = 8192;
constexpr int CW_ERR = 12288;
#ifndef ATT_CHECK
#define ATT_CHECK 0
#endif

constexpr int RING_BYTES = 131072;
constexpr int LTAB_OFF = 133120;
constexpr int SIDE_OFF = LTAB_OFF + 2048, SIDE_BYTES = 4096;
constexpr int MISC_OFF = LTAB_OFF + 24576;
constexpr int LDS_BYTES = MISC_OFF + 256;

#define RLX_AGENT __ATOMIC_RELAXED, __HIP_MEMORY_SCOPE_AGENT
#define LDS_WAIT() asm volatile("s_waitcnt lgkmcnt(0)" ::: "memory")
#define VM_WAIT() asm volatile("s_waitcnt vmcnt(0)" ::: "memory")
__device__ __forceinline__ unsigned cvt_pk_bf16(float lo, float hi) { unsigned r; asm volatile("v_cvt_pk_bf16_f32 %0, %1, %2" : "=v"(r) : "v"(lo), "v"(hi)); return r; }
__device__ __forceinline__ unsigned cvt_pk_bf16_mfma(float lo, float hi) { unsigned r; asm volatile("v_cvt_pk_bf16_f32 %0, %1, %2\n\ts_nop 1" : "=v"(r) : "v"(lo), "v"(hi)); return r; }
typedef short s16x2_t __attribute__((ext_vector_type(2)));
__device__ __forceinline__ unsigned pk4_fp8_div(float a, float b, float c, float d, float div) {
    s16x2_t r = __builtin_bit_cast(s16x2_t, a);
    r = __builtin_amdgcn_cvt_scalef32_pk_fp8_f32(r, a, b, div, false); r = __builtin_amdgcn_cvt_scalef32_pk_fp8_f32(r, c, d, div, true);
    return __builtin_bit_cast(unsigned, r); }
__device__ __forceinline__ float bf_lo(unsigned u) { return __uint_as_float(u << 16); }
__device__ __forceinline__ float bf_hi(unsigned u) { return __uint_as_float(u & 0xffff0000u); }
__device__ __forceinline__ float fast_exp2(float x) { return __builtin_amdgcn_exp2f(x); }
__device__ __forceinline__ float fast_rcp(float x) { return __builtin_amdgcn_rcpf(x); }
__device__ __forceinline__ float sigmoidf_(float x) { return fast_rcp(1.0f + fast_exp2(-1.4426950408889634f * x)); }
__device__ __forceinline__ float wave_sum(float v) {
#define WS_STEP(ctrl, rmask) v += __int_as_float(__builtin_amdgcn_update_dpp(0, __float_as_int(v), ctrl, rmask, 0xf, false))
    WS_STEP(0x111, 0xf); WS_STEP(0x112, 0xf); WS_STEP(0x114, 0xf); WS_STEP(0x118, 0xf); WS_STEP(0x142, 0xa); WS_STEP(0x143, 0xc);
#undef WS_STEP
    return __int_as_float(__builtin_amdgcn_readlane(__float_as_int(v), 63));
}
__device__ __forceinline__ int fresh_lane() { int l; asm volatile("v_mbcnt_lo_u32_b32 %0, -1, 0\n\tv_mbcnt_hi_u32_b32 %0, -1, %0" : "=v"(l)); return l; }

#define XB_TMO      128
#define XB_XCNT(j)  (256  + 64 * (j))
#define XB_XSUB(j)  (1280 + 64 * (j))
#define XB_XGEN(j)  (2304 + 64 * (j))
#define XB_TOP      3328
#define XB_TOPGEN   3392
#define XCD_BAR_WORDS 3456
#define XB_SPIN_CAP (1u << 20)
__device__ __forceinline__ unsigned xb_ld(unsigned* p)              { return __hip_atomic_load(p, __ATOMIC_RELAXED, __HIP_MEMORY_SCOPE_AGENT); }
__device__ __forceinline__ unsigned xb_add(unsigned* p, unsigned v) { return __hip_atomic_fetch_add(p, v, __ATOMIC_RELAXED, __HIP_MEMORY_SCOPE_AGENT); }
__device__ __forceinline__ unsigned xb_xcc_id() { return (unsigned)__builtin_amdgcn_s_getreg((3 << 11) | 20) & 0xFu; }
#define XB_SPIN(cond, bar) do { unsigned _sp = 0; while (cond) { __builtin_amdgcn_s_sleep(1); \
    if ((++_sp & 255u) == 0u) { if (xb_ld(&(bar)[XB_TMO])) break; if (_sp > XB_SPIN_CAP) { atomicAdd(&(bar)[XB_TMO], 1u); break; } } } } while (0)
struct XcdBarrier { unsigned* bar; unsigned x; volatile LAS unsigned* st; };
__device__ __forceinline__ XcdBarrier xcd_barrier_post(unsigned* bar, volatile LAS unsigned* st, bool t0) {
    XcdBarrier b; b.bar = bar; b.x = xb_xcc_id(); b.st = st;
    if (t0) (void)xb_add(&bar[XB_XCNT(b.x)], 1u);
    return b;
}
__device__ __forceinline__ void xcd_barrier_complete(unsigned* bar, unsigned x, unsigned& nloc, unsigned& nx) {
    const unsigned G = gridDim.x * gridDim.y * gridDim.z;
    unsigned sum, cnt, mine, sp = 0u;
    for (;;) {
        sum = 0u; cnt = 0u; mine = 0u;
#pragma unroll
        for (unsigned j = 0; j < 16; ++j) { const unsigned c = xb_ld(&bar[XB_XCNT(j)]); sum += c; cnt += (c > 0u) ? 1u : 0u; mine = (j == x) ? c : mine; }
        if (sum == G) break;
        __builtin_amdgcn_s_sleep(1);
        if ((++sp & 255u) == 0u) { if (xb_ld(&bar[XB_TMO])) break; if (sp > XB_SPIN_CAP) { atomicAdd(&bar[XB_TMO], 1u); break; } }
    }
    nloc = mine > 0u ? mine : 1u; nx = cnt > 0u ? cnt : 1u;
}
__device__ __forceinline__ void xcd_barrier(const XcdBarrier& b, bool t0) {
    asm volatile("s_waitcnt vmcnt(0)" ::: "memory");
    __syncthreads();
    if (t0) {
        unsigned* bar = b.bar;
        __builtin_amdgcn_s_waitcnt(0);
        unsigned nloc = b.st[0], nx = b.st[1];
        if (nloc == 0u) { xcd_barrier_complete(bar, b.x, nloc, nx); b.st[0] = nloc; b.st[1] = nx; }
        const unsigned old = xb_add(&bar[XB_XSUB(b.x)], 1u);
        const unsigned gen = old / nloc;
        if (old + 1u == (gen + 1u) * nloc) {
            __builtin_amdgcn_fence(__ATOMIC_RELEASE, "agent");
            asm volatile("s_waitcnt vmcnt(0)" ::: "memory");
            const unsigned og = xb_add(&bar[XB_TOP], 1u);
            const unsigned tg = og / nx;
            if (og + 1u == (tg + 1u) * nx) xb_add(&bar[XB_TOPGEN], 1u);
            else XB_SPIN(xb_ld(&bar[XB_TOPGEN]) == tg, bar);
            __builtin_amdgcn_fence(__ATOMIC_ACQUIRE, "agent");
            xb_add(&bar[XB_XGEN(b.x)], 1u);
            asm volatile("s_waitcnt vmcnt(0)" ::: "memory");
        } else {
            XB_SPIN(xb_ld(&bar[XB_XGEN(b.x)]) == gen, bar);
            __builtin_amdgcn_fence(__ATOMIC_ACQUIRE, "agent");
            asm volatile("s_waitcnt vmcnt(0)" ::: "memory");
        }
    }
    __syncthreads();
}

struct Args {
    const float* in[27];
    float* out;
    unsigned char* ws;
    int ph_lo, ph_hi;
    int use_bar, pad;
};
enum { I_X = 0, I_N1G, I_WIN, I_QNG, I_KNC, I_KNS, I_KNW, I_CKPOS, I_CKW1, I_CKB1, I_CKW2, I_CKB2, I_CVPOS, I_CVW1, I_CVB1, I_CVW2, I_CVB2,
       I_POOLW, I_POOLS, I_WOUT, I_N2G, I_WR, I_BR, I_WGU, I_BGU, I_WD, I_BD };

#ifndef EPI_DBL_MASK
#define EPI_DBL_MASK 0
#endif
namespace pg8 {
constexpr int BM = 256, BK = 64, HALF = 128, HTB = HALF * BK * 2, STAGE_BYTES = 8 * HTB, NXCD = 8, WGM = 8;
__host__ __device__ __forceinline__ int lds_byte(int r, int c) { const int st = (r >> 4) * 2 + (c >> 5), rr = r & 15, cc = c & 31, ob = rr * 64 + cc * 2; return st * 1024 + (ob ^ (((ob >> 9) & 1) << 5)); }
__host__ __device__ __forceinline__ void stage_rc(int b, int& R, int& C) { const int st = b / 1024, sb = b % 1024, swz = sb ^ (((sb >> 9) & 1) << 5); R = (st >> 1) * 16 + swz / 64; C = (st & 1) * 32 + (swz % 64) / 2; }
__host__ __device__ __forceinline__ int perm32(int rho) { const int n = rho >> 4, i = rho & 15; return 8 * (i >> 2) + 4 * n + (i & 3); }

template <class Epi, class Sched>
__device__ __forceinline__ void gemm_phase(LAS unsigned char* lds, const Sched& S, const Epi& E, const int Kb  , const int wid, const int ntiles = 0  ) {
    const int lane = fresh_lane(), tid = wid * 64 + lane, wr = wid >> 2, wc = wid & 3, fr = lane & 15, fq = lane >> 4;
    const int nt = ntiles ? ntiles : Kb / 128;
    constexpr int BR = Sched::B_K16;
    int Rr[2], Cc[2]; unsigned voffB[2];
#pragma unroll
    for (int i = 0; i < 2; ++i) { int R, C; stage_rc(tid * 16 + i * 8192, R, C); Rr[i] = R; Cc[i] = C; const int Rb = Epi::PERM ? ((R & ~31) + perm32(R & 31)) : R; voffB[i] = BR ? (unsigned)(((C >> 3) * BR + Rb) * 16) : (unsigned)(Rb * Kb) + (unsigned)C * 2u; }
    const size_t kstep = (size_t)(BK * 2);
    const size_t kstepB = BR ? (size_t)8 * BR * 16 : kstep;
    const size_t hstepB = BR ? (size_t)HALF * 16 : (size_t)HALF * Kb;
    const unsigned ldsw = (unsigned)wid * 1024u;
    const int aoff = lds_byte(wr * 64 + fr, fq * 8), boff = lds_byte(wc * 32 + fr, fq * 8);
    const char* const Ab = S.a_base();
#define PG8_SA(b, h) (((b) * 2 + (h)) * HTB)
#define PG8_SB(b, h) ((4 + (b) * 2 + (h)) * HTB)
#define PG8_STAGE(bufoff, gbase, voff) do { _Pragma("unroll") for (int _i = 0; _i < 2; ++_i) \
        __builtin_amdgcn_global_load_lds((const unsigned*)((const char*)(gbase) + (voff)[_i]), (LAS unsigned*)(lds + (bufoff) + ldsw + _i * 8192), 16, 0, 0); } while (0)
#define PG8_LDA(dst, b, h) do { _Pragma("unroll") for (int m = 0; m < 4; ++m) _Pragma("unroll") for (int k = 0; k < 2; ++k) dst[m][k] = *(const LAS bf16x8*)(lds + PG8_SA(b, h) + aoff + m * 2048 + k * 1024); } while (0)
#define PG8_LDB(dst, b, h) do { _Pragma("unroll") for (int n = 0; n < 2; ++n) _Pragma("unroll") for (int k = 0; k < 2; ++k) dst[n][k] = *(const LAS bf16x8*)(lds + PG8_SB(b, h) + boff + n * 2048 + k * 1024); } while (0)
#define PG8_MMA(ai, bj, At, Bt) do { __builtin_amdgcn_s_setprio(1); \
        if constexpr (Epi::FP8) { _Pragma("unroll") for (int m = 0; m < 4; ++m) _Pragma("unroll") for (int n = 0; n < 2; ++n) { \
            const i32x8 _b = __builtin_shufflevector(__builtin_bit_cast(i32x4, Bt[n][0]), __builtin_bit_cast(i32x4, Bt[n][1]), 0, 1, 2, 3, 4, 5, 6, 7); \
            const i32x8 _a = __builtin_shufflevector(__builtin_bit_cast(i32x4, At[m][0]), __builtin_bit_cast(i32x4, At[m][1]), 0, 1, 2, 3, 4, 5, 6, 7); \
            acc[ai][bj][m][n] = __builtin_amdgcn_mfma_scale_f32_16x16x128_f8f6f4(_b, _a, acc[ai][bj][m][n], 0, 0, 0, 0x7f7f7f7f, 0, 0x7f7f7f7f); } } \
        else { _Pragma("unroll") for (int m = 0; m < 4; ++m) _Pragma("unroll") for (int n = 0; n < 2; ++n) _Pragma("unroll") for (int k = 0; k < 2; ++k) \
            acc[ai][bj][m][n] = __builtin_amdgcn_mfma_f32_16x16x32_bf16(Bt[n][k], At[m][k], acc[ai][bj][m][n], 0, 0, 0); } \
        __builtin_amdgcn_s_setprio(0); } while (0)
#define PG8_WAIT_V(n) asm volatile("s_waitcnt vmcnt(" #n ")" ::: "memory")
#define PG8_WAIT_L(n) asm volatile("s_waitcnt lgkmcnt(" #n ")" ::: "memory")
#define PG8_BAR __builtin_amdgcn_s_barrier()
#define PG8_SCHED __builtin_amdgcn_sched_barrier(0)
    typename Sched::Unit cur, nxt; int ui = 0;
    if (!S.next(0, cur)) return;
    f32x4 acc[2][2][4][2];
#pragma unroll
    for (int a = 0; a < 2; ++a)
#pragma unroll
        for (int b = 0; b < 2; ++b)
#pragma unroll
            for (int m = 0; m < 4; ++m)
#pragma unroll
                for (int n = 0; n < 2; ++n) acc[a][b][m][n] = (f32x4){0.f, 0.f, 0.f, 0.f};
    bf16x8 At[4][2], B0[2][2], B1[2][2];
    unsigned offA0[2], offA1[2], nofA0[2], nofA1[2];
#pragma unroll
    for (int i = 0; i < 2; ++i) { offA0[i] = S.a_off(cur, Rr[i], Cc[i]); offA1[i] = S.a_off(cur, HALF + Rr[i], Cc[i]); nofA0[i] = offA0[i]; nofA1[i] = offA1[i]; }
    const char* cB = S.b_ptr(cur);
    PG8_STAGE(PG8_SB(0, 0), cB, voffB); PG8_STAGE(PG8_SA(0, 0), Ab, offA0); PG8_STAGE(PG8_SB(0, 1), cB + hstepB, voffB); PG8_STAGE(PG8_SA(0, 1), Ab, offA1);
    if (wr == 1) PG8_BAR;
    PG8_WAIT_V(4); PG8_BAR;
    PG8_STAGE(PG8_SB(1, 0), cB + kstepB, voffB); PG8_STAGE(PG8_SA(1, 0), Ab + kstep, offA0); PG8_STAGE(PG8_SB(1, 1), cB + hstepB + kstepB, voffB);
    PG8_WAIT_V(6); PG8_BAR;
    for (;;) {
        const bool has_next = S.next(ui + 1, nxt);
        const char* nB = has_next ? S.b_ptr(nxt) : cB;
        if (has_next) {
            if constexpr (Sched::SIDE_IDX) S.stage_idx(lds, nxt, (ui + 1) & 1, wid, lane);
            else {
#pragma unroll
                for (int i = 0; i < 2; ++i) { nofA0[i] = S.a_off(nxt, Rr[i], Cc[i]); nofA1[i] = S.a_off(nxt, HALF + Rr[i], Cc[i]); }
            }
        }
        E.stage(lds, cur, ui & 1, wid, lane);
        for (int t = 0; t < nt; t += 2) {
            const bool last = (t == nt - 2);
            const char* a1 = Ab + (size_t)(t + 1) * kstep;
            PG8_LDB(B0, 0, 0); PG8_SCHED; PG8_LDA(At, 0, 0); PG8_STAGE(PG8_SA(1, 1), a1, offA1);
            if (last) {
                if constexpr (Sched::SIDE_IDX) { if (has_next) {
#pragma unroll
                    for (int i = 0; i < 2; ++i) { nofA0[i] = S.a_off_lds(lds, nxt, (ui + 1) & 1, Rr[i], Cc[i]); nofA1[i] = S.a_off_lds(lds, nxt, (ui + 1) & 1, HALF + Rr[i], Cc[i]); } } }
#pragma unroll
                for (int i = 0; i < 2; ++i) { offA0[i] = nofA0[i]; offA1[i] = nofA1[i]; }
            }
            const char* a2 = last ? Ab : Ab + (size_t)(t + 2) * kstep; const char* b2 = last ? nB : cB + (size_t)(t + 2) * kstepB;
            const char* a3 = a2 + kstep; const char* b3 = b2 + kstepB;
            PG8_WAIT_L(8); PG8_BAR; PG8_WAIT_L(0); PG8_MMA(0, 0, At, B0); PG8_BAR; PG8_SCHED;
            PG8_LDB(B1, 0, 1); PG8_STAGE(PG8_SB(0, 0), b2, voffB);
            PG8_BAR; PG8_WAIT_L(0); PG8_MMA(0, 1, At, B1); PG8_BAR;
            PG8_LDA(At, 0, 1); PG8_STAGE(PG8_SA(0, 0), a2, offA0);
            PG8_BAR; PG8_WAIT_L(0); PG8_MMA(1, 0, At, B0); PG8_BAR; PG8_SCHED;
            PG8_STAGE(PG8_SB(0, 1), b2 + hstepB, voffB);
            PG8_WAIT_V(6); PG8_BAR; PG8_MMA(1, 1, At, B1); PG8_BAR;
            PG8_LDB(B0, 1, 0); PG8_SCHED; PG8_LDA(At, 1, 0); PG8_STAGE(PG8_SA(0, 1), a2, offA1);
            PG8_WAIT_L(8); PG8_BAR; PG8_WAIT_L(0); PG8_MMA(0, 0, At, B0); PG8_BAR; PG8_SCHED;
            PG8_LDB(B1, 1, 1); PG8_STAGE(PG8_SB(1, 0), b3, voffB);
            PG8_BAR; PG8_WAIT_L(0); PG8_MMA(0, 1, At, B1); PG8_BAR;
            PG8_LDA(At, 1, 1); PG8_STAGE(PG8_SA(1, 0), a3, offA0);
            PG8_BAR; PG8_WAIT_L(0); PG8_MMA(1, 0, At, B0); PG8_BAR; PG8_SCHED;
            PG8_STAGE(PG8_SB(1, 1), b3 + hstepB, voffB);
            PG8_WAIT_V(6); PG8_BAR; PG8_MMA(1, 1, At, B1); PG8_BAR;
        }
        E(acc, cur, wr, wc, fr, fq, lds, ui & 1);
        if constexpr ((EPI_DBL_MASK & Epi::ID) != 0) E(acc, cur, wr, wc, fr, fq, lds, ui & 1);
        if (!has_next) break;
#pragma unroll
        for (int a = 0; a < 2; ++a)
#pragma unroll
            for (int b = 0; b < 2; ++b)
#pragma unroll
                for (int m = 0; m < 4; ++m)
#pragma unroll
                    for (int n = 0; n < 2; ++n) acc[a][b][m][n] = (f32x4){0.f, 0.f, 0.f, 0.f};
        cur = nxt; cB = nB; ++ui;
    }
    PG8_WAIT_V(0);
    if (wr == 0) PG8_BAR;
    PG8_BAR;
#undef PG8_SA
#undef PG8_SB
#undef PG8_STAGE
#undef PG8_LDA
#undef PG8_LDB
#undef PG8_MMA
#undef PG8_WAIT_V
#undef PG8_WAIT_L
#undef PG8_BAR
#undef PG8_SCHED
}

struct DUnit { int pm, pn; };
struct DenseSched {
    typedef DUnit Unit; static constexpr bool SIDE_IDX = false; static constexpr int B_K16 = 0;
    const char* A; unsigned lda2; const char* Bt; int K; int nM, nN, nwg, G, c;
    __device__ __forceinline__ void init(const void* A_, int lda, const void* Bt_, int M, int N, int K_, int G_, int c_) { A = (const char*)A_; lda2 = (unsigned)lda * 2u; Bt = (const char*)Bt_; K = K_; nM = M / BM; nN = N / BM; nwg = nM * nN; G = G_; c = c_; }
    __device__ __forceinline__ bool next(int i, Unit& u) const {
        const long L = (long)i * G + c; if (L >= nwg) return false;
        int wgid = (int)L; { const int q = nwg / NXCD, r = nwg % NXCD, xcd = wgid % NXCD, off = wgid / NXCD; wgid = (xcd < r ? xcd * (q + 1) : r * (q + 1) + (xcd - r) * q) + off; }
        const int nig = WGM * nN, gid = wgid / nig, fm = gid * WGM, gsz = (nM - fm) < WGM ? (nM - fm) : WGM;
        u.pm = fm + ((wgid % nig) % gsz); u.pn = (wgid % nig) / gsz; return true;
    }
    __device__ __forceinline__ const char* a_base() const { return A; }
    __device__ __forceinline__ unsigned a_off(const Unit& u, int r, int C) const { return (unsigned)(u.pm * BM + r) * lda2 + (unsigned)C * 2u; }
    __device__ __forceinline__ const char* b_ptr(const Unit& u) const { return Bt + (size_t)u.pn * BM * K * 2; }
};
}

namespace epi {
using pg8::BM; using pg8::HALF;
struct InProj {
    __device__ __forceinline__ void stage(LAS unsigned char*, const pg8::DUnit&, int, int, int) const {}
    static constexpr bool PERM = true; static constexpr int ID = 1; static constexpr bool FP8 = false;
    bf16_t* Q; bf16_t* KV; bf16_t* PIN; float* GLOG;
    __device__ __forceinline__ void operator()(const f32x4 (&acc)[2][2][4][2], const pg8::DUnit& u, int wr, int wc, int fr, int fq, LAS unsigned char*, int) const {
        const int row0 = u.pm * BM + wr * 64 + fr, cw = wc * 32 + 8 * fq;
#pragma unroll
        for (int ai = 0; ai < 2; ++ai)
#pragma unroll
            for (int m = 0; m < 4; ++m) {
                const int row = row0 + ai * HALF + m * 16;
#pragma unroll
                for (int bj = 0; bj < 2; ++bj) {
                    const f32x4 v0 = acc[ai][bj][m][0], v1 = acc[ai][bj][m][1];
                    if (u.pn == 14) {
                        if (bj == 0 && cw < 24) { float* g = GLOG + (size_t)row * 32 + cw; *(f32x4*)g = v0; *(f32x4*)(g + 4) = v1; }
                    } else {
                        u32x4 w; w.x = cvt_pk_bf16(v0[0], v0[1]); w.y = cvt_pk_bf16(v0[2], v0[3]); w.z = cvt_pk_bf16(v1[0], v1[1]); w.w = cvt_pk_bf16(v1[2], v1[3]);
                        bf16_t* dst;
                        if (u.pn < 4) dst = Q + (size_t)row * 1024 + u.pn * 256 + bj * 128 + cw;
                        else if (u.pn < 10) { const int b = row >> 13, s = row & 8191; dst = KV + (size_t)(u.pn - 4) * (KV_STRIDE / 2) + ((size_t)((b * 2 + bj) * SEQ + s)) * 128 + cw; }
                        else dst = PIN + (size_t)row * 1024 + (u.pn - 10) * 256 + bj * 128 + cw;
                        *(u32x4*)dst = w;
                    }
                }
            }
    }
};
struct CUnit { int kv, pm, ks; };
struct CmpHid {
    __device__ __forceinline__ void stage(LAS unsigned char*, const CUnit&, int, int, int) const {}
    static constexpr bool PERM = false; static constexpr int ID = 2; static constexpr bool FP8 = false;
    float* HIDP;
    __device__ __forceinline__ void operator()(const f32x4 (&acc)[2][2][4][2], const CUnit& u, int wr, int wc, int fr, int fq, LAS unsigned char*, int) const {
        const int row0 = u.pm * BM + wr * 64 + fr, col0 = wc * 32 + 4 * fq;
        float* base = HIDP + ((size_t)(u.ks * 2 + u.kv) * 2048) * 256;
#pragma unroll
        for (int ai = 0; ai < 2; ++ai)
#pragma unroll
            for (int m = 0; m < 4; ++m) { float* rowp = base + (size_t)(row0 + ai * HALF + m * 16) * 256 + col0;
#pragma unroll
                for (int bj = 0; bj < 2; ++bj)
#pragma unroll
                    for (int n = 0; n < 2; ++n) *(f32x4*)(rowp + bj * HALF + n * 16) = acc[ai][bj][m][n]; }
    }
};
struct PUnit { int g, pm; };
struct Pool {
    __device__ __forceinline__ void stage(LAS unsigned char*, const PUnit&, int, int, int) const {}
    static constexpr bool PERM = true; static constexpr int ID = 4; static constexpr bool FP8 = false;
    bf16_t* MIX; const float* scale;
    __device__ __forceinline__ void operator()(const f32x4 (&acc)[2][2][4][2], const PUnit& u, int wr, int wc, int fr, int fq, LAS unsigned char*, int) const {
        const int row0 = u.pm * BM + wr * 64 + fr, cw = wc * 32 + 8 * fq;
        float sc[2][8];
#pragma unroll
        for (int bj = 0; bj < 2; ++bj)
#pragma unroll
            for (int j = 0; j < 8; ++j) sc[bj][j] = scale[u.g * 256 + bj * 128 + cw + j];
#pragma unroll
        for (int ai = 0; ai < 2; ++ai)
#pragma unroll
            for (int m = 0; m < 4; ++m) {
                const int row = row0 + ai * HALF + m * 16;
#pragma unroll
                for (int bj = 0; bj < 2; ++bj) {
                    float v[8];
#pragma unroll
                    for (int j = 0; j < 8; ++j) v[j] = acc[ai][bj][m][j >> 2][j & 3] * sc[bj][j];
                    u32x4 w; w.x = cvt_pk_bf16(v[0], v[1]); w.y = cvt_pk_bf16(v[2], v[3]); w.z = cvt_pk_bf16(v[4], v[5]); w.w = cvt_pk_bf16(v[6], v[7]);
                    *(u32x4*)(MIX + (size_t)row * 2048 + 1024 + u.g * 256 + bj * 128 + cw) = w;
                }
            }
    }
};
struct OutProj {
    __device__ __forceinline__ void stage(LAS unsigned char*, const pg8::DUnit&, int, int, int) const {}
    static constexpr bool PERM = true; static constexpr int ID = 8; static constexpr bool FP8 = false;
    bf16_t* ATT;
    __device__ __forceinline__ void operator()(const f32x4 (&acc)[2][2][4][2], const pg8::DUnit& u, int wr, int wc, int fr, int fq, LAS unsigned char*, int) const {
        const int row0 = u.pm * BM + wr * 64 + fr, cw = u.pn * BM + wc * 32 + 8 * fq;
#pragma unroll
        for (int ai = 0; ai < 2; ++ai)
#pragma unroll
            for (int m = 0; m < 4; ++m) { bf16_t* rowp = ATT + (size_t)(row0 + ai * HALF + m * 16) * DM + cw;
#pragma unroll
                for (int bj = 0; bj < 2; ++bj) { const f32x4 v0 = acc[ai][bj][m][0], v1 = acc[ai][bj][m][1];
                    u32x4 w; w.x = cvt_pk_bf16(v0[0], v0[1]); w.y = cvt_pk_bf16(v0[2], v0[3]); w.z = cvt_pk_bf16(v1[0], v1[1]); w.w = cvt_pk_bf16(v1[2], v1[3]);
                    *(u32x4*)(rowp + bj * HALF) = w; } }
    }
};
struct MUnit { int e, pm, pn, rowbase, cnt; };
constexpr float W8_SCALE = 64.0f, W8_INV = 1.0f / 64.0f;
struct GateUp {
    static constexpr bool PERM = true; static constexpr int ID = 16; static constexpr bool FP8 = true;
    unsigned char* ACT; const float* bgu;
    __device__ __forceinline__ void stage(LAS unsigned char* lds, const MUnit& u, int par, int wid, int lane) const {
        if (wid < 4) { const float* src = bgu + (size_t)u.e * 4096 + (wid >> 1) * 2048 + u.pn * 128 + (wid & 1) * 64 + lane;
            __builtin_amdgcn_global_load_lds((const unsigned*)src, (LAS unsigned*)(lds + SIDE_OFF + par * SIDE_BYTES + 1024 + wid * 256), 4, 0, 0); }
    }
    __device__ __forceinline__ void operator()(const f32x4 (&acc)[2][2][4][2], const MUnit& u, int wr, int wc, int fr, int fq, LAS unsigned char* lds, int par) const {
        const int row0 = u.rowbase + wr * 64 + fr, cw = wc * 32 + 8 * fq, j0 = u.pn * 128 + cw;
        float bg[8], bu[8];
        { const LAS f32x4* sb = (const LAS f32x4*)(lds + SIDE_OFF + par * SIDE_BYTES + 1024);
          const f32x4 g0 = sb[cw >> 2], g1 = sb[(cw >> 2) + 1], u0 = sb[32 + (cw >> 2)], u1 = sb[33 + (cw >> 2)];
#pragma unroll
          for (int j = 0; j < 4; ++j) { bg[j] = g0[j]; bg[4 + j] = g1[j]; bu[j] = u0[j]; bu[4 + j] = u1[j]; } }
#pragma unroll
        for (int ai = 0; ai < 2; ++ai)
#pragma unroll
            for (int m = 0; m < 4; ++m) {
                const int row = row0 + ai * HALF + m * 16;
                float v[8];
#pragma unroll
                for (int j = 0; j < 8; ++j) {
                    float g = fmaf(acc[ai][0][m][j >> 2][j & 3], W8_INV, bg[j]), up = fmaf(acc[ai][1][m][j >> 2][j & 3], W8_INV, bu[j]);
                    g = fminf(g, 7.0f); up = fminf(fmaxf(up, -7.0f), 7.0f);
                    v[j] = (up + 1.0f) * g * fast_rcp(1.0f + fast_exp2(-2.4554669595930157f * g));
                }
                u32x2 w; int p = __builtin_amdgcn_cvt_pk_fp8_f32(v[0], v[1], 0, false); p = __builtin_amdgcn_cvt_pk_fp8_f32(v[2], v[3], p, true); w.x = (unsigned)p;
                p = __builtin_amdgcn_cvt_pk_fp8_f32(v[4], v[5], 0, false); p = __builtin_amdgcn_cvt_pk_fp8_f32(v[6], v[7], p, true); w.y = (unsigned)p;
                *(u32x2*)(ACT + (size_t)row * 2048 + j0) = w;
            }
    }
};
constexpr float Y8_DIV = 0.125f, Y8_INV = 0.125f;
struct Down {
    static constexpr bool PERM = true; static constexpr int ID = 32; static constexpr bool FP8 = true;
    unsigned char* YBUF; const float* bd; const float* WL;
    __device__ __forceinline__ void stage(LAS unsigned char* lds, const MUnit& u, int par, int wid, int lane) const {
        const float* src = wid < 4 ? bd + (size_t)u.e * 2048 + u.pn * 256 + wid * 64 + lane : WL + (size_t)u.e * NTOK + u.pm * 256 + (wid - 4) * 64 + lane;
        __builtin_amdgcn_global_load_lds((const unsigned*)src, (LAS unsigned*)(lds + SIDE_OFF + par * SIDE_BYTES + 1024 + wid * 256), 4, 0, 0);
    }
    __device__ __forceinline__ void operator()(const f32x4 (&acc)[2][2][4][2], const MUnit& u, int wr, int wc, int fr, int fq, LAS unsigned char* lds, int par) const {
        const int rl0 = wr * 64 + fr, cw = wc * 32 + 8 * fq;
        float bias[2][8];
        const LAS f32x4* sb = (const LAS f32x4*)(lds + SIDE_OFF + par * SIDE_BYTES + 1024);
        const LAS float* sw = (const LAS float*)(lds + SIDE_OFF + par * SIDE_BYTES + 2048);
#pragma unroll
        for (int bj = 0; bj < 2; ++bj) { const f32x4 b0 = sb[bj * 32 + (cw >> 2)], b1 = sb[bj * 32 + (cw >> 2) + 1];
#pragma unroll
            for (int j = 0; j < 4; ++j) { bias[bj][j] = b0[j]; bias[bj][4 + j] = b1[j]; } }
#pragma unroll
        for (int ai = 0; ai < 2; ++ai)
#pragma unroll
            for (int m = 0; m < 4; ++m) {
                const float wt = sw[rl0 + ai * HALF + m * 16];
                const size_t row = (size_t)(u.rowbase + rl0 + ai * HALF + m * 16);
#pragma unroll
                for (int bj = 0; bj < 2; ++bj) {
                    float v[8];
#pragma unroll
                    for (int j = 0; j < 8; ++j) v[j] = fmaf(acc[ai][bj][m][j >> 2][j & 3], W8_INV, bias[bj][j]) * wt;
                    u32x2 w; w.x = pk4_fp8_div(v[0], v[1], v[2], v[3], Y8_DIV); w.y = pk4_fp8_div(v[4], v[5], v[6], v[7], Y8_DIV);
                    *(u32x2*)(YBUF + row * 2048 + u.pn * 256 + bj * 128 + cw) = w;
                }
            }
    }
};
}

namespace pg8 {
struct CmpSched {
    typedef epi::CUnit Unit; static constexpr bool SIDE_IDX = false; static constexpr int B_K16 = 0;
    const char* A; const char* Bt; int G, c;
    __device__ __forceinline__ bool next(int i, Unit& u) const { const int L = i * G + c; if (L >= 64) return false; u.kv = L >> 5; u.pm = (L >> 2) & 7; u.ks = L & 3; return true; }
    __device__ __forceinline__ const char* a_base() const { return A; }
    __device__ __forceinline__ unsigned a_off(const Unit& u, int r, int C) const { return (unsigned)(u.kv * (int)KV_STRIDE) + (unsigned)(u.pm * BM + r) * 4096u + (unsigned)u.ks * 2048u + (unsigned)C * 2u; }
    __device__ __forceinline__ const char* b_ptr(const Unit& u) const { return Bt + (size_t)u.kv * 256 * 4096 * 2 + (size_t)u.ks * 2048; }
};
struct PoolSched {
    typedef epi::PUnit Unit; static constexpr bool SIDE_IDX = false; static constexpr int B_K16 = 0;
    const char* A; const char* Bt; int G, c;
    __device__ __forceinline__ bool next(int i, Unit& u) const { const int L = i * G + c; if (L >= 256) return false; u.g = L >> 6; u.pm = L & 63; return true; }
    __device__ __forceinline__ const char* a_base() const { return A; }
    __device__ __forceinline__ unsigned a_off(const Unit& u, int r, int C) const { return (unsigned)(u.pm * BM + r) * 2048u + (unsigned)(u.g * 256 + C) * 2u; }
    __device__ __forceinline__ const char* b_ptr(const Unit& u) const { return Bt + (size_t)u.g * 256 * 256 * 2; }
};
template <int NTN, bool GATHER>
struct MoeSched {
    typedef epi::MUnit Unit; static constexpr bool SIDE_IDX = GATHER; static constexpr int B_K16 = NTN * 256;
    __device__ __forceinline__ void stage_idx(LAS unsigned char* lds, const Unit& u, int par, int wid, int lane) const {
        if (wid >= 4) __builtin_amdgcn_global_load_lds((const unsigned*)(tokl + (size_t)u.e * NTOK + u.pm * 256 + (wid - 4) * 64 + lane), (LAS unsigned*)(lds + SIDE_OFF + par * SIDE_BYTES + (wid - 4) * 256), 4, 0, 0);
    }
    __device__ __forceinline__ unsigned a_off_lds(LAS unsigned char* lds, const Unit& u, int par, int r, int C) const {
        const unsigned tok = ((const LAS unsigned*)(lds + SIDE_OFF + par * SIDE_BYTES))[r]; return (tok < (unsigned)NTOK ? tok : 0u) * 2048u + (unsigned)C * 2u;
    }
    const char* A; const char* Bt; const int* tokl; const LAS int* tb; const LAS int* cn; int G, c; size_t bstride;
    __device__ __forceinline__ bool next(int i, Unit& u) const {
        const int L = i * G + c, tile = L / NTN; if (tile >= tb[32]) return false;
        int e = -1;
        { const LAS i32x4* t4 = (const LAS i32x4*)tb;
#pragma unroll
          for (int k = 0; k < 8; ++k) { const i32x4 v = t4[k]; e += (v.x <= tile) + (v.y <= tile) + (v.z <= tile) + (v.w <= tile); } }
        u.e = e; u.pm = tile - tb[e]; u.pn = L % NTN; u.rowbase = tile * 256; u.cnt = cn[e]; return true;
    }
    __device__ __forceinline__ const char* a_base() const { return A; }
    __device__ __forceinline__ unsigned a_off(const Unit& u, int r, int C) const {
        if (GATHER) { int rl = u.pm * 256 + r; rl = rl < u.cnt ? rl : u.cnt - 1; const int tok = tokl[(size_t)u.e * NTOK + rl]; return (unsigned)tok * 2048u + (unsigned)C * 2u; }
        else return (unsigned)(u.rowbase + r) * 2048u + (unsigned)C * 2u;
    }
    __device__ __forceinline__ const char* b_ptr(const Unit& u) const { return Bt + (size_t)u.e * bstride + (size_t)u.pn * BM * 16; }
};
}

namespace att {
constexpr float SCALE = 0.08838834764831845f, CLOG = SCALE * 1.4426950408889634f;
constexpr float THR_RAW = 8.0f / SCALE;
constexpr int SHM_V = 16384, SHM_K = 16384;
constexpr int NKVB = 2;
constexpr int L_V = 0, L_K = NKVB * SHM_V, L_CV0 = NKVB * (SHM_V + SHM_K), L_WS = 98304, L_BS = L_WS + NWAVES * 64 * 4;
static_assert(L_CV0 + 32768 <= L_WS, "attention LDS");
constexpr int BS_STRIDE = 129;
constexpr int L_SEL = L_BS + 64 * BS_STRIDE * 4;
constexpr int L_UNI = L_SEL + 64 * 16;
constexpr int L_LIST = L_UNI + 32;
constexpr int L_END = L_LIST + 128 * 4;
constexpr int L_K3 = (L_END + 15) & ~15;
static_assert(L_K3 + SHM_K <= MISC_OFF, "attention LDS");
#define KSWZ(row, colB) ((row) * 256 + ((colB) ^ (((row) & 15) << 4)))
#define SBAR() __builtin_amdgcn_sched_barrier(0)
__device__ __forceinline__ int crow(int r, int hi) { return (r & 3) + 8 * (r >> 2) + 4 * hi; }
__device__ __forceinline__ void qkt(f32x16& p0, f32x16& p1, const char* Ks, const bf16x8* qr, int r32, int hi) {
    p0 = f32x16{}; p1 = f32x16{};
#define QK_LD(D0, B0, B1) do { const int ad_ = kb_ + KSWZ(r32, ((D0) * 16 + hi * 8) * 2); \
        asm volatile("ds_read_b128 %0, %1" : "=&v"(B0) : "v"(ad_) : "memory"); asm volatile("ds_read_b128 %0, %1 offset:8192" : "=&v"(B1) : "v"(ad_) : "memory"); } while (0)
#define QK_MM(D0, B0, B1) do { p0 = __builtin_amdgcn_mfma_f32_32x32x16_bf16(B0, qr[D0], p0, 0, 0, 0); p1 = __builtin_amdgcn_mfma_f32_32x32x16_bf16(B1, qr[D0], p1, 0, 0, 0); } while (0)
    bf16x8 a0, a1, b0, b1, c0, c1; const int kb_ = (int)(uintptr_t)Ks;
    QK_LD(0, a0, a1); QK_LD(1, b0, b1);
    QK_LD(2, c0, c1); asm volatile("s_waitcnt lgkmcnt(4)" ::: "memory"); SBAR(); QK_MM(0, a0, a1); SBAR();
    QK_LD(3, a0, a1); asm volatile("s_waitcnt lgkmcnt(4)" ::: "memory"); SBAR(); QK_MM(1, b0, b1); SBAR();
    QK_LD(4, b0, b1); asm volatile("s_waitcnt lgkmcnt(4)" ::: "memory"); SBAR(); QK_MM(2, c0, c1); SBAR();
    QK_LD(5, c0, c1); asm volatile("s_waitcnt lgkmcnt(4)" ::: "memory"); SBAR(); QK_MM(3, a0, a1); SBAR();
    QK_LD(6, a0, a1); asm volatile("s_waitcnt lgkmcnt(4)" ::: "memory"); SBAR(); QK_MM(4, b0, b1); SBAR();
    QK_LD(7, b0, b1); asm volatile("s_waitcnt lgkmcnt(4)" ::: "memory"); SBAR(); QK_MM(5, c0, c1); SBAR();
    asm volatile("s_waitcnt lgkmcnt(2)" ::: "memory"); SBAR(); QK_MM(6, a0, a1); SBAR();
    asm volatile("s_waitcnt lgkmcnt(0)" ::: "memory"); SBAR(); QK_MM(7, b0, b1);
#undef QK_LD
#undef QK_MM
}
__device__ __forceinline__ int v_st(int k, int c) { const int kk = (k & ~0xC) | ((k & 4) << 1) | ((k & 8) >> 1); return ((kk >> 3) * 4 + (c >> 5)) * 512 + ((kk & 7) * 32 + (c & 31)) * 2; }
__device__ __forceinline__ int v_rd_base(int lane) { return ((lane & 3) << 3) | (((lane >> 2) & 3) << 6) | (((lane >> 4) & 1) << 5) | (((lane >> 5) & 1) << 8); }
constexpr int v_rd_off(int d0, int ks, int half) { return d0 * 512 + ks * 4096 + half * 2048; }
template <int OFF> __device__ __forceinline__ s16x4 tr_read(int vb) {
    s16x4 r; asm volatile("ds_read_b64_tr_b16 %0, %1 offset:%2" : "=&v"(r) : "v"(vb), "i"(OFF) : "memory"); return r;
}
template <int D0> __device__ __forceinline__ void pv_one(f32x16& od, int vb, bf16x8 pa0, bf16x8 pa1, bf16x8 pa2, bf16x8 pa3) {
    const s16x4 l0 = tr_read<v_rd_off(D0, 0, 0)>(vb), h0 = tr_read<v_rd_off(D0, 0, 1)>(vb), l1 = tr_read<v_rd_off(D0, 1, 0)>(vb), h1 = tr_read<v_rd_off(D0, 1, 1)>(vb);
    const s16x4 l2 = tr_read<v_rd_off(D0, 2, 0)>(vb), h2 = tr_read<v_rd_off(D0, 2, 1)>(vb), l3 = tr_read<v_rd_off(D0, 3, 0)>(vb), h3 = tr_read<v_rd_off(D0, 3, 1)>(vb);
    asm volatile("s_waitcnt lgkmcnt(0)" ::: "memory"); SBAR();
#define PKV(L, H) (bf16x8){L[0], L[1], L[2], L[3], H[0], H[1], H[2], H[3]}
    od = __builtin_amdgcn_mfma_f32_32x32x16_bf16(pa0, PKV(l0, h0), od, 0, 0, 0);
    od = __builtin_amdgcn_mfma_f32_32x32x16_bf16(pa1, PKV(l1, h1), od, 0, 0, 0);
    od = __builtin_amdgcn_mfma_f32_32x32x16_bf16(pa2, PKV(l2, h2), od, 0, 0, 0);
    od = __builtin_amdgcn_mfma_f32_32x32x16_bf16(pa3, PKV(l3, h3), od, 0, 0, 0);
#undef PKV
}
__device__ __forceinline__ void pv_d0(f32x16* o, int vb, bf16x8 pa0, bf16x8 pa1, bf16x8 pa2, bf16x8 pa3) {
    pv_one<0>(o[0], vb, pa0, pa1, pa2, pa3); pv_one<1>(o[1], vb, pa0, pa1, pa2, pa3); pv_one<2>(o[2], vb, pa0, pa1, pa2, pa3); pv_one<3>(o[3], vb, pa0, pa1, pa2, pa3);
}
__device__ __forceinline__ void pack_p(const f32x16& p0, const f32x16& p1, bf16x8& pa0, bf16x8& pa1, bf16x8& pa2, bf16x8& pa3) {
#define PK4(P, BASE, OUT) do { unsigned a0 = cvt_pk_bf16(P[BASE + 0], P[BASE + 1]), a1 = cvt_pk_bf16(P[BASE + 2], P[BASE + 3]);   \
    unsigned b0 = cvt_pk_bf16(P[BASE + 4], P[BASE + 5]), b1 = cvt_pk_bf16(P[BASE + 6], P[BASE + 7]);                              \
    auto r0 = __builtin_amdgcn_permlane32_swap(a0, b0, false, false); auto r1 = __builtin_amdgcn_permlane32_swap(a1, b1, false, false); \
    u32x4 w = {r0[0], r1[0], r0[1], r1[1]}; OUT = *reinterpret_cast<bf16x8*>(&w); } while (0)
    PK4(p0, 0, pa0); PK4(p0, 8, pa1); PK4(p1, 0, pa2); PK4(p1, 8, pa3);
#undef PK4
}
__device__ __forceinline__ float fmx(float a, float b) { return __builtin_elementwise_maximum(a, b); }
__device__ __forceinline__ float half_max(float v) { auto rr = __builtin_amdgcn_permlane32_swap(__float_as_uint(v), __float_as_uint(v), false, false); return fmx(__uint_as_float(rr[0]), __uint_as_float(rr[1])); }
__device__ __forceinline__ float half_sum(float v) { auto rr = __builtin_amdgcn_permlane32_swap(__float_as_uint(v), __float_as_uint(v), false, false); return __uint_as_float(rr[0]) + __uint_as_float(rr[1]); }

struct Ptrs { const bf16_t* Q; const bf16_t* KV; const bf16_t* KCMP; const bf16_t* VCMP; const float* GLOG; bf16_t* MIX; float* scr; const float* qng; const float* cosT; const float* sinT; };

template <int MODE>
__device__ __forceinline__ void branch_ref(char* lds, const bf16_t* Kb, const bf16_t* Vb, const bf16x8* qr, int ntiles, int qi, int qoff, int nmax,
                                       const unsigned (&selw)[4], float& m_reg, float& l_reg, float inv_l, f32x16* o, const int wid) {
    const int lane = fresh_lane(), tid = wid * 64 + lane, r32 = lane & 31, hi = lane >> 5;
    char* V_lds = lds + L_V; char* K_lds = lds + L_K;
    float* al_l = (float*)(lds + L_WS) + wid * 64 + 32;
    float* bs = (float*)(lds + L_BS);
    const int* tlist = (const int*)(lds + L_LIST);
    const int sr = tid >> 4, sc = (tid & 15) * 8, vst0 = v_st(sr, sc), vst1 = v_st(32 + sr, sc);
    const int vb0 = (int)(uintptr_t)V_lds + v_rd_base(lane);
    const int j0w = (qi - 8 > 0) ? qi - 8 : 0;
    bf16x8 vs0, vs1, ks0, ks1;
#define TILE_OF(i) (MODE <= 1 ? (i) : (MODE == 2 ? tlist[i] : j0w + (i)))
#define SLOADT(j) do { const size_t k0 = (size_t)(j) * 64; ks0 = *(const bf16x8*)(Kb + (k0 + sr) * 128 + sc); ks1 = *(const bf16x8*)(Kb + (k0 + 32 + sr) * 128 + sc); \
        if (MODE != 0) { vs0 = *(const bf16x8*)(Vb + (k0 + sr) * 128 + sc); vs1 = *(const bf16x8*)(Vb + (k0 + 32 + sr) * 128 + sc); } } while (0)
#define SWRITET(b) do { const int kc = sc * 2; *(bf16x8*)(K_lds + (b) * SHM_K + KSWZ(sr, kc)) = ks0; *(bf16x8*)(K_lds + (b) * SHM_K + KSWZ(32 + sr, kc)) = ks1; \
        if (MODE != 0) { *(bf16x8*)(V_lds + (b) * SHM_V + vst0) = vs0; *(bf16x8*)(V_lds + (b) * SHM_V + vst1) = vs1; } } while (0)
    SLOADT(TILE_OF(0)); SWRITET(0); __syncthreads();
    for (int i = 0; i < ntiles; ++i) {
        const int j = TILE_OF(i), buf = i & 1;
        if (i + 1 < ntiles) SLOADT(TILE_OF(i + 1));
        f32x16 p0, p1;
        qkt(p0, p1, K_lds + buf * SHM_K, qr, r32, hi);
        int lo = 0, hi_ = 63;
        if (MODE <= 1) hi_ = nmax - j * 64;
        else if (MODE == 2) { const int jw = j >> 5; const unsigned sw_ = jw == 0 ? selw[0] : jw == 1 ? selw[1] : jw == 2 ? selw[2] : selw[3]; const bool sel = (sw_ >> (j & 31)) & 1u; hi_ = sel ? (j == qi ? qoff : 63) : -1; }
        else { if (j == qi) hi_ = qoff; else if (j == qi - 8) lo = qoff + 1; }
        const int lo4 = lo - 4 * hi, hi4 = hi_ - 4 * hi;
        float pmax = -INFINITY;
#pragma unroll
        for (int r = 0; r < 16; ++r) { const int kc0 = (r & 3) + 8 * (r >> 2);
            p0[r] = (kc0 >= lo4 && kc0 <= hi4) ? p0[r] : -INFINITY; p1[r] = (kc0 + 32 >= lo4 && kc0 + 32 <= hi4) ? p1[r] : -INFINITY;
            pmax = fmaxf(pmax, fmaxf(p0[r], p1[r])); }
        float alpha = 1.f;
        if (MODE != 1) {
            pmax = half_max(pmax);
            const float mn = fmaxf(m_reg, pmax); alpha = fast_exp2((m_reg - mn) * CLOG); m_reg = mn;
        }
        const float mnC = -m_reg * CLOG;
        float ps = 0.f;
#pragma unroll
        for (int r = 0; r < 16; ++r) { p0[r] = fast_exp2(fmaf(p0[r], CLOG, mnC)); p1[r] = fast_exp2(fmaf(p1[r], CLOG, mnC)); ps += p0[r] + p1[r]; }
        if (MODE != 1) { ps = half_sum(ps); l_reg = l_reg * alpha + ps; }
        if (MODE == 1) {
#pragma unroll
            for (int r = 0; r < 16; ++r) { p0[r] *= inv_l; p1[r] *= inv_l; }
            unsigned* row = (unsigned*)bs + qoff * BS_STRIDE + j * 16 + hi;
#pragma unroll
            for (int a = 0; a < 4; ++a) {
                const float s0 = 2.f * (p0[4 * a] + p0[4 * a + 1] + p0[4 * a + 2]) + p0[4 * a + 3], s1 = 2.f * (p1[4 * a] + p1[4 * a + 1] + p1[4 * a + 2]) + p1[4 * a + 3];
                atomicAdd(row + 2 * a, (unsigned)(s0 * 67108864.f + 0.5f)); atomicAdd(row + 2 * a + 1, (unsigned)(p0[4 * a + 3] * 67108864.f + 0.5f));
                atomicAdd(row + 8 + 2 * a, (unsigned)(s1 * 67108864.f + 0.5f)); atomicAdd(row + 8 + 2 * a + 1, (unsigned)(p1[4 * a + 3] * 67108864.f + 0.5f));
            }
        }
        if (MODE != 0) {
            if (MODE != 1) {
                if (__any(alpha < 1.f)) { if (hi == 0) al_l[r32] = alpha; asm volatile("s_waitcnt lgkmcnt(0)" ::: "memory");
#pragma unroll
                    for (int d = 0; d < 4; ++d)
#pragma unroll
                        for (int r = 0; r < 16; ++r) o[d][r] *= al_l[crow(r, hi)]; }
            }
            bf16x8 pa0, pa1, pa2, pa3;
            pack_p(p0, p1, pa0, pa1, pa2, pa3);
            pv_d0(o, vb0 + buf * SHM_V, pa0, pa1, pa2, pa3);
        }
        if (i + 1 < ntiles) SWRITET(buf ^ 1);
        __syncthreads();
    }
#undef TILE_OF
#undef SLOADT
#undef SWRITET
}


struct Conv { const char* sg; const char* sd; unsigned char* dg; unsigned char* dd; int next, total; bool live; };
constexpr int L_CV1 = L_BS;
static_assert(64 * BS_STRIDE * 4 >= 32768, "conversion buffer 1");
__device__ __forceinline__ Conv conv_init(const float* wgu, const float* wd, unsigned char* ws, int c, bool on, const int wid) {
    Conv cv;
    const int gn = (c & 7) * 512 + wid * 64, dn = (c & 3) * 512 + wid * 64;
    const int grow = gn < 2048 ? ((gn >> 7) * 256 + (gn & 127)) : (((gn - 2048) >> 7) * 256 + 128 + (gn & 127));
    cv.sg = (const char*)(wgu + (size_t)(c >> 3) * 16 * 4096 + gn);
    cv.dg = ws + WS_WGU + ((size_t)(c >> 3) * 4096 + grow) * 16;
    cv.sd = (const char*)(wd + (size_t)(c >> 2) * 16 * 2048 + dn) - ((size_t)128 << 23);
    cv.dd = ws + WS_WD + ((size_t)(c >> 2) * 2048 + dn) * 16 - ((size_t)128 << 21);
    cv.next = 0; cv.total = on ? 192 : 0; cv.live = false;
    return cv;
}
__device__ __forceinline__ void conv_issue(LAS unsigned char* ldsl, int cb, const Conv& cv, int L, const int wid, const int lane) {
    const bool gu = L < 128; const int sh = gu ? 14 : 13;
    const char* src = (gu ? cv.sg : cv.sd) + ((size_t)L << 23);
    const unsigned voff = ((unsigned)(lane >> 4) << sh) + (unsigned)(lane & 15) * 16u;
    LAS unsigned char* d = ldsl + cb + wid * 4096;
    __builtin_amdgcn_global_load_lds((const unsigned*)(src + voff), (LAS unsigned*)d, 16, 0, 2);
    __builtin_amdgcn_global_load_lds((const unsigned*)(src + ((size_t)4 << sh) + voff), (LAS unsigned*)(d + 1024), 16, 0, 2);
    __builtin_amdgcn_global_load_lds((const unsigned*)(src + ((size_t)8 << sh) + voff), (LAS unsigned*)(d + 2048), 16, 0, 2);
    __builtin_amdgcn_global_load_lds((const unsigned*)(src + ((size_t)12 << sh) + voff), (LAS unsigned*)(d + 3072), 16, 0, 2);
}
typedef short s16x2 __attribute__((ext_vector_type(2)));
__device__ __forceinline__ unsigned cv_pk4(float a, float b, float c, float d) {
    s16x2 r = __builtin_bit_cast(s16x2, a);
    r = __builtin_amdgcn_cvt_scalef32_pk_fp8_f32(r, a, b, 0.015625f, false);
    r = __builtin_amdgcn_cvt_scalef32_pk_fp8_f32(r, c, d, 0.015625f, true);
    return __builtin_bit_cast(unsigned, r); }
__device__ __forceinline__ void conv_read(LAS unsigned char* ldsl, int cb, const int wid, const int lane, float (&v)[16]) {
    const LAS float* bp = (const LAS float*)(ldsl + cb + wid * 4096 + lane * 4);
#pragma unroll
    for (int j = 0; j < 16; ++j) v[j] = bp[j * 64];
}
__device__ __forceinline__ void conv_store(const Conv& cv, int L, const int wid, const int lane, const float (&v)[16]) {
    unsigned char* dst = (L < 128 ? cv.dg : cv.dd) + ((size_t)L << 21);
    u32x4 o;
    o.x = cv_pk4(v[0], v[1], v[2], v[3]); o.y = cv_pk4(v[4], v[5], v[6], v[7]); o.z = cv_pk4(v[8], v[9], v[10], v[11]); o.w = cv_pk4(v[12], v[13], v[14], v[15]);
    *(u32x4*)(dst + (unsigned)(lane * 16)) = o;
}
__device__ __forceinline__ void conv_consume(LAS unsigned char* ldsl, int cb, const Conv& cv, int L, const int wid, const int lane) {
    float v[16];
    conv_read(ldsl, cb, wid, lane, v);
    asm volatile("s_waitcnt lgkmcnt(0)" ::: "memory");
    conv_store(cv, L, wid, lane, v);
}
__device__ __forceinline__ void conv_prime(char* lds, Conv& cv, int niter, const int wid) {
    const int lane = fresh_lane(); LAS unsigned char* ldsl = (LAS unsigned char*)(unsigned)(uintptr_t)lds;
    cv.live = cv.next + 2 + niter <= cv.total;
    if (cv.live) { conv_issue(ldsl, (cv.next & 1) ? L_CV1 : L_CV0, cv, cv.next, wid, lane); conv_issue(ldsl, ((cv.next + 1) & 1) ? L_CV1 : L_CV0, cv, cv.next + 1, wid, lane); cv.next += 2; }
}
__device__ __forceinline__ void conv_drain(char* lds, Conv& cv, const int wid) {
    const int lane = fresh_lane(); LAS unsigned char* ldsl = (LAS unsigned char*)(unsigned)(uintptr_t)lds;
    if (cv.live) {
        asm volatile("s_waitcnt vmcnt(0)" ::: "memory");
        conv_consume(ldsl, ((cv.next - 2) & 1) ? L_CV1 : L_CV0, cv, cv.next - 2, wid, lane);
        conv_consume(ldsl, ((cv.next - 1) & 1) ? L_CV1 : L_CV0, cv, cv.next - 1, wid, lane);
        cv.live = false;
    }
}
__device__ __forceinline__ void conv_tail(char* lds, Conv& cv, const int wid) {
    const int lane = fresh_lane();
    LAS unsigned char* ldsl = (LAS unsigned char*)(unsigned)(uintptr_t)lds;
    int is = cv.next, co = cv.next;
    for (int k = 0; k < 3 && is < cv.total; ++k, ++is) conv_issue(ldsl, (is & 3) * 32768, cv, is, wid, lane);
    while (co < cv.total) {
        if (is < cv.total) { conv_issue(ldsl, (is & 3) * 32768, cv, is, wid, lane); ++is; asm volatile("s_waitcnt vmcnt(12)" ::: "memory"); }
        else asm volatile("s_waitcnt vmcnt(0)" ::: "memory");
        conv_consume(ldsl, (co & 3) * 32768, cv, co, wid, lane); ++co;
    }
    cv.next = cv.total;
}

constexpr int CONV_EARLY = 4;
__device__ __forceinline__ void conv_early(char* lds, const float* wgu, const float* wd, unsigned char* ws, int first, int stride, const int wid) {
    const int lane = fresh_lane();
    LAS unsigned char* ldsl = (LAS unsigned char*)(unsigned)(uintptr_t)lds;
    constexpr int N = 256 * CONV_EARLY, L0 = 192 - CONV_EARLY;
    int is = first, co = first, kis = 0, kco = 0;
    for (int k = 0; k < 3 && is < N; ++k, is += stride, ++kis) { const Conv c = conv_init(wgu, wd, ws, is & 255, true, wid); conv_issue(ldsl, (kis & 3) * 32768, c, L0 + (is >> 8), wid, lane); }
    while (co < N) {
        if (is < N) { const Conv c = conv_init(wgu, wd, ws, is & 255, true, wid); conv_issue(ldsl, (kis & 3) * 32768, c, L0 + (is >> 8), wid, lane); is += stride; ++kis; asm volatile("s_waitcnt vmcnt(12)" ::: "memory"); }
        else asm volatile("s_waitcnt vmcnt(0)" ::: "memory");
        { const Conv c = conv_init(wgu, wd, ws, co & 255, true, wid); conv_consume(ldsl, (kco & 3) * 32768, c, L0 + (co >> 8), wid, lane); }
        co += stride; ++kco;
    }
}

template <int MODE, bool CONV>
__device__ __forceinline__ void branch(char* lds, const bf16_t* Kb, const bf16_t* Vb, const bf16x8* qr, int ntiles, int qi, int qoff, int nmax,
                                       const unsigned (&selw)[4], float& m_reg, float& l_reg, float inv_l, f32x16* o, const int wid, Conv& cv) {
    const int lane = fresh_lane(), r32 = lane & 31, hi = lane >> 5;
    char* V_lds = lds + L_V; char* K_lds = lds + L_K;
    LAS unsigned char* ldsl = (LAS unsigned char*)(unsigned)(uintptr_t)lds;
    float* al_l = (float*)(lds + L_WS) + wid * 64 + 32;
    float* bs = (float*)(lds + L_BS);
    const int* tlist = (const int*)(lds + L_LIST);
    const int vb0 = (int)(uintptr_t)V_lds + v_rd_base(lane);
    const int j0w = (qi - 8 > 0) ? qi - 8 : 0;
    unsigned ksrc[2], vsrc[2];
#pragma unroll
    for (int i = 0; i < 2; ++i) { const int q = (i * 8 + wid) * 64 + lane;
        { const int row = q >> 4, c = (q & 15) ^ (row & 15); ksrc[i] = (unsigned)(row * 256 + c * 16); }
        { const int sub = q >> 5, within = q & 31, kk = (sub >> 2) * 8 + (within >> 2), k = (kk & ~0xC) | ((kk & 4) << 1) | ((kk & 8) >> 1), c = (sub & 3) * 32 + (within & 3) * 8; vsrc[i] = (unsigned)(k * 256 + c * 2); } }
#define TILE_OF(i) (MODE <= 1 ? (i) : (MODE == 2 ? tlist[i] : j0w + (i)))
#define ISSUE(j, b) do { const char* kg_ = (const char*)Kb + (size_t)(j) * 16384; const char* vg_ = (const char*)Vb + (size_t)(j) * 16384; \
        _Pragma("unroll") for (int _i = 0; _i < 2; ++_i) { \
            __builtin_amdgcn_global_load_lds((const unsigned*)(kg_ + ksrc[_i]), (LAS unsigned*)(ldsl + L_K + (b) * SHM_K + (_i * 8 + wid) * 1024), 16, 0, 0); \
            if (MODE != 0) __builtin_amdgcn_global_load_lds((const unsigned*)(vg_ + vsrc[_i]), (LAS unsigned*)(ldsl + L_V + (b) * SHM_V + (_i * 8 + wid) * 1024), 16, 0, 0); } } while (0)
    ISSUE(TILE_OF(0), 0);
    int buf = 0;
    for (int i = 0; i < ntiles; ++i) {
        const int j = TILE_OF(i);
        if (CONV && i > 0) asm volatile("s_waitcnt vmcnt(4)" ::: "memory"); else asm volatile("s_waitcnt vmcnt(0)" ::: "memory");
        asm volatile("s_waitcnt lgkmcnt(0)" ::: "memory");
        __builtin_amdgcn_s_barrier();
        asm volatile("" ::: "memory");
        if (i + 1 < ntiles) ISSUE(TILE_OF(i + 1), buf ^ 1);
        f32x16 p0, p1;
        qkt(p0, p1, K_lds + buf * SHM_K, qr, r32, hi);
        float cvv[16]; const int cvb = (cv.next & 1) ? L_CV1 : L_CV0;
        if (CONV) { conv_read(ldsl, cvb, wid, lane, cvv); SBAR(); }
        bool boundary;
        if (MODE <= 1) boundary = (64 * j + 63 > 4 * qi - 2);
        else if (MODE == 2) boundary = (j == qi);
        else boundary = (j == qi) || (j == qi - 8);
        float pmax = -INFINITY; bool rowvalid = true;
        if (boundary) {
            int lo = 0, hi_ = 63;
            if (MODE <= 1) hi_ = nmax - j * 64;
            else if (MODE == 2) hi_ = qoff;
            else { if (j == qi) hi_ = qoff; else lo = qoff + 1; }
            const int lo4 = lo - 4 * hi, hi4 = hi_ - 4 * hi;
#pragma unroll
            for (int r = 0; r < 16; ++r) { const int kc0 = (r & 3) + 8 * (r >> 2);
                p0[r] = (kc0 >= lo4 && kc0 <= hi4) ? p0[r] : -INFINITY; p1[r] = (kc0 + 32 >= lo4 && kc0 + 32 <= hi4) ? p1[r] : -INFINITY;
                pmax = fmx(pmax, fmx(p0[r], p1[r])); }
        } else {
            if (MODE == 2) { const int jw = j >> 5; const unsigned sw_ = jw == 0 ? selw[0] : jw == 1 ? selw[1] : jw == 2 ? selw[2] : selw[3]; rowvalid = (sw_ >> (j & 31)) & 1u; }
#pragma unroll
            for (int r = 0; r < 16; ++r) pmax = fmx(pmax, fmx(p0[r], p1[r]));
            if (MODE == 2) pmax = rowvalid ? pmax : -INFINITY;
        }
        float alpha = 1.f;
        if (MODE != 1) {
            pmax = half_max(pmax);
            if (!__all(pmax - m_reg <= THR_RAW)) { const float mn = fmx(m_reg, pmax); alpha = fast_exp2((m_reg - mn) * CLOG); m_reg = mn; }
        }
        float mnC = -m_reg * CLOG;
        if (MODE == 2) mnC = rowvalid ? mnC : -INFINITY;
        float ps;
        { const f32x2 cl2 = {CLOG, CLOG}, mc2 = {mnC, mnC}; f32x2 acc = {0.f, 0.f};
#pragma unroll
          for (int k = 0; k < 8; ++k) {
              f32x2 a = {p0[2 * k], p0[2 * k + 1]}, b = {p1[2 * k], p1[2 * k + 1]};
              a = __builtin_elementwise_fma(a, cl2, mc2); b = __builtin_elementwise_fma(b, cl2, mc2);
              a.x = fast_exp2(a.x); a.y = fast_exp2(a.y); b.x = fast_exp2(b.x); b.y = fast_exp2(b.y);
              p0[2 * k] = a.x; p0[2 * k + 1] = a.y; p1[2 * k] = b.x; p1[2 * k + 1] = b.y;
              acc += a + b; }
          ps = acc.x + acc.y; }
        if (MODE != 1) { ps = half_sum(ps); l_reg = l_reg * alpha + ps; }
        if (MODE == 1) {
#pragma unroll
            for (int r = 0; r < 16; ++r) { p0[r] *= inv_l; p1[r] *= inv_l; }
            unsigned* row = (unsigned*)bs + qoff * BS_STRIDE + j * 16 + hi;
#pragma unroll
            for (int a = 0; a < 4; ++a) {
                const float s0 = 2.f * (p0[4 * a] + p0[4 * a + 1] + p0[4 * a + 2]) + p0[4 * a + 3], s1 = 2.f * (p1[4 * a] + p1[4 * a + 1] + p1[4 * a + 2]) + p1[4 * a + 3];
                atomicAdd(row + 2 * a, (unsigned)(s0 * 67108864.f + 0.5f)); atomicAdd(row + 2 * a + 1, (unsigned)(p0[4 * a + 3] * 67108864.f + 0.5f));
                atomicAdd(row + 8 + 2 * a, (unsigned)(s1 * 67108864.f + 0.5f)); atomicAdd(row + 8 + 2 * a + 1, (unsigned)(p1[4 * a + 3] * 67108864.f + 0.5f));
            }
        }
        if (MODE != 0) {
            if (MODE != 1) {
                if (__any(alpha < 1.f)) { if (hi == 0) al_l[r32] = alpha; asm volatile("s_waitcnt lgkmcnt(0)" ::: "memory");
#pragma unroll
                    for (int d = 0; d < 4; ++d)
#pragma unroll
                        for (int r = 0; r < 16; ++r) o[d][r] *= al_l[crow(r, hi)]; }
            }
            bf16x8 pa0, pa1, pa2, pa3;
            pack_p(p0, p1, pa0, pa1, pa2, pa3);
            if (CONV) {
                SBAR();
                asm volatile("s_waitcnt lgkmcnt(0)" ::: "memory");
                conv_issue(ldsl, cvb, cv, cv.next, wid, lane);
                SBAR();
                pv_one<0>(o[0], vb0 + buf * SHM_V, pa0, pa1, pa2, pa3);
                conv_store(cv, cv.next - 2, wid, lane, cvv);
                ++cv.next;
                pv_one<1>(o[1], vb0 + buf * SHM_V, pa0, pa1, pa2, pa3); pv_one<2>(o[2], vb0 + buf * SHM_V, pa0, pa1, pa2, pa3); pv_one<3>(o[3], vb0 + buf * SHM_V, pa0, pa1, pa2, pa3);
            } else pv_d0(o, vb0 + buf * SHM_V, pa0, pa1, pa2, pa3);
        }
        buf ^= 1;
    }
    asm volatile("s_waitcnt lgkmcnt(0)" ::: "memory");
    __builtin_amdgcn_s_barrier();
    asm volatile("" ::: "memory");
#undef TILE_OF
#undef ISSUE
}

template <int MODE, bool CONV, bool LATE>
__device__ __forceinline__ void branch_stag(char* lds, const bf16_t* Kb, const bf16_t* Vb, const bf16x8* qr, int ntiles, int qi, int qoff,
                                            const unsigned (&selw)[4], float& m_reg, float& l_reg, f32x16* o, const int wid, Conv& cv) {
    static_assert(MODE >= 2, "selected / window only");
    const int lane = fresh_lane(), r32 = lane & 31, hi = lane >> 5;
    char* V_lds = lds + L_V;
    LAS unsigned char* ldsl = (LAS unsigned char*)(unsigned)(uintptr_t)lds;
    float* al_l = (float*)(lds + L_WS) + wid * 64 + 32;
    const int* tlist = (const int*)(lds + L_LIST);
    const int vb0 = (int)(uintptr_t)V_lds + v_rd_base(lane);
    const int j0w = (qi - 8 > 0) ? qi - 8 : 0;
    constexpr bool late = LATE;
    unsigned ksrc[2], vsrc[2];
#pragma unroll
    for (int i = 0; i < 2; ++i) { const int q = (i * 8 + wid) * 64 + lane;
        { const int row = q >> 4, c = (q & 15) ^ (row & 15); ksrc[i] = (unsigned)(row * 256 + c * 16); }
        { const int sub = q >> 5, within = q & 31, kk = (sub >> 2) * 8 + (within >> 2), k = (kk & ~0xC) | ((kk & 4) << 1) | ((kk & 8) >> 1), c = (sub & 3) * 32 + (within & 3) * 8; vsrc[i] = (unsigned)(k * 256 + c * 2); } }
#define TILE_OF(i) (MODE == 2 ? tlist[i] : j0w + (i))
#define KSLOT(s) ((s) == 2 ? L_K3 : L_K + (s) * SHM_K)
#define ISSUE_K(j, s) do { const char* kg_ = (const char*)Kb + (size_t)(j) * 16384; const int ko_ = KSLOT(s); \
        _Pragma("unroll") for (int _i = 0; _i < 2; ++_i) __builtin_amdgcn_global_load_lds((const unsigned*)(kg_ + ksrc[_i]), (LAS unsigned*)(ldsl + ko_ + (_i * 8 + wid) * 1024), 16, 0, 0); } while (0)
#define ISSUE_V(j, b) do { const char* vg_ = (const char*)Vb + (size_t)(j) * 16384; \
        _Pragma("unroll") for (int _i = 0; _i < 2; ++_i) __builtin_amdgcn_global_load_lds((const unsigned*)(vg_ + vsrc[_i]), (LAS unsigned*)(ldsl + L_V + (b) * SHM_V + (_i * 8 + wid) * 1024), 16, 0, 0); } while (0)
#define SP_PHASE(J, VB) do { const int j = (J); \
        float cvv[16]; const int cvb = (cv.next & 1) ? L_CV1 : L_CV0; \
        if (CONV) { conv_read(ldsl, cvb, wid, lane, cvv); SBAR(); } \
        bool boundary; if (MODE == 2) boundary = (j == qi); else boundary = (j == qi) || (j == qi - 8); \
        float pmax = -INFINITY; bool rowvalid = true; \
        if (boundary) { int lo = 0, hi_ = 63; \
            if (MODE == 2) hi_ = qoff; else { if (j == qi) hi_ = qoff; else lo = qoff + 1; } \
            const int lo4 = lo - 4 * hi, hi4 = hi_ - 4 * hi; \
            _Pragma("unroll") for (int r = 0; r < 16; ++r) { const int kc0 = (r & 3) + 8 * (r >> 2); \
                p0[r] = (kc0 >= lo4 && kc0 <= hi4) ? p0[r] : -INFINITY; p1[r] = (kc0 + 32 >= lo4 && kc0 + 32 <= hi4) ? p1[r] : -INFINITY; \
                pmax = fmx(pmax, fmx(p0[r], p1[r])); } \
        } else { \
            if (MODE == 2) { const int jw = j >> 5; const unsigned sw_ = jw == 0 ? selw[0] : jw == 1 ? selw[1] : jw == 2 ? selw[2] : selw[3]; rowvalid = (sw_ >> (j & 31)) & 1u; } \
            _Pragma("unroll") for (int r = 0; r < 16; ++r) pmax = fmx(pmax, fmx(p0[r], p1[r])); \
            if (MODE == 2) pmax = rowvalid ? pmax : -INFINITY; } \
        float alpha = 1.f; \
        pmax = half_max(pmax); \
        if (!__all(pmax - m_reg <= THR_RAW)) { const float mn = fmx(m_reg, pmax); alpha = fast_exp2((m_reg - mn) * CLOG); m_reg = mn; } \
        float mnC = -m_reg * CLOG; \
        if (MODE == 2) mnC = rowvalid ? mnC : -INFINITY; \
        float ps; \
        { const f32x2 cl2 = {CLOG, CLOG}, mc2 = {mnC, mnC}; f32x2 acc = {0.f, 0.f}; \
          _Pragma("unroll") for (int k = 0; k < 8; ++k) { \
              f32x2 a = {p0[2 * k], p0[2 * k + 1]}, b = {p1[2 * k], p1[2 * k + 1]}; \
              a = __builtin_elementwise_fma(a, cl2, mc2); b = __builtin_elementwise_fma(b, cl2, mc2); \
              a.x = fast_exp2(a.x); a.y = fast_exp2(a.y); b.x = fast_exp2(b.x); b.y = fast_exp2(b.y); \
              p0[2 * k] = a.x; p0[2 * k + 1] = a.y; p1[2 * k] = b.x; p1[2 * k + 1] = b.y; \
              acc += a + b; } \
          ps = acc.x + acc.y; } \
        ps = half_sum(ps); l_reg = l_reg * alpha + ps; \
        if (__any(alpha < 1.f)) { if (hi == 0) al_l[r32] = alpha; asm volatile("s_waitcnt lgkmcnt(0)" ::: "memory"); \
            _Pragma("unroll") for (int d = 0; d < 4; ++d) _Pragma("unroll") for (int r = 0; r < 16; ++r) o[d][r] *= al_l[crow(r, hi)]; } \
        bf16x8 pa0, pa1, pa2, pa3; \
        pack_p(p0, p1, pa0, pa1, pa2, pa3); \
        const int vbb_ = vb0 + (VB) * SHM_V; \
        if (CONV) { \
            SBAR(); asm volatile("s_waitcnt lgkmcnt(0)" ::: "memory"); \
            conv_issue(ldsl, cvb, cv, cv.next, wid, lane); \
            SBAR(); \
            pv_one<0>(o[0], vbb_, pa0, pa1, pa2, pa3); \
            conv_store(cv, cv.next - 2, wid, lane, cvv); \
            ++cv.next; \
            pv_one<1>(o[1], vbb_, pa0, pa1, pa2, pa3); pv_one<2>(o[2], vbb_, pa0, pa1, pa2, pa3); pv_one<3>(o[3], vbb_, pa0, pa1, pa2, pa3); \
        } else pv_d0(o, vbb_, pa0, pa1, pa2, pa3); } while (0)
    int jc = TILE_OF(0), jn = ntiles > 1 ? TILE_OF(1) : 0, jnn = ntiles > 2 ? TILE_OF(2) : 0;
    ISSUE_K(jc, 0); ISSUE_V(jc, 0); if (ntiles > 1) ISSUE_K(jn, 1);
    asm volatile("s_waitcnt vmcnt(0)" ::: "memory"); asm volatile("s_waitcnt lgkmcnt(0)" ::: "memory");
    __builtin_amdgcn_s_barrier();
    asm volatile("" ::: "memory");
    f32x16 p0, p1;
    if (late) qkt(p0, p1, lds + KSLOT(0), qr, r32, hi);
    int ks = 0, vbuf = 0;
    for (int t = 0; t < ntiles; ++t) {
        if (CONV && t > 0) asm volatile("s_waitcnt vmcnt(4)" ::: "memory"); else asm volatile("s_waitcnt vmcnt(0)" ::: "memory");
        asm volatile("s_waitcnt lgkmcnt(0)" ::: "memory");
        __builtin_amdgcn_s_barrier();
        asm volatile("" ::: "memory");
        const int ks1 = ks == 2 ? 0 : ks + 1, ks2 = ks1 == 2 ? 0 : ks1 + 1;
        if (t + 2 < ntiles) ISSUE_K(jnn, ks2);
        if (t + 1 < ntiles) ISSUE_V(jn, vbuf ^ 1);
        const int jt = jc; jc = jn; jn = jnn; if (t + 3 < ntiles) jnn = TILE_OF(t + 3);
        if (!late) { qkt(p0, p1, lds + KSLOT(ks), qr, r32, hi); SP_PHASE(jt, vbuf); }
        else { SP_PHASE(jt, vbuf); if (t + 1 < ntiles) qkt(p0, p1, lds + KSLOT(ks1), qr, r32, hi); }
        ks = ks1; vbuf ^= 1;
    }
    asm volatile("s_waitcnt lgkmcnt(0)" ::: "memory");
    __builtin_amdgcn_s_barrier();
    asm volatile("" ::: "memory");
#undef TILE_OF
#undef KSLOT
#undef ISSUE_K
#undef ISSUE_V
#undef SP_PHASE
}

template <int STAGE, bool CHECK = false>
__device__ __forceinline__ void finalize(char* lds, const f32x16* o, float f, float* scr, bf16_t* mixrow0  , const int wid, unsigned* err = nullptr) {
    const int lane = fresh_lane(), r32 = lane & 31, hi = lane >> 5;
    float* li_l = (float*)(lds + L_WS) + wid * 64;
    if (hi == 0) li_l[r32] = f;
    asm volatile("s_waitcnt lgkmcnt(0)" ::: "memory");
    int lb = hi * 4; asm volatile("" : "+v"(lb));
    float* sw = scr + (size_t)(wid * 32 + lb) * 128 + r32;
    bf16_t* mw = mixrow0 + (size_t)lb * 2048 + r32;
#pragma unroll
    for (int r = 0; r < 16; ++r) { const int orc = (r & 3) + 8 * (r >> 2); const float fr_ = li_l[orc + lb];
#pragma unroll
        for (int d0 = 0; d0 < 4; ++d0) {
            float* p = sw + orc * 128 + d0 * 32;
            float v = o[d0][r] * fr_;
            if (STAGE >= 1) v += *p;
            if (STAGE <= 1) *p = v;
            else { bf16_t* mp = mw + (size_t)orc * 2048 + d0 * 32;
                if (CHECK) { const float old = __uint_as_float((unsigned)(*mp) << 16); if (!(fabsf(old - v) <= 0.02f * fabsf(v) + 2e-3f)) __hip_atomic_store(err, 1u, RLX_AGENT); }
                *mp = (bf16_t)(cvt_pk_bf16(v, v) & 0xffffu); }
        } }
}


typedef unsigned u32x8 __attribute__((ext_vector_type(8)));
__device__ __forceinline__ void accum_out(char* lds, const f32x16* o, float f, u32x8* out, const int wid, const bool first) {
    const int lane = fresh_lane(), r32 = lane & 31, hi = lane >> 5;
    float* li_l = (float*)(lds + L_WS) + wid * 64;
    if (hi == 0) li_l[r32] = f;
    asm volatile("s_waitcnt lgkmcnt(0)" ::: "memory");
#pragma unroll
    for (int k = 0; k < 8; ++k) { const float f0 = li_l[crow(2 * k, hi)], f1 = li_l[crow(2 * k + 1, hi)];
#pragma unroll
        for (int d0 = 0; d0 < 4; ++d0) { const unsigned pk = out[d0][k]; const float a = first ? 0.f : bf_lo(pk), b = first ? 0.f : bf_hi(pk);
            out[d0][k] = cvt_pk_bf16(fmaf(o[d0][2 * k], f0, a), fmaf(o[d0][2 * k + 1], f1, b)); } }
}
template <bool CHECK>
__device__ __forceinline__ void store_out(char* lds, const u32x8* out, bf16_t* mixrow0, const int wid, unsigned* err) {
    const int lane = fresh_lane(), r32 = lane & 31, hi = lane >> 5;
    unsigned short* st = (unsigned short*)(lds + wid * 8192);
#pragma unroll
    for (int k = 0; k < 8; ++k) { const int row0 = crow(2 * k, hi), row1 = crow(2 * k + 1, hi);
#pragma unroll
        for (int d0 = 0; d0 < 4; ++d0) { const unsigned pk = out[d0][k]; st[row0 * 128 + d0 * 32 + r32] = (unsigned short)(pk & 0xffffu); st[row1 * 128 + d0 * 32 + r32] = (unsigned short)(pk >> 16); } }
    asm volatile("s_waitcnt lgkmcnt(0)" ::: "memory");
#pragma unroll
    for (int q = 0; q < 8; ++q) { const int idx = q * 64 + lane, row = idx >> 4, ch = idx & 15;
        const u32x4 v = *(const u32x4*)(st + row * 128 + ch * 8);
        u32x4* gp = (u32x4*)(mixrow0 + (size_t)row * 2048 + ch * 8);
        if (CHECK) { const u32x4 old = *gp; const unsigned a[4] = {old.x, old.y, old.z, old.w}, b[4] = {v.x, v.y, v.z, v.w};
#pragma unroll
            for (int k = 0; k < 4; ++k) { const float x0 = bf_lo(a[k]), x1 = bf_hi(a[k]), y0 = bf_lo(b[k]), y1 = bf_hi(b[k]);
                if (!(fabsf(x0 - y0) <= 0.03f * fabsf(y0) + 3e-3f) || !(fabsf(x1 - y1) <= 0.03f * fabsf(y1) + 3e-3f)) __hip_atomic_store(err, 1u, RLX_AGENT); } }
        *gp = v; }
}

template <int IMPL, bool CHECK>
__device__ __forceinline__ void attn_item(char* lds, const Ptrs& P, int b, int g, int qi, const int wid, unsigned* err, Conv& cv) {
    const int lane = fresh_lane(), tid = wid * 64 + lane, r32 = lane & 31, hi = lane >> 5;
    const int hh = wid >> 1, head = g * 4 + hh, qoff = (wid & 1) * 32 + r32, t = qi * 64 + qoff;
    const size_t tok = (size_t)b * SEQ + t;
    bf16x8 qr[8];
    { const bf16_t* Qw = P.Q + tok * 1024 + head * 128 + hi * 8;
#pragma unroll
      for (int d0 = 0; d0 < 8; ++d0) qr[d0] = *(const bf16x8*)(Qw + d0 * 16); }
    { float x[8][8]; float ss = 0.f;
#pragma unroll
      for (int d0 = 0; d0 < 8; ++d0) { const u32x4 w = __builtin_bit_cast(u32x4, qr[d0]);
          x[d0][0] = bf_lo(w.x); x[d0][1] = bf_hi(w.x); x[d0][2] = bf_lo(w.y); x[d0][3] = bf_hi(w.y); x[d0][4] = bf_lo(w.z); x[d0][5] = bf_hi(w.z); x[d0][6] = bf_lo(w.w); x[d0][7] = bf_hi(w.w);
#pragma unroll
          for (int e = 0; e < 8; ++e) ss += x[d0][e] * x[d0][e]; }
      ss = half_sum(ss);
      const float rstd = rsqrtf(ss * (1.0f / 128.0f) + 1e-6f);
#pragma unroll
      for (int d0 = 0; d0 < 8; ++d0) { const f32x4 ga = *(const f32x4*)(P.qng + d0 * 16 + hi * 8), gb = *(const f32x4*)(P.qng + d0 * 16 + hi * 8 + 4);
#pragma unroll
          for (int e = 0; e < 8; ++e) x[d0][e] = x[d0][e] * rstd * (e < 4 ? ga[e] : gb[e - 4]); }
      { const int ti = t * 16 + hi * 8;
        const f32x4 c0 = *(const f32x4*)(P.cosT + ti), c1 = *(const f32x4*)(P.cosT + ti + 4), s0 = *(const f32x4*)(P.sinT + ti), s1 = *(const f32x4*)(P.sinT + ti + 4);
#pragma unroll
        for (int e = 0; e < 8; ++e) { const float cs = e < 4 ? c0[e] : c1[e - 4], sn = e < 4 ? s0[e] : s1[e - 4]; const float x1 = x[0][e], x2 = x[1][e];
            x[0][e] = x1 * cs - x2 * sn; x[1][e] = x2 * cs + x1 * sn; } }
#pragma unroll
      for (int d0 = 0; d0 < 8; ++d0) { u32x4 w; w.x = cvt_pk_bf16(x[d0][0], x[d0][1]); w.y = cvt_pk_bf16(x[d0][2], x[d0][3]); w.z = cvt_pk_bf16(x[d0][4], x[d0][5]); w.w = cvt_pk_bf16(x[d0][6], x[d0][7]);
          qr[d0] = __builtin_bit_cast(bf16x8, w); } }
    const float* gl = P.GLOG + tok * 32 + head * 3;
    const float g_c = sigmoidf_(gl[0]), g_s = sigmoidf_(gl[1]), g_w = sigmoidf_(gl[2]);
    const size_t kvo = (size_t)((b * 2 + g) * SEQ) * 128, cmo = (size_t)((b * 2 + g) * NCMP) * 128;
    const bf16_t* Ks = P.KV + 2 * (KV_STRIDE / 2) + kvo; const bf16_t* Vs = P.KV + 3 * (KV_STRIDE / 2) + kvo;
    const bf16_t* Kw = P.KV + 4 * (KV_STRIDE / 2) + kvo; const bf16_t* Vw = P.KV + 5 * (KV_STRIDE / 2) + kvo;
    const bf16_t* Kc = P.KCMP + cmo; const bf16_t* Vc = P.VCMP + cmo;
    float* bs = (float*)(lds + L_BS);
    unsigned* selm = (unsigned*)(lds + L_SEL); unsigned* uni = (unsigned*)(lds + L_UNI); int* tlist = (int*)(lds + L_LIST);
    for (int i = tid; i < 64 * BS_STRIDE; i += 512) ((unsigned*)bs)[i] = 0u;
    if (tid < 8) uni[tid] = 0u;
    __syncthreads();
    bf16_t* mixrow0 = P.MIX + ((size_t)b * SEQ + qi * 64 + (wid & 1) * 32) * 2048 + head * 128;
    unsigned selw[4] = {0u, 0u, 0u, 0u};
    f32x16 o[4];
    u32x8 out[4];
    const int nmax = (t - 31) >> 4;
    const int ntc = ((4 * qi + 2) >> 6) + 1;
    float m_c = -1e30f, l_c = 0.f;
    if (IMPL == 0) branch_ref<0>(lds, Kc, Vc, qr, ntc, qi, qoff, nmax, selw, m_c, l_c, 0.f, o, wid); else branch<0, false>(lds, Kc, Vc, qr, ntc, qi, qoff, nmax, selw, m_c, l_c, 0.f, o, wid, cv);
    const float inv_lc = l_c > 0.f ? 1.0f / l_c : 0.f;
#pragma unroll
    for (int d = 0; d < 4; ++d) o[d] = f32x16{};
    if (IMPL == 0) branch_ref<1>(lds, Kc, Vc, qr, ntc, qi, qoff, nmax, selw, m_c, l_c, inv_lc, o, wid); else branch<1, false>(lds, Kc, Vc, qr, ntc, qi, qoff, nmax, selw, m_c, l_c, inv_lc, o, wid, cv);
    if (IMPL == 1) accum_out(lds, o, g_c, out, wid, true); else finalize<0>(lds, o, g_c, P.scr, mixrow0, wid);
    __syncthreads();
    if (IMPL == 0) {
    {
        const int cur = qi;
        for (int qq = 0; qq < 8; ++qq) {
            const int q = wid * 8 + qq;
            unsigned mk0 = 0u, mk1 = 0u, mk2 = 0u, mk3 = 0u;
#define MK_SET(idx) do { const int _w = (idx) >> 5; const unsigned _b = 1u << ((idx) & 31); mk0 |= _w == 0 ? _b : 0u; mk1 |= _w == 1 ? _b : 0u; mk2 |= _w == 2 ? _b : 0u; mk3 |= _w == 3 ? _b : 0u; } while (0)
            if (cur <= 15) { mk0 = (1u << (cur + 1)) - 1u; }
            else {
                MK_SET(0); MK_SET(cur); MK_SET(cur - 1);
                const int j0 = lane, j1 = lane + 64;
                const unsigned* bsu = (const unsigned*)bs;
                unsigned s0 = (j0 >= 1 && j0 <= cur - 2) ? bsu[q * BS_STRIDE + j0] + 1u : 0u;
                unsigned s1 = (j1 <= cur - 2) ? bsu[q * BS_STRIDE + j1] + 1u : 0u;
                for (int it = 0; it < 13; ++it) {
                    unsigned bv; int bi;
                    if (s1 > s0) { bv = s1; bi = j1; } else { bv = s0; bi = j0; }
#pragma unroll
                    for (int off = 1; off < 64; off <<= 1) { const unsigned ov = (unsigned)__shfl_xor((int)bv, off); const int oi = __shfl_xor(bi, off); if (ov > bv || (ov == bv && oi < bi)) { bv = ov; bi = oi; } }
                    bi = __builtin_amdgcn_readfirstlane(bi);
                    MK_SET(bi);
                    if (bi == j0) s0 = 0u;
                    if (bi == j1) s1 = 0u;
                }
            }
#undef MK_SET
            if (lane < 4) { const unsigned v = lane == 0 ? mk0 : lane == 1 ? mk1 : lane == 2 ? mk2 : mk3; selm[q * 4 + lane] = v; atomicOr(&uni[lane], v); }
        }
    }
    } else {
    {
        const int cur = qi;
        if (cur <= 15) {
            if (lane < 4) { const unsigned v = lane == 0 ? ((1u << (cur + 1)) - 1u) : 0u;
#pragma unroll
                for (int qq = 0; qq < 8; ++qq) selm[(wid * 8 + qq) * 4 + lane] = v;
                atomicOr(&uni[lane], v); }
        } else {
            const unsigned* bsu = (const unsigned*)bs; const int j0 = lane, j1 = lane + 64;
            const bool v0 = j0 >= 1 && j0 <= cur - 2, v1 = j1 <= cur - 2;
#pragma unroll 1
            for (int qb = 0; qb < 8; qb += 4) {
                unsigned s0[4], s1[4]; unsigned long long ma[4], mb[4];
#pragma unroll
                for (int u = 0; u < 4; ++u) { const int q = wid * 8 + qb + u;
                    s0[u] = v0 ? bsu[q * BS_STRIDE + j0] + 1u : 0u; s1[u] = v1 ? bsu[q * BS_STRIDE + j1] + 1u : 0u;
                    ma[u] = 1ull; mb[u] = 0ull;
                    if (cur < 64) ma[u] |= 1ull << cur; else mb[u] |= 1ull << (cur - 64);
                    if (cur - 1 < 64) ma[u] |= 1ull << (cur - 1); else mb[u] |= 1ull << (cur - 65); }
#pragma unroll 1
                for (int it = 0; it < 13; ++it) {
#pragma unroll
                    for (int u = 0; u < 4; ++u) {
                        unsigned v = s0[u] > s1[u] ? s0[u] : s1[u];
                        { unsigned t;
                          t = (unsigned)__builtin_amdgcn_update_dpp(0, (int)v, 0x111, 0xf, 0xf, false); v = v > t ? v : t;
                          t = (unsigned)__builtin_amdgcn_update_dpp(0, (int)v, 0x112, 0xf, 0xf, false); v = v > t ? v : t;
                          t = (unsigned)__builtin_amdgcn_update_dpp(0, (int)v, 0x114, 0xf, 0xf, false); v = v > t ? v : t;
                          t = (unsigned)__builtin_amdgcn_update_dpp(0, (int)v, 0x118, 0xf, 0xf, false); v = v > t ? v : t;
                          t = (unsigned)__builtin_amdgcn_update_dpp(0, (int)v, 0x142, 0xa, 0xf, false); v = v > t ? v : t;
                          t = (unsigned)__builtin_amdgcn_update_dpp(0, (int)v, 0x143, 0xc, 0xf, false); v = v > t ? v : t; }
                        const unsigned m = (unsigned)__builtin_amdgcn_readlane((int)v, 63);
                        const unsigned long long b0 = __ballot(s0[u] == m), b1 = __ballot(s1[u] == m);
                        if (b0) { const int idx = __builtin_ctzll(b0); ma[u] |= 1ull << idx; if (lane == idx) s0[u] = 0u; }
                        else    { const int idx = __builtin_ctzll(b1); mb[u] |= 1ull << idx; if (lane == idx) s1[u] = 0u; }
                    }
                }
#pragma unroll
                for (int u = 0; u < 4; ++u) { const int q = wid * 8 + qb + u;
                    if (lane < 4) { const unsigned v = lane == 0 ? (unsigned)ma[u] : lane == 1 ? (unsigned)(ma[u] >> 32) : lane == 2 ? (unsigned)mb[u] : (unsigned)(mb[u] >> 32); selm[q * 4 + lane] = v; atomicOr(&uni[lane], v); } }
            }
        }
    }
    }
    __syncthreads();
    if (tid < 128) {
        const unsigned w = uni[tid >> 5]; const bool on = (w >> (tid & 31)) & 1u;
        if (on) { int pos = __popc(w & ((1u << (tid & 31)) - 1u)); for (int k = 0; k < (tid >> 5); ++k) pos += __popc(uni[k]); tlist[pos] = tid; }
    }
    const int nsel = __popc(uni[0]) + __popc(uni[1]) + __popc(uni[2]) + __popc(uni[3]);
#pragma unroll
    for (int k = 0; k < 4; ++k) selw[k] = selm[qoff * 4 + k];
    __syncthreads();
    { float m_s = -1e30f, l_s = 0.f;
#pragma unroll
      for (int d = 0; d < 4; ++d) o[d] = f32x16{};
      if (IMPL == 0) branch_ref<2>(lds, Ks, Vs, qr, nsel, qi, qoff, 0, selw, m_s, l_s, 0.f, o, wid); else { conv_prime(lds, cv, nsel + (qi - ((qi - 8 > 0) ? qi - 8 : 0) + 1), wid); if (wid >= 4) { if (cv.live) branch_stag<2, true, true>(lds, Ks, Vs, qr, nsel, qi, qoff, selw, m_s, l_s, o, wid, cv); else branch_stag<2, false, true>(lds, Ks, Vs, qr, nsel, qi, qoff, selw, m_s, l_s, o, wid, cv); }
        else { if (cv.live) branch_stag<2, true, false>(lds, Ks, Vs, qr, nsel, qi, qoff, selw, m_s, l_s, o, wid, cv); else branch_stag<2, false, false>(lds, Ks, Vs, qr, nsel, qi, qoff, selw, m_s, l_s, o, wid, cv); } }
      if (IMPL == 1) accum_out(lds, o, l_s > 0.f ? g_s / l_s : 0.f, out, wid, false); else finalize<1>(lds, o, l_s > 0.f ? g_s / l_s : 0.f, P.scr, mixrow0, wid); }
    { float m_w = -1e30f, l_w = 0.f;
#pragma unroll
      for (int d = 0; d < 4; ++d) o[d] = f32x16{};
      const int j0w = (qi - 8 > 0) ? qi - 8 : 0;
      if (IMPL == 0) branch_ref<3>(lds, Kw, Vw, qr, qi - j0w + 1, qi, qoff, 0, selw, m_w, l_w, 0.f, o, wid); else { if (wid >= 4) { if (cv.live) branch_stag<3, true, true>(lds, Kw, Vw, qr, qi - j0w + 1, qi, qoff, selw, m_w, l_w, o, wid, cv); else branch_stag<3, false, true>(lds, Kw, Vw, qr, qi - j0w + 1, qi, qoff, selw, m_w, l_w, o, wid, cv); }
        else { if (cv.live) branch_stag<3, true, false>(lds, Kw, Vw, qr, qi - j0w + 1, qi, qoff, selw, m_w, l_w, o, wid, cv); else branch_stag<3, false, false>(lds, Kw, Vw, qr, qi - j0w + 1, qi, qoff, selw, m_w, l_w, o, wid, cv); } conv_drain(lds, cv, wid); }
      if (IMPL == 1) { accum_out(lds, o, l_w > 0.f ? g_w / l_w : 0.f, out, wid, false); store_out<CHECK>(lds, out, mixrow0, wid, err); }
      else finalize<2, CHECK>(lds, o, l_w > 0.f ? g_w / l_w : 0.f, P.scr, mixrow0, wid, err); }
    __syncthreads();
}
}

struct Frame {
    LAS unsigned char* lds; char* ldsg;
    unsigned* ctl; unsigned char* ws;
    int wave, G, c;
};
#define FRESH_TID() const int lane = fresh_lane(); const int tid = F.wave * 64 + lane; (void)tid; (void)lane
__constant__ float c_inv_freq[16] = {1.0f, 0.44036659598350525f, 0.1939227432012558f, 0.08539710193872452f, 0.03760603070259094f, 0.016560440883040428f, 0.007292664609849453f,
    0.0032114461064338684f, 0.0014142135623842478f, 0.0006227724370546639f, 0.00027424818836152554f, 0.00012076973507646471f, 5.3182957344688475e-05f, 2.34199997066753e-05f,
    1.0313385246263351e-05f, 4.541670477919979e-06f};

template <int MODE> __device__ __forceinline__ int rowmap(int n) {
    if (MODE == 1) return n < 2560 ? n : (n < 2584 ? 3584 + (n - 2560) : n - 24);
    if (MODE == 2) return n < 2048 ? ((n >> 7) * 256 + (n & 127)) : (((n - 2048) >> 7) * 256 + 128 + ((n - 2048) & 127));
    return n;
}
struct TrMat { const float* W; bf16_t* WT; int K, N, ldt, mode, nkt, nnt; };
__device__ __forceinline__ void tr_load(const TrMat& M, int kt, int nt, int w, int lane, f32x4 (&v)[8]) {
    const int n = nt * 128 + (lane & 31) * 4, kb = kt * 128 + w * 16 + (lane >> 5) * 8;
    const bool ok = n < M.N; const float* p = M.W + (size_t)kb * M.N + (ok ? n : 0);
#pragma unroll
    for (int i = 0; i < 8; ++i) v[i] = *(const f32x4*)(p + (size_t)i * M.N);
}
__device__ __forceinline__ void tr_lds_write(LAS unsigned* buf, int w, int lane, const f32x4 (&v)[8]) {
#pragma unroll
    for (int i2 = 0; i2 < 4; ++i2) { const int kp = w * 8 + (lane >> 5) * 4 + i2;
        u32x4 o; o.x = cvt_pk_bf16(v[2 * i2][0], v[2 * i2 + 1][0]); o.y = cvt_pk_bf16(v[2 * i2][1], v[2 * i2 + 1][1]); o.z = cvt_pk_bf16(v[2 * i2][2], v[2 * i2 + 1][2]); o.w = cvt_pk_bf16(v[2 * i2][3], v[2 * i2 + 1][3]);
        *(LAS u32x4*)(buf + kp * 128 + (((lane & 31) * 4) ^ (4 * ((kp >> 2) & 7)))) = o; }
}
__device__ __forceinline__ void tr_store(const TrMat& M, int kt, int nt, const LAS unsigned* buf, int tid) {
#pragma unroll
    for (int q = 0; q < 4; ++q) { const int idx = tid + 512 * q, nl = idx >> 4, kg = idx & 15, n = nt * 128 + nl;
        u32x4 o; const LAS unsigned* b = buf + (kg * 4) * 128 + (nl ^ (4 * (kg & 7)));
        o.x = b[0]; o.y = b[128]; o.z = b[256]; o.w = b[384];
        if (n < M.N) { const int row = M.mode == 1 ? rowmap<1>(n) : n; *(u32x4*)(M.WT + (size_t)row * M.ldt + kt * 128 + kg * 8) = o; } }
}
__device__ __forceinline__ unsigned pk4_fp8(float a, float b, float c, float d) { int p = __builtin_amdgcn_cvt_pk_fp8_f32(a, b, 0, false); p = __builtin_amdgcn_cvt_pk_fp8_f32(c, d, p, true); return (unsigned)p; }
__device__ __forceinline__ void tr_lds_write8(LAS unsigned* buf, int w, int lane, const f32x4 (&v)[8]) {
#pragma unroll
    for (int i2 = 0; i2 < 2; ++i2) { const int kq = w * 4 + (lane >> 5) * 2 + i2;
        u32x4 o;
#pragma unroll
        for (int j = 0; j < 4; ++j) o[j] = pk4_fp8(v[4 * i2][j] * 64.0f, v[4 * i2 + 1][j] * 64.0f, v[4 * i2 + 2][j] * 64.0f, v[4 * i2 + 3][j] * 64.0f);
        *(LAS u32x4*)(buf + kq * 128 + (((lane & 31) * 4) ^ (4 * ((kq >> 2) & 7)))) = o; }
}
__device__ __forceinline__ void tr_store8(const TrMat& M, int kt, int nt, const LAS unsigned* buf, int tid) {
#pragma unroll
    for (int q = 0; q < 2; ++q) { const int idx = tid + 512 * q, nl = idx >> 3, kg = idx & 7, n = nt * 128 + nl;
        u32x4 o; const LAS unsigned* b = buf + (kg * 4) * 128 + (nl ^ (4 * kg));
        o.x = b[0]; o.y = b[128]; o.z = b[256]; o.w = b[384];
        const int row = M.mode == 2 ? rowmap<2>(n) : n; *(u32x4*)((unsigned char*)M.WT + ((size_t)(kt * 8 + kg) * M.N + row) * 16) = o; }
}
__device__ __forceinline__ bool tr_pick(const Frame& F, const Args& A, int id, TrMat& M, int& kt, int& nt) {
    constexpr int T_GU = 16 * 32, T_DN = 16 * 16, T_IN = 16 * 29, T_OUT = 16 * 16, T_W1 = 32 * 2, T_PW = 2 * 2, T_W2 = 2;
    int r = id;
    if (r < 32 * T_GU) { const int e = r / T_GU; r %= T_GU; M = TrMat{A.in[I_WGU] + (size_t)e * 2048 * 4096, (bf16_t*)(F.ws + WS_WGU + (size_t)e * 4096 * 2048), 2048, 4096, 2048, 2, 16, 32}; }
    else if ((r -= 32 * T_GU) < 32 * T_DN) { const int e = r / T_DN; r %= T_DN; M = TrMat{A.in[I_WD] + (size_t)e * 2048 * 2048, (bf16_t*)(F.ws + WS_WD + (size_t)e * 2048 * 2048), 2048, 2048, 2048, 3, 16, 16}; }
    else if ((r -= 32 * T_DN) < T_IN) { M = TrMat{A.in[I_WIN], (bf16_t*)(F.ws + WS_WINT), 2048, 3608, 2048, 1, 16, 29}; }
    else if ((r -= T_IN) < T_OUT) { M = TrMat{A.in[I_WOUT], (bf16_t*)(F.ws + WS_WOUTT), 2048, 2048, 2048, 0, 16, 16}; }
    else if ((r -= T_OUT) < 2 * T_W1) { const int kv = r / T_W1; r %= T_W1; M = TrMat{kv ? A.in[I_CVW1] : A.in[I_CKW1], (bf16_t*)(F.ws + WS_W1T) + (size_t)kv * 256 * 4096, 4096, 256, 4096, 0, 32, 2}; }
    else if ((r -= 2 * T_W1) < 4 * T_PW) { const int g = r / T_PW; r %= T_PW; M = TrMat{A.in[I_POOLW] + (size_t)g * 65536, (bf16_t*)(F.ws + WS_PWT) + (size_t)g * 65536, 256, 256, 256, 0, 2, 2}; }
    else if ((r -= 4 * T_PW) < 2 * T_W2) { const int kv = r / T_W2; r %= T_W2; M = TrMat{kv ? A.in[I_CVW2] : A.in[I_CKW2], (bf16_t*)(F.ws + WS_W2T) + (size_t)kv * 128 * 256, 256, 128, 256, 0, 2, 1}; }
    else return false;
    kt = r / M.nnt; nt = r % M.nnt; return true;
}
constexpr int NMOE_TILES = 32 * (16 * 32 + 16 * 16);
__device__ __forceinline__ void convert_tiles(const Frame& F, const Args& A, int first, int stride, int end) {
    FRESH_TID();
    LAS unsigned* tb0 = (LAS unsigned*)F.lds; TrMat MA, MB; int ktA = 0, ntA = 0, ktB = 0, ntB = 0; f32x4 vA[8], vB[8];
    int id = first;
    bool haveA = id < end && tr_pick(F, A, id, MA, ktA, ntA); if (haveA) tr_load(MA, ktA, ntA, F.wave, lane, vA);
    bool haveB = id + stride < end && tr_pick(F, A, id + stride, MB, ktB, ntB); if (haveB) tr_load(MB, ktB, ntB, F.wave, lane, vB);
    id += 2 * stride;
    while (haveA) {
        { LAS unsigned* buf = tb0;
          if (MA.mode >= 2) tr_lds_write8(buf, F.wave, lane, vA); else tr_lds_write(buf, F.wave, lane, vA);
          __syncthreads();
          const TrMat Mc = MA; const int ktc = ktA, ntc = ntA;
          haveA = id < end && tr_pick(F, A, id, MA, ktA, ntA); if (haveA) tr_load(MA, ktA, ntA, F.wave, lane, vA);
          if (Mc.mode >= 2) tr_store8(Mc, ktc, ntc, buf, tid); else tr_store(Mc, ktc, ntc, buf, tid); }
        if (!haveB) break;
        { LAS unsigned* buf = tb0 + 8192;
          if (MB.mode >= 2) tr_lds_write8(buf, F.wave, lane, vB); else tr_lds_write(buf, F.wave, lane, vB);
          __syncthreads();
          const TrMat Mc = MB; const int ktc = ktB, ntc = ntB;
          haveB = id + stride < end && tr_pick(F, A, id + stride, MB, ktB, ntB); if (haveB) tr_load(MB, ktB, ntB, F.wave, lane, vB);
          if (Mc.mode >= 2) tr_store8(Mc, ktc, ntc, buf, tid); else tr_store(Mc, ktc, ntc, buf, tid); }
        id += 2 * stride;
    }
    __syncthreads();
}
__device__ __forceinline__ void posb_partials(const Frame& F, const Args& A, int rank, int n) {
    FRESH_TID();
    float* pb = (float*)(F.ws + WS_POSB64);
    for (long i = (long)rank * 512 + tid; i < 64 * 512; i += (long)n * 512) { const int o = (int)(i & 511), ks = (int)(i >> 9), kv = o >> 8, h = o & 255;
        const float* pos = kv ? A.in[I_CVPOS] : A.in[I_CKPOS]; const float* w1 = kv ? A.in[I_CVW1] : A.in[I_CKW1]; float s0 = 0.f, s1 = 0.f, s2 = 0.f, s3 = 0.f;
#pragma unroll 4
        for (int r = ks * 64; r < ks * 64 + 64; r += 4) { s0 = fmaf(pos[r], w1[(size_t)r * 256 + h], s0); s1 = fmaf(pos[r + 1], w1[(size_t)(r + 1) * 256 + h], s1); s2 = fmaf(pos[r + 2], w1[(size_t)(r + 2) * 256 + h], s2); s3 = fmaf(pos[r + 3], w1[(size_t)(r + 3) * 256 + h], s3); }
        pb[i] = (s0 + s1) + (s2 + s3); }
}
__device__ __forceinline__ void phase0(const Frame& F, const Args& A) {
    FRESH_TID();
    const int gw = F.c * NWAVES + F.wave, NGW = F.G * NWAVES;
    const long gt = (long)F.c * 512 + tid, NT = (long)F.G * 512;
    { const float* x = A.in[I_X]; const float* g1 = A.in[I_N1G]; bf16_t* H = (bf16_t*)(F.ws + WS_H);
      for (int row = gw; row < NTOK; row += 2 * NGW) {
        const bool hasB = row + NGW < NTOK; const int rowB = hasB ? row + NGW : row;
        const f32x4* xa = (const f32x4*)(x + (size_t)row * DM) + lane; const f32x4* xb = (const f32x4*)(x + (size_t)rowB * DM) + lane; f32x4 va[8], vb[8]; float sa = 0.f, sb = 0.f;
#pragma unroll
        for (int j = 0; j < 8; ++j) { va[j] = xa[64 * j]; vb[j] = xb[64 * j]; }
#pragma unroll
        for (int j = 0; j < 8; ++j) { sa += (va[j][0] * va[j][0] + va[j][1] * va[j][1]) + (va[j][2] * va[j][2] + va[j][3] * va[j][3]); sb += (vb[j][0] * vb[j][0] + vb[j][1] * vb[j][1]) + (vb[j][2] * vb[j][2] + vb[j][3] * vb[j][3]); }
        const float ra = rsqrtf(wave_sum(sa) * (1.0f / DM) + 1e-5f), rb = rsqrtf(wave_sum(sb) * (1.0f / DM) + 1e-5f);
        u32x2* oa = (u32x2*)(H + (size_t)row * DM) + lane; u32x2* ob = (u32x2*)(H + (size_t)rowB * DM) + lane;
#pragma unroll
        for (int j = 0; j < 8; ++j) { const f32x4 gg = ((const f32x4*)g1)[64 * j + lane]; u32x2 w;
            w.x = cvt_pk_bf16(va[j][0] * ra * gg[0], va[j][1] * ra * gg[1]); w.y = cvt_pk_bf16(va[j][2] * ra * gg[2], va[j][3] * ra * gg[3]); oa[64 * j] = w;
            if (hasB) { w.x = cvt_pk_bf16(vb[j][0] * rb * gg[0], vb[j][1] * rb * gg[1]); w.y = cvt_pk_bf16(vb[j][2] * rb * gg[2], vb[j][3] * rb * gg[3]); ob[64 * j] = w; } }
      } }
    convert_tiles(F, A, (F.G == 256 ? NMOE_TILES : 0) + F.c, F.G, F.G == 256 ? NMOE_TILES + 16 * 29 : 1 << 30);
    { u32x4* z = (u32x4*)((bf16_t*)(F.ws + WS_WINT) + (size_t)3608 * 2048); const long n16 = (long)(NINP - 3608) * 2048 * 2 / 16;
      for (long i = gt; i < n16; i += NT) z[i] = (u32x4){0u, 0u, 0u, 0u}; }
    { float* tc = (float*)(F.ws + WS_COS); float* tsn = (float*)(F.ws + WS_SIN);
      for (long i = gt; i < 8208 * 16; i += NT) { const int pos = (int)(i >> 4), k = (int)(i & 15);
        const float ang = (float)pos * c_inv_freq[k]; double xr = (double)ang * 0.15915494309189535; xr -= __builtin_rint(xr);
        tc[i] = __builtin_amdgcn_cosf((float)xr); tsn[i] = __builtin_amdgcn_sinf((float)xr); } }
}

struct RowJob { bf16_t* p; u32x4 raw; f32x4 g0, g1, c0, c1, s0, s1; };
__device__ __forceinline__ void rowjob_issue(RowJob& J, const Frame& F, const Args& A, int row, int sub) {
    constexpr int NQ = NTOK * 8, NK = NB * NGRP * SEQ;
    bf16_t* Q = (bf16_t*)(F.ws + WS_Q); bf16_t* KS = (bf16_t*)(F.ws + WS_KV + 2 * KV_STRIDE); bf16_t* KW = (bf16_t*)(F.ws + WS_KV + 4 * KV_STRIDE);
    const float* tc = (const float*)(F.ws + WS_COS); const float* tsn = (const float*)(F.ws + WS_SIN);
    const float* gain; int pos;
    if (row < NQ) { J.p = Q + (size_t)row * 128; gain = A.in[I_QNG]; pos = (row >> 3) & (SEQ - 1); }
    else if (row < NQ + NK) { const int r = row - NQ; J.p = KS + (size_t)r * 128; gain = A.in[I_KNS]; pos = r & (SEQ - 1); }
    else { const int r = row - NQ - NK; J.p = KW + (size_t)r * 128; gain = A.in[I_KNW]; pos = r & (SEQ - 1); }
    J.raw = *(const u32x4*)(J.p + sub * 8);
    J.g0 = *(const f32x4*)(gain + sub * 8); J.g1 = *(const f32x4*)(gain + sub * 8 + 4);
    const int ti = pos * 16 + (sub & 1) * 8;
    J.c0 = *(const f32x4*)(tc + ti); J.c1 = *(const f32x4*)(tc + ti + 4); J.s0 = *(const f32x4*)(tsn + ti); J.s1 = *(const f32x4*)(tsn + ti + 4);
}
__device__ __forceinline__ void rowjob_finish(const RowJob& J, int sub) {
    const u32x4 raw = J.raw;
    float x[8] = {bf_lo(raw.x), bf_hi(raw.x), bf_lo(raw.y), bf_hi(raw.y), bf_lo(raw.z), bf_hi(raw.z), bf_lo(raw.w), bf_hi(raw.w)};
    float ss = 0.f;
#pragma unroll
    for (int j = 0; j < 8; ++j) ss += x[j] * x[j];
    ss += __shfl_xor(ss, 1); ss += __shfl_xor(ss, 2); ss += __shfl_xor(ss, 4); ss += __shfl_xor(ss, 8);
    const float rstd = rsqrtf(ss * (1.0f / 128.0f) + 1e-6f);
#pragma unroll
    for (int j = 0; j < 8; ++j) x[j] = x[j] * rstd * (j < 4 ? J.g0[j] : J.g1[j - 4]);
#pragma unroll
    for (int j = 0; j < 8; ++j) { const float other = __shfl_xor(x[j], 2); const float cs = j < 4 ? J.c0[j] : J.c1[j - 4], sn = j < 4 ? J.s0[j] : J.s1[j - 4];
        const float rot = (sub < 2) ? (x[j] * cs - other * sn) : (x[j] * cs + other * sn); x[j] = sub < 4 ? rot : x[j]; }
    u32x4 w; w.x = cvt_pk_bf16(x[0], x[1]); w.y = cvt_pk_bf16(x[2], x[3]); w.z = cvt_pk_bf16(x[4], x[5]); w.w = cvt_pk_bf16(x[6], x[7]);
    *(u32x4*)(J.p + sub * 8) = w;
}
constexpr int NROPE_ITEM = (NTOK * 8 + 2 * NB * NGRP * SEQ) / 4;
constexpr int NROPE_Q = NTOK * 8 / 4;
constexpr int P2_ROPE_SPLIT = NROPE_ITEM;
__device__ __forceinline__ void norm_rope_rows(const Frame& F, const Args& A, int ec, int eG, int it0 = NROPE_Q, int it1 = NROPE_ITEM) {
    FRESH_TID();
    const int gw = ec * NWAVES + F.wave, NGW = eG * NWAVES, sub = lane & 15, rsel = lane >> 4;
    for (int it = it0 + gw; it < it1; it += 2 * NGW) {
        RowJob JA, JB; const bool hasB = it + NGW < it1;
        rowjob_issue(JA, F, A, it * 4 + rsel, sub);
        if (hasB) rowjob_issue(JB, F, A, (it + NGW) * 4 + rsel, sub);
        rowjob_finish(JA, sub);
        if (hasB) rowjob_finish(JB, sub);
    }
}
template <int W> __device__ __forceinline__ void pool_item4(const bf16_t* PIN, bf16_t* DP, int tok0, int c8) {
    const int s0 = tok0 & (SEQ - 1);
    u32x4 raw[W + 3];
#pragma unroll
    for (int r = 0; r < W + 3; ++r) { const int rel = r - (W - 1); const int tr = (s0 + rel >= 0) ? tok0 + rel : tok0;
        raw[r] = *(const u32x4*)(PIN + (size_t)tr * 1024 + c8 * 8); }
#pragma unroll
    for (int k = 0; k < 4; ++k) { const int s = s0 + k;
        float acc[8] = {0.f, 0.f, 0.f, 0.f, 0.f, 0.f, 0.f, 0.f};
#pragma unroll
        for (int j = 0; j < W; ++j) { const float wg = j <= s ? 1.f : 0.f; const u32x4 r = raw[W - 1 + k - j];
            acc[0] = fmaf(bf_lo(r.x), wg, acc[0]); acc[1] = fmaf(bf_hi(r.x), wg, acc[1]); acc[2] = fmaf(bf_lo(r.y), wg, acc[2]); acc[3] = fmaf(bf_hi(r.y), wg, acc[3]);
            acc[4] = fmaf(bf_lo(r.z), wg, acc[4]); acc[5] = fmaf(bf_hi(r.z), wg, acc[5]); acc[6] = fmaf(bf_lo(r.w), wg, acc[6]); acc[7] = fmaf(bf_hi(r.w), wg, acc[7]); }
        const u32x4 r0 = raw[W - 1 + k]; const float cur[8] = {bf_lo(r0.x), bf_hi(r0.x), bf_lo(r0.y), bf_hi(r0.y), bf_lo(r0.z), bf_hi(r0.z), bf_lo(r0.w), bf_hi(r0.w)};
        const float inv = 1.0f / (float)((s + 1 < W) ? s + 1 : W); float d[8];
#pragma unroll
        for (int q = 0; q < 8; ++q) d[q] = acc[q] * inv - cur[q];
        u32x4 o; o.x = cvt_pk_bf16(d[0], d[1]); o.y = cvt_pk_bf16(d[2], d[3]); o.z = cvt_pk_bf16(d[4], d[5]); o.w = cvt_pk_bf16(d[6], d[7]);
        *(u32x4*)(DP + (size_t)(tok0 + k) * 1024 + c8 * 8) = o; }
}
__device__ __forceinline__ void pool_diffs(const Frame& F, int ec, int eG) {
    const bf16_t* PIN = (const bf16_t*)(F.ws + WS_PIN); bf16_t* DP = (bf16_t*)(F.ws + WS_DP);
    FRESH_TID();
    const long gt = (long)ec * 512 + tid, NT = (long)eG * 512;
    for (long i = gt; i < 4L * (NTOK / 4) * 32; i += NT) {
        const int g = (int)(i >> 17), tok0 = (int)((i >> 5) & (NTOK / 4 - 1)) * 4, c8 = g * 32 + (int)(i & 31);
        if (g == 0) pool_item4<2>(PIN, DP, tok0, c8); else if (g == 1) pool_item4<4>(PIN, DP, tok0, c8); else if (g == 2) pool_item4<8>(PIN, DP, tok0, c8); else pool_item4<16>(PIN, DP, tok0, c8);
    }
}
__device__ __forceinline__ void cmp_bias_total(const Frame& F, const Args& A) {
    FRESH_TID();
    const float* posb = (const float*)(F.ws + WS_POSB64); float* bt = (float*)(F.ws + WS_POSB + 65536 - 2048);
#pragma unroll
    for (int q = 0; q < 8; ++q) { const int o = q * 64 + lane; float sacc = (o < 256 ? A.in[I_CKB1] : A.in[I_CVB1])[o & 255];
        for (int p = 0; p < 64; ++p) sacc += posb[p * 512 + o];
        bt[o] = sacc; }
}
__device__ __forceinline__ void cmp_layer2(const Frame& F, const Args& A, int kv, int rg) {
    FRESH_TID();
    const int w = F.wave, l15 = lane & 15, q4 = lane >> 4;
    const float* HP = (const float*)(F.ws + WS_ACT); const bf16_t* W2T = (const bf16_t*)(F.ws + WS_W2T) + (size_t)kv * 128 * 256;
    const float* bt = (const float*)(F.ws + WS_POSB + 65536 - 2048) + kv * 256;
    LAS f32x4* red = (LAS f32x4*)F.lds;
    { const int rowA = rg * 16 + l15, k0 = w * 32 + q4 * 8;
      f32x4 h0 = *(const f32x4*)(bt + k0), h1 = *(const f32x4*)(bt + k0 + 4);
#pragma unroll
      for (int p = 0; p < 4; ++p) { const float* src = HP + ((size_t)(p * 2 + kv) * 2048 + rowA) * 256 + k0; h0 += *(const f32x4*)src; h1 += *(const f32x4*)(src + 4); }
      float g[8];
#pragma unroll
      for (int j = 0; j < 8; ++j) { const float x = j < 4 ? h0[j] : h1[j - 4]; const float uu = 0.7978845608028654f * (x + 0.044715f * x * x * x);
          g[j] = x * fast_rcp(1.0f + fast_exp2(-2.885390081777927f * uu)); }
      auto f2b = [](float f) -> unsigned { unsigned u = __float_as_uint(f); return (u + 0x7fffu + ((u >> 16) & 1u)) >> 16; };
      u32x4 aw; aw.x = f2b(g[0]) | (f2b(g[1]) << 16); aw.y = f2b(g[2]) | (f2b(g[3]) << 16); aw.z = f2b(g[4]) | (f2b(g[5]) << 16); aw.w = f2b(g[6]) | (f2b(g[7]) << 16);
      const bf16x8 a = *reinterpret_cast<const bf16x8*>(&aw);
#pragma unroll
      for (int nt = 0; nt < 8; ++nt) { const bf16x8 b = *(const bf16x8*)(W2T + (size_t)(nt * 16 + l15) * 256 + w * 32 + q4 * 8);
          const f32x4 z = {0.f, 0.f, 0.f, 0.f}; red[(w * 8 + nt) * 64 + lane] = __builtin_amdgcn_mfma_f32_16x16x32_bf16(a, b, z, 0, 0, 0); } }
    __syncthreads();
    if (w == 0) {
        bf16_t* OUT = (bf16_t*)(F.ws + WS_CMP + (kv ? 512 * 1024 : 0));
        const float* b2 = kv ? A.in[I_CVB2] : A.in[I_CKB2]; const float* gain = A.in[I_KNC];
        const float* tc = (const float*)(F.ws + WS_COS); const float* tsn = (const float*)(F.ws + WS_SIN);
        f32x4 acc[8]; float bb[8], gg[8];
#pragma unroll
        for (int nt = 0; nt < 8; ++nt) { f32x4 t = red[nt * 64 + lane];
#pragma unroll
            for (int ww = 1; ww < 8; ++ww) t += red[(ww * 8 + nt) * 64 + lane];
            acc[nt] = t; bb[nt] = b2[nt * 16 + l15]; gg[nt] = gain[nt * 16 + l15]; }
#pragma unroll
        for (int r = 0; r < 4; ++r) {
            const int m = rg * 16 + q4 * 4 + r, n = m & 511;
            float v[8]; float ss = 0.f;
#pragma unroll
            for (int nt = 0; nt < 8; ++nt) { v[nt] = acc[nt][r] + bb[nt]; ss += v[nt] * v[nt]; }
            if (kv == 0) {
                ss += __shfl_xor(ss, 1); ss += __shfl_xor(ss, 2); ss += __shfl_xor(ss, 4); ss += __shfl_xor(ss, 8);
                const float rstd = rsqrtf(ss * (1.0f / 128.0f) + 1e-6f);
#pragma unroll
                for (int nt = 0; nt < 8; ++nt) v[nt] = v[nt] * rstd * gg[nt];
                const int pos = n * 16 + 31; const float cs = tc[pos * 16 + l15], sn = tsn[pos * 16 + l15];
                const float x1 = v[0], x2 = v[1]; v[0] = x1 * cs - x2 * sn; v[1] = x2 * cs + x1 * sn;
            }
#pragma unroll
            for (int nt = 0; nt < 8; ++nt) { const float o = (n == 511) ? 0.f : v[nt]; OUT[(size_t)m * 128 + nt * 16 + l15] = (bf16_t)(cvt_pk_bf16(o, o) & 0xffffu); }
        }
    }
    __syncthreads();
}

__device__ __forceinline__ void phase5(const Frame& F, const Args& A) {
    FRESH_TID();
    const int w = F.wave;
    LAS float* xs = (LAS float*)F.lds;
    LAS float* red = (LAS float*)(F.lds + LTAB_OFF);
    LAS int* hist = (LAS int*)(F.lds + LTAB_OFF + 16384);
    LAS int* base = hist + 32;
    const float* X1 = A.in[I_X]; const bf16_t* ATT = (const bf16_t*)(F.ws + WS_H); const float* g2 = A.in[I_N2G]; const float* Wr = A.in[I_WR]; const float* br = A.in[I_BR];
    unsigned char* H2 = (unsigned char*)(F.ws + WS_H2);
    unsigned* slot = (unsigned*)(F.ws + WS_SLOT); int* tokl = (int*)(F.ws + WS_TOKL); float* wl = (float*)(F.ws + WS_WL);
    unsigned* counts = F.ctl + CW_CNT;
    constexpr int XS = 2050;
    float wr0[64], wr1[64];
    { const float* wb = Wr + (size_t)(256 * w + (lane >> 4)) * 32 + (lane & 15);
#pragma unroll
      for (int s = 0; s < 64; ++s) { wr0[s] = wb[(size_t)s * 128]; wr1[s] = wb[(size_t)s * 128 + 16]; } }
    LAS unsigned* rec = (LAS unsigned*)(F.lds + LTAB_OFF + 16384 + 512);
    int ci = 0;
    f32x4 vp[8]; u32x2 ap[8];
#define P5_PREFETCH(CH) do { const int ct_ = (CH) < NTOK / 16 ? (CH) : F.c; const f32x4* xr_ = (const f32x4*)(X1 + (size_t)(ct_ * 16 + 2 * w) * DM) + lane; const u32x2* ar_ = (const u32x2*)(ATT + (size_t)(ct_ * 16 + 2 * w) * DM) + lane; \
        _Pragma("unroll") for (int j = 0; j < 8; ++j) { vp[j] = xr_[64 * j]; ap[j] = ar_[64 * j]; } } while (0)
    P5_PREFETCH(F.c);
    for (int ch = F.c; ch < NTOK / 16; ch += F.G, ++ci) {
        if ((ci & 3) == 0 && tid < 32) hist[tid] = 0;
        { const int tok0 = ch * 16 + 2 * w;
#define P5_ROW(TOK, V, AT) do { float ssq = 0.f; \
              _Pragma("unroll") for (int j = 0; j < 8; ++j) { V[j][0] += bf_lo(AT[j].x); V[j][1] += bf_hi(AT[j].x); V[j][2] += bf_lo(AT[j].y); V[j][3] += bf_hi(AT[j].y); \
                  ssq += (V[j][0] * V[j][0] + V[j][1] * V[j][1]) + (V[j][2] * V[j][2] + V[j][3] * V[j][3]); } \
              { u32x2* x1o = (u32x2*)((bf16_t*)(F.ws + WS_MIX) + (size_t)(TOK) * DM) + lane; \
                _Pragma("unroll") for (int j = 0; j < 8; ++j) { u32x2 w1; w1.x = cvt_pk_bf16(V[j][0], V[j][1]); w1.y = cvt_pk_bf16(V[j][2], V[j][3]); x1o[64 * j] = w1; } } \
              const float rs = rsqrtf(wave_sum(ssq) * (1.0f / DM) + 1e-5f); \
              unsigned* oo = (unsigned*)(H2 + (size_t)(TOK) * DM) + lane; \
              _Pragma("unroll") for (int j = 0; j < 8; ++j) { const f32x4 gg = ((const f32x4*)g2)[64 * j + lane]; \
                  const float y0 = V[j][0] * rs * gg[0], y1 = V[j][1] * rs * gg[1], y2 = V[j][2] * rs * gg[2], y3 = V[j][3] * rs * gg[3]; \
                  oo[64 * j] = pk4_fp8(y0, y1, y2, y3); LAS f32x2* d = (LAS f32x2*)(xs + ((TOK) & 15) * XS + (64 * j + lane) * 4); d[0] = (f32x2){y0, y1}; d[1] = (f32x2){y2, y3}; } } while (0)
          P5_ROW(tok0, vp, ap);
          f32x4 vb[8]; u32x2 ab[8];
          { const f32x4* xr = (const f32x4*)(X1 + (size_t)(tok0 + 1) * DM) + lane; const u32x2* ar = (const u32x2*)(ATT + (size_t)(tok0 + 1) * DM) + lane;
#pragma unroll
            for (int j = 0; j < 8; ++j) { vb[j] = xr[64 * j]; ab[j] = ar[64 * j]; } }
          P5_ROW(tok0 + 1, vb, ab);
        }
        __syncthreads();
        P5_PREFETCH(ch + F.G);
        { f32x4 a0 = {0.f, 0.f, 0.f, 0.f}, a1 = {0.f, 0.f, 0.f, 0.f};
          const LAS float* xa = xs + (lane & 15) * XS + 256 * w + (lane >> 4);
#pragma unroll
          for (int s = 0; s < 64; ++s) { const float a = xa[4 * s];
              a0 = __builtin_amdgcn_mfma_f32_16x16x4f32(a, wr0[s], a0, 0, 0, 0); a1 = __builtin_amdgcn_mfma_f32_16x16x4f32(a, wr1[s], a1, 0, 0, 0); }
#pragma unroll
          for (int r = 0; r < 4; ++r) { red[(w * 16 + (lane >> 4) * 4 + r) * 32 + (lane & 15)] = a0[r]; red[(w * 16 + (lane >> 4) * 4 + r) * 32 + 16 + (lane & 15)] = a1[r]; } }
        __syncthreads();
        const int tl = tid >> 5, e = tid & 31, tok = ch * 16 + tl;
        float lg = br[e];
#pragma unroll
        for (int k = 0; k < 8; ++k) lg += red[(k * 16 + tl) * 32 + e];
        float tv[4]; int ti[4];
#pragma unroll
        for (int r = 0; r < 4; ++r) { float bv = lg; int bi = e;
#pragma unroll
            for (int off = 1; off < 32; off <<= 1) { const float ov = __shfl_xor(bv, off); const int oi = __shfl_xor(bi, off); if (ov > bv || (ov == bv && oi < bi)) { bv = ov; bi = oi; } }
            tv[r] = bv; ti[r] = bi; if (e == bi) lg = -INFINITY; }
        const float e1 = __expf(tv[1] - tv[0]), e2 = __expf(tv[2] - tv[0]), e3 = __expf(tv[3] - tv[0]); const float inv = 1.0f / (1.0f + e1 + e2 + e3);
        const int my_e = e == 0 ? ti[0] : e == 1 ? ti[1] : e == 2 ? ti[2] : ti[3];
        const float my_w = (e == 0 ? 1.0f : e == 1 ? e1 : e == 2 ? e2 : e3) * inv;
        if (e < 4) { const int lr = atomicAdd((int*)&hist[my_e], 1); LAS unsigned* r = rec + (((ci & 3) * 64) + tl * 4 + e) * 4;
            r[0] = (unsigned)tok * 4u + (unsigned)e; r[1] = (unsigned)my_e; r[2] = __float_as_uint(my_w); r[3] = (unsigned)lr; }
        const bool lastc = ch + F.G >= NTOK / 16;
        if ((ci & 3) == 3 || lastc) {
            __syncthreads();
            if (tid < 32) { const int hcnt = hist[tid]; base[tid] = hcnt > 0 ? (int)__hip_atomic_fetch_add(counts + 64 * tid, (unsigned)hcnt, RLX_AGENT) : 0; }
            __syncthreads();
            const int nrec = ((ci & 3) + 1) * 64;
            if (tid < nrec) { const LAS unsigned* r = rec + tid * 4; const unsigned ts = r[0], ee = r[1], wb = r[2]; const int rank = base[ee] + (int)r[3];
                __hip_atomic_store((unsigned*)tokl + (size_t)ee * NTOK + rank, ts >> 2, RLX_AGENT); __hip_atomic_store((unsigned*)wl + (size_t)ee * NTOK + rank, wb, RLX_AGENT);
                slot[ts] = (ee << 16) | (unsigned)rank; }
        }
        __syncthreads();
    }
}

__device__ __forceinline__ void moe_tables(const Frame& F) {
    FRESH_TID();
    LAS int* tb = (LAS int*)(F.lds + LTAB_OFF); LAS int* cn = tb + 64;
    if (tid < 32) cn[tid] = (int)__hip_atomic_load(F.ctl + CW_CNT + 64 * tid, RLX_AGENT);
    __syncthreads();
    if (tid == 0) { int acc = 0;
        for (int e = 0; e < 32; ++e) { tb[e] = acc; acc += (cn[e] + 255) >> 8; }
        tb[32] = acc; }
    __syncthreads();
}
__device__ __forceinline__ void phase8(const Frame& F, const Args& A) {
    FRESH_TID();
    const int gw = F.c * NWAVES + F.wave, NGW = F.G * NWAVES;
    const LAS int* tb = (const LAS int*)(F.lds + LTAB_OFF);
    const unsigned* slot = (const unsigned*)(F.ws + WS_SLOT); const unsigned char* Y = (const unsigned char*)(F.ws + WS_YBUF); float* out = A.out;
    for (int tok = gw; tok < NTOK; tok += NGW) {
        const u32x4 sl = *(const u32x4*)(slot + (size_t)tok * 4);
        const size_t r0 = (size_t)tb[sl.x >> 16] * 256 + (sl.x & 0xffffu), r1 = (size_t)tb[sl.y >> 16] * 256 + (sl.y & 0xffffu), r2 = (size_t)tb[sl.z >> 16] * 256 + (sl.z & 0xffffu), r3 = (size_t)tb[sl.w >> 16] * 256 + (sl.w & 0xffffu);
        f32x4* xo = (f32x4*)(out + (size_t)tok * DM) + lane; const u32x2* x1 = (const u32x2*)((const bf16_t*)(F.ws + WS_MIX) + (size_t)tok * DM) + lane;
        const unsigned* y0 = (const unsigned*)(Y + r0 * DM) + lane; const unsigned* y1 = (const unsigned*)(Y + r1 * DM) + lane; const unsigned* y2 = (const unsigned*)(Y + r2 * DM) + lane; const unsigned* y3 = (const unsigned*)(Y + r3 * DM) + lane;
#pragma unroll
        for (int j = 0; j < 8; ++j) { const u32x2 t = x1[64 * j]; const unsigned a = y0[64 * j], b = y1[64 * j], c = y2[64 * j], d = y3[64 * j];
            const f32x2 al = __builtin_amdgcn_cvt_pk_f32_fp8((int)a, false), ah = __builtin_amdgcn_cvt_pk_f32_fp8((int)a, true), bl = __builtin_amdgcn_cvt_pk_f32_fp8((int)b, false), bh = __builtin_amdgcn_cvt_pk_f32_fp8((int)b, true);
            const f32x2 cl = __builtin_amdgcn_cvt_pk_f32_fp8((int)c, false), ch = __builtin_amdgcn_cvt_pk_f32_fp8((int)c, true), dl = __builtin_amdgcn_cvt_pk_f32_fp8((int)d, false), dh = __builtin_amdgcn_cvt_pk_f32_fp8((int)d, true);
            f32x4 v;
            v[0] = fmaf((al.x + bl.x) + (cl.x + dl.x), epi::Y8_INV, bf_lo(t.x)); v[1] = fmaf((al.y + bl.y) + (cl.y + dl.y), epi::Y8_INV, bf_hi(t.x));
            v[2] = fmaf((ah.x + bh.x) + (ch.x + dh.x), epi::Y8_INV, bf_lo(t.y)); v[3] = fmaf((ah.y + bh.y) + (ch.y + dh.y), epi::Y8_INV, bf_hi(t.y));
            xo[64 * j] = v; }
    }
}

constexpr int NPHASE = 10;
__global__ void __launch_bounds__(NWAVES * 64, 2) hybrid_fwd(Args args) {
    extern __shared__ __attribute__((aligned(16))) unsigned char lds[];
    Frame F;
    F.lds = (LAS unsigned char*)lds; F.ldsg = (char*)lds;
    F.wave = __builtin_amdgcn_readfirstlane((int)(threadIdx.x >> 6));
    F.G = gridDim.x; F.c = blockIdx.x;
    F.ws = args.ws; F.ctl = (unsigned*)(args.ws + WS_CTL);
    volatile LAS unsigned* MISC = (volatile LAS unsigned*)(F.lds + MISC_OFF);
    { const int l0 = fresh_lane(); if (F.wave == 0) MISC[l0] = 0u; }
    __syncthreads();
    XcdBarrier bar; bar.bar = F.ctl + CW_BAR; bar.x = 0; bar.st = nullptr;
    if (args.use_bar) bar = xcd_barrier_post(F.ctl + CW_BAR, MISC + 8, F.wave == 0 && fresh_lane() == 0);
    const int lo = args.ph_lo, hi = args.ph_hi;
#ifndef PHASE_MASK
#define PHASE_MASK 0x3ff
#endif
#define IN(k) ((((PHASE_MASK) >> (k)) & 1) && lo <= (k) && (k) < hi)
#ifndef DBL_MASK
#define DBL_MASK 0
#endif
#define DBL(k) (((DBL_MASK) >> (k)) & 1)
#define SEAM(k) do { if (IN(k) && IN((k) + 1)) xcd_barrier(bar, F.wave == 0 && fresh_lane() == 0); } while (0)

    if (IN(0)) { for (int rep = 0; rep <= DBL(0); ++rep) phase0(F, args); }
    SEAM(0);
    if (IN(1)) for (int rep = 0; rep <= DBL(1); ++rep) {
        pg8::DenseSched S; S.init(F.ws + WS_H, DM, F.ws + WS_WINT, NTOK, NINP, DM, F.G, F.c);
        epi::InProj E{(bf16_t*)(F.ws + WS_Q), (bf16_t*)(F.ws + WS_KV), (bf16_t*)(F.ws + WS_PIN), (float*)(F.ws + WS_GLOG)};
        pg8::gemm_phase(F.lds, S, E, DM * 2, F.wave);
        if (rep == 0) { if (F.G == 256) { if (F.c >= 192) { posb_partials(F, args, F.c - 192, 64); __syncthreads();
                                                            convert_tiles(F, args, NMOE_TILES + 16 * 29 + (F.c - 192), 64, 1 << 30); } }
                        else posb_partials(F, args, F.c, F.G); }
    }
    SEAM(1);
    if (IN(2)) {
        const bool split = F.G >= 128;
        if (!split || F.c < 64) {
            pg8::CmpSched S{(const char*)(F.ws + WS_KV), (const char*)(F.ws + WS_W1T), split ? 64 : F.G, F.c};
            epi::CmpHid E{(float*)(F.ws + WS_ACT)};
            pg8::gemm_phase(F.lds, S, E, 8192, F.wave, 16);
            if (split) norm_rope_rows(F, args, F.c, 64, P2_ROPE_SPLIT, NROPE_ITEM);
        }
        if (!split || F.c >= 64) { const int ec = split ? F.c - 64 : F.c, eG = split ? F.G - 64 : F.G;
            if (ec == 0 && F.wave == 0) cmp_bias_total(F, args);
            norm_rope_rows(F, args, ec, eG, NROPE_Q, split ? P2_ROPE_SPLIT : NROPE_ITEM); pool_diffs(F, ec, eG);
            if (F.G == 256) { __syncthreads(); att::conv_early(F.ldsg, args.in[I_WGU], args.in[I_WD], F.ws, ec, eG, F.wave); __syncthreads(); } }
    }
    SEAM(2);
    if (IN(3)) { for (int L = F.c; L < 256; L += F.G) cmp_layer2(F, args, L >> 7, L & 127); }
    SEAM(3);
    if (IN(4)) for (int rep = 0; rep <= DBL(4); ++rep) {
        { pg8::PoolSched S{(const char*)(F.ws + WS_DP), (const char*)(F.ws + WS_PWT), F.G, F.c};
          epi::Pool E{(bf16_t*)(F.ws + WS_MIX), args.in[I_POOLS]};
          pg8::gemm_phase(F.lds, S, E, 512, F.wave); }
        __syncthreads();
        att::Ptrs P{(const bf16_t*)(F.ws + WS_Q), (const bf16_t*)(F.ws + WS_KV), (const bf16_t*)(F.ws + WS_CMP), (const bf16_t*)(F.ws + WS_CMP + 512 * 1024),
                    (const float*)(F.ws + WS_GLOG), (bf16_t*)(F.ws + WS_MIX), (float*)(F.ws + WS_ASCR) + (size_t)F.c * 256 * 128,
                    args.in[I_QNG], (const float*)(F.ws + WS_COS), (const float*)(F.ws + WS_SIN)};
        att::Conv cv = att::conv_init(args.in[I_WGU], args.in[I_WD], F.ws, F.c, F.G == 256 && rep == 0, F.wave); if (cv.total) cv.total -= att::CONV_EARLY;
        for (int r = 0;; ++r) { const int k = r * F.G + ((r & 1) ? (F.G - 1 - F.c) : F.c); if (k >= 512) break;
            const int qi = 127 - (k >> 2), bg = k & 3;
#if ATT_CHECK
            att::attn_item<0, false>(F.ldsg, P, bg >> 1, bg & 1, qi, F.wave, F.ctl + CW_ERR, cv); att::attn_item<1, true>(F.ldsg, P, bg >> 1, bg & 1, qi, F.wave, F.ctl + CW_ERR, cv);
#else
            att::attn_item<1, false>(F.ldsg, P, bg >> 1, bg & 1, qi, F.wave, F.ctl + CW_ERR, cv);
#endif
        }
        att::conv_tail(F.ldsg, cv, F.wave);
        __syncthreads();
    }
    SEAM(4);
    if (IN(5)) for (int rep = 0; rep <= DBL(5); ++rep) {
        pg8::DenseSched S; S.init(F.ws + WS_MIX, DM, F.ws + WS_WOUTT, NTOK, DM, DM, F.G, F.c);
        epi::OutProj E{(bf16_t*)(F.ws + WS_H)};
        pg8::gemm_phase(F.lds, S, E, DM * 2, F.wave);
    }
    SEAM(5);
    if (IN(6)) { phase5(F, args); }
    SEAM(6);
    if (IN(7)) for (int rep = 0; rep <= DBL(7); ++rep) {
        moe_tables(F);
        pg8::MoeSched<16, true> S{(const char*)(F.ws + WS_H2), (const char*)(F.ws + WS_WGU), (const int*)(F.ws + WS_TOKL), (const LAS int*)(F.lds + LTAB_OFF), (const LAS int*)(F.lds + LTAB_OFF) + 64, F.G, F.c, (size_t)4096 * 2048};
        epi::GateUp E{(unsigned char*)(F.ws + WS_ACT), args.in[I_BGU]};
        pg8::gemm_phase(F.lds, S, E, DM, F.wave);
    }
    SEAM(7);
    if (IN(8)) for (int rep = 0; rep <= DBL(8); ++rep) {
        moe_tables(F);
        pg8::MoeSched<8, false> S{(const char*)(F.ws + WS_ACT), (const char*)(F.ws + WS_WD), nullptr, (const LAS int*)(F.lds + LTAB_OFF), (const LAS int*)(F.lds + LTAB_OFF) + 64, F.G, F.c, (size_t)2048 * 2048};
        epi::Down E{(unsigned char*)(F.ws + WS_YBUF), args.in[I_BD], (const float*)(F.ws + WS_WL)};
        pg8::gemm_phase(F.lds, S, E, DFF, F.wave);
    }
    SEAM(8);
    if (IN(9)) { moe_tables(F); phase8(F, args);
#if ATT_CHECK
        if (__hip_atomic_load(F.ctl + CW_ERR, RLX_AGENT) != 0u && F.c == 0 && F.wave == 0) { VM_WAIT(); args.out[fresh_lane()] = __builtin_nanf(""); }
#endif
    }
#undef IN
#undef SEAM
}

#ifndef N_LAUNCH_MODE
#define N_LAUNCH_MODE 1
#endif
extern "C" void kernel_launch(void* const* d_in, const int* in_sizes, int n_in, void* d_out, int out_size, void* d_ws, size_t ws_size, hipStream_t stream) {
    static int grid = 0;
    if (grid == 0) {
        if (n_in != 27 || out_size != NTOK * DM || ws_size < WS_END) { fprintf(stderr, "kernel_launch: unexpected shapes (n_in %d out %d ws %zu)\n", n_in, out_size, ws_size); grid = -1; return; }
        int dev = 0, cus = 0, per_cu = 0;
        if (hipGetDevice(&dev) != hipSuccess || hipDeviceGetAttribute(&cus, hipDeviceAttributeMultiprocessorCount, dev) != hipSuccess) { grid = -1; return; }
        if (hipFuncSetAttribute((const void*)hybrid_fwd, hipFuncAttributeMaxDynamicSharedMemorySize, LDS_BYTES) != hipSuccess) { fprintf(stderr, "kernel_launch: hipFuncSetAttribute failed\n"); grid = -1; return; }
        if (hipOccupancyMaxActiveBlocksPerMultiprocessor(&per_cu, (const void*)hybrid_fwd, NWAVES * 64, LDS_BYTES) != hipSuccess || per_cu < 1) { fprintf(stderr, "kernel_launch: occupancy query says %d\n", per_cu); }
        (void)hipGetLastError();
        grid = cus;
    }
    if (grid < 0) return;
    (void)hipMemsetAsync((char*)d_ws + WS_CTL, 0, CTL_ZERO_BYTES, stream);
    Args a{};
    for (int i = 0; i < 27; ++i) a.in[i] = (const float*)d_in[i];
    a.out = (float*)d_out; a.ws = (unsigned char*)d_ws; a.pad = 0;
    if (N_LAUNCH_MODE == 1) {
        a.ph_lo = 0; a.ph_hi = NPHASE; a.use_bar = 1;
        hipLaunchKernelGGL(hybrid_fwd, dim3(grid), dim3(NWAVES * 64), LDS_BYTES, stream, a);
    } else {
        for (int p = 0; p < NPHASE; ++p) { a.ph_lo = p; a.ph_hi = p + 1; a.use_bar = 0;
            hipLaunchKernelGGL(hybrid_fwd, dim3(grid), dim3(NWAVES * 64), LDS_BYTES, stream, a); }
    }
}
```
